# Optimizing an MI355X kernel written in HIP

```python
import math
import jax, jax.numpy as jnp
from jax import lax
import numpy as np

D_MODEL = 1024
BATCH = 16
SEQ = 4096
DEPTH = 1

PLE_DIM = 256
SSM_WIDTH = D_MODEL // 2
SSM_GROUP = 16
SSM_GROUPS = SSM_WIDTH // SSM_GROUP
SSM_STATE = 64
POOL_WIDTH = D_MODEL // 2
POOL_WINDOWS = (2, 4, 8, 16)
POOL_GROUPS = len(POOL_WINDOWS)
POOL_GROUP_DIM = POOL_WIDTH // POOL_GROUPS
N_BRANCHES = 2
IN_PROJ_WIDTH = SSM_WIDTH + POOL_WIDTH + N_BRANCHES * D_MODEL
N_EXPERTS = 32
TOP_K = 4
D_EXPERT = D_MODEL
SWIGLU_LIMIT = 7.0
SWIGLU_ALPHA = 1.702
EXPERT_BLOCK = 128
LN_EPS = 1e-5
DEEPNORM_ALPHA = (2.0 * DEPTH) ** 0.25
DEEPNORM_BETA = (8.0 * DEPTH) ** -0.25

kernel_name = "hybrid_s5_pool_moe_deepnorm"


def _layer_norm(x, g, b):
    xf = x.astype(jnp.float32)
    mu = jnp.mean(xf, axis=-1, keepdims=True)
    xc = xf - mu
    var = jnp.mean(xc * xc, axis=-1, keepdims=True)
    y = xc * lax.rsqrt(var + LN_EPS)
    return (y * g.astype(jnp.float32) + b.astype(jnp.float32)).astype(x.dtype)


def _linear_recurrence_op(e1, e2):
    a1, b1 = e1
    a2, b2 = e2
    return a2 * a1, a2 * b1 + b2


def _s5_branch(u, lam_re, lam_im, log_step, b_re, b_im, c_re, c_im, d_skip, w_val, w_gate):
    bsz, seq, _ = u.shape
    f32 = jnp.float32
    uf = u.astype(f32).reshape(bsz, seq, SSM_GROUPS, SSM_GROUP)
    lam = lax.complex(lam_re.astype(f32), lam_im.astype(f32))
    step = jnp.exp(log_step.astype(f32))[:, None]
    lam_bar = jnp.exp(lam * step)
    b_cplx = lax.complex(b_re.astype(f32), b_im.astype(f32))
    b_bar = ((lam_bar - 1.0) / lam)[..., None] * b_cplx
    bu = jnp.einsum('blgh,gph->blgp', uf.astype(jnp.complex64), b_bar)
    a = jnp.broadcast_to(lam_bar, (1, seq) + lam_bar.shape)
    _, states = lax.associative_scan(_linear_recurrence_op, (a, bu), axis=1)
    c_cplx = lax.complex(c_re.astype(f32), c_im.astype(f32))
    y = jnp.einsum('blgp,ghp->blgh', states, c_cplx).real + d_skip.astype(f32) * uf
    z = jax.nn.gelu(y.reshape(bsz, seq, SSM_WIDTH))
    return (z @ w_val) * jax.nn.sigmoid(z @ w_gate)


def _pool_branch(u, w_group, scale, w_proj):
    bsz, seq, _ = u.shape
    f32 = jnp.float32
    uf = u.astype(f32).reshape(bsz, seq, POOL_GROUPS, POOL_GROUP_DIM)
    cs = jnp.cumsum(uf, axis=1)
    pos = jnp.arange(1, seq + 1, dtype=f32)
    outs = []
    for g, w in enumerate(POOL_WINDOWS):
        cs_g = cs[:, :, g]
        lagged = jnp.pad(cs_g[:, :seq - w], ((0, 0), (w, 0), (0, 0)))
        count = jnp.minimum(pos, float(w))[None, :, None]
        outs.append((cs_g - lagged) / count - uf[:, :, g])
    pooled = jnp.stack(outs, axis=2)
    mixed = jnp.einsum('blgc,gcd->blgd', pooled, w_group.astype(f32)).reshape(bsz, seq, POOL_WIDTH)
    return (mixed * scale) @ w_proj


def _moe(h, w_router, b_router, w_gate, b_gate, w_up, b_up, w_down, b_down):
    bsz, seq, d = h.shape
    t = h.reshape(-1, d)
    n_tok = t.shape[0]
    logits = (t @ w_router + b_router).astype(jnp.float32)
    top_val, top_idx = lax.top_k(logits, TOP_K)
    weights = jax.nn.softmax(top_val, axis=-1)
    n_slots = n_tok * TOP_K
    n_blocks = -(-n_slots // EXPERT_BLOCK) + N_EXPERTS
    n_rows = n_blocks * EXPERT_BLOCK
    flat_e = top_idx.reshape(-1).astype(jnp.int32)
    order = jnp.argsort(flat_e)
    sorted_e = flat_e[order]
    counts = jnp.bincount(flat_e, length=N_EXPERTS)
    start = jnp.cumsum(counts) - counts
    padded = ((counts + EXPERT_BLOCK - 1) // EXPERT_BLOCK) * EXPERT_BLOCK
    pad_end = jnp.cumsum(padded)
    pad_start = pad_end - padded
    rank = jnp.arange(n_slots, dtype=jnp.int32) - start[sorted_e]
    dest_sorted = (pad_start[sorted_e] + rank).astype(jnp.int32)
    row_token = jnp.full((n_rows,), n_tok, jnp.int32).at[dest_sorted].set((order // TOP_K).astype(jnp.int32))
    t_pad = jnp.concatenate([t, jnp.zeros((1, d), t.dtype)], axis=0)
    xs = t_pad[row_token].reshape(n_blocks, EXPERT_BLOCK, d)
    block_start = jnp.arange(n_blocks, dtype=pad_end.dtype) * EXPERT_BLOCK
    block_expert = jnp.minimum(jnp.searchsorted(pad_end, block_start, side='right'), N_EXPERTS - 1)

    def expert_block(args):
        xb, e = args
        g = xb @ w_gate[e] + b_gate[e]
        u = xb @ w_up[e] + b_up[e]
        g = jnp.minimum(g, SWIGLU_LIMIT)
        u = jnp.clip(u, -SWIGLU_LIMIT, SWIGLU_LIMIT)
        glu = g * jax.nn.sigmoid(SWIGLU_ALPHA * g)
        return ((u + 1.0) * glu) @ w_down[e] + b_down[e]

    ys = lax.map(expert_block, (xs, block_expert)).reshape(n_rows, d)
    dest = jnp.zeros((n_slots,), jnp.int32).at[order].set(dest_sorted).reshape(n_tok, TOP_K)
    out = jnp.einsum('tk,tkd->td', weights.astype(ys.dtype), ys[dest])
    return out.reshape(bsz, seq, d)


def setup_inputs(seed: int = 0) -> dict:
    key = jax.random.key(seed)
    ks = iter(jax.random.split(key, 40))
    f32 = jnp.float32

    def nrm(shape, scale):
        return jax.random.normal(next(ks), shape, f32) * scale

    L = DEPTH
    D = D_MODEL
    G, P, H = SSM_GROUPS, SSM_STATE, SSM_GROUP
    n_idx = jnp.arange(P, dtype=f32)
    return {
        "x": nrm((BATCH, SEQ, D), 1.0),
        "p": nrm((DEPTH, BATCH, SEQ, PLE_DIM), 1.0),
        "w_in": nrm((L, D, IN_PROJ_WIDTH), D ** -0.5),
        "ssm_lambda_re": -0.5 + nrm((L, G, P), 0.01),
        "ssm_lambda_im": math.pi * n_idx + nrm((L, G, P), 0.01),
        "ssm_log_step": jax.random.uniform(next(ks), (L, G), f32, math.log(1e-3), math.log(1e-1)),
        "ssm_b_re": nrm((L, G, P, H), (2.0 * H) ** -0.5),
        "ssm_b_im": nrm((L, G, P, H), (2.0 * H) ** -0.5),
        "ssm_c_re": nrm((L, G, H, P), (2.0 * P) ** -0.5),
        "ssm_c_im": nrm((L, G, H, P), (2.0 * P) ** -0.5),
        "ssm_d": nrm((L, G, H), 1.0),
        "w_glu_val": nrm((L, SSM_WIDTH, D), SSM_WIDTH ** -0.5),
        "w_glu_gate": nrm((L, SSM_WIDTH, D), SSM_WIDTH ** -0.5),
        "w_pool_group": nrm((L, POOL_GROUPS, POOL_GROUP_DIM, POOL_GROUP_DIM), POOL_GROUP_DIM ** -0.5),
        "pool_scale": 1.0 + nrm((L, POOL_WIDTH), 0.02),
        "w_pool_proj": nrm((L, POOL_WIDTH, D), POOL_WIDTH ** -0.5),
        "w_out": nrm((L, D, D), DEEPNORM_BETA * D ** -0.5),
        "ln1_g": 1.0 + nrm((L, D), 0.02),
        "ln1_b": nrm((L, D), 0.02),
        "w_router": nrm((L, D, N_EXPERTS), D ** -0.5),
        "b_router": nrm((L, N_EXPERTS), 0.01),
        "w_gate": nrm((L, N_EXPERTS, D, D_EXPERT), D ** -0.5),
        "b_gate": nrm((L, N_EXPERTS, D_EXPERT), 0.01),
        "w_up": nrm((L, N_EXPERTS, D, D_EXPERT), D ** -0.5),
        "b_up": nrm((L, N_EXPERTS, D_EXPERT), 0.01),
        "w_down": nrm((L, N_EXPERTS, D_EXPERT, D), DEEPNORM_BETA * D_EXPERT ** -0.5),
        "b_down": nrm((L, N_EXPERTS, D), 0.01),
        "w_ple_gate": nrm((L, D, D), D ** -0.5),
        "w_ple_proj": nrm((L, PLE_DIM, D), PLE_DIM ** -0.5),
        "ln2_g": 1.0 + nrm((L, D), 0.02),
        "ln2_b": nrm((L, D), 0.02),
    }


def reference(x, p, w_in, ssm_lambda_re, ssm_lambda_im, ssm_log_step, ssm_b_re, ssm_b_im,
              ssm_c_re, ssm_c_im, ssm_d, w_glu_val, w_glu_gate, w_pool_group, pool_scale,
              w_pool_proj, w_out, ln1_g, ln1_b, w_router, b_router, w_gate, b_gate, w_up, b_up,
              w_down, b_down, w_ple_gate, w_ple_proj, ln2_g, ln2_b):
    h = x
    for i in range(DEPTH):
        proj = h @ w_in[i]
        u_ssm = proj[..., :SSM_WIDTH]
        u_pool = proj[..., SSM_WIDTH:SSM_WIDTH + POOL_WIDTH]
        gate_a = jax.nn.sigmoid(proj[..., SSM_WIDTH + POOL_WIDTH:SSM_WIDTH + POOL_WIDTH + D_MODEL])
        gate_b = jax.nn.sigmoid(proj[..., SSM_WIDTH + POOL_WIDTH + D_MODEL:])
        y_ssm = _s5_branch(u_ssm, ssm_lambda_re[i], ssm_lambda_im[i], ssm_log_step[i],
                           ssm_b_re[i], ssm_b_im[i], ssm_c_re[i], ssm_c_im[i], ssm_d[i],
                           w_glu_val[i], w_glu_gate[i])
        y_pool = _pool_branch(u_pool, w_pool_group[i], pool_scale[i], w_pool_proj[i])
        merged = gate_a * y_ssm + gate_b * y_pool
        h = _layer_norm(DEEPNORM_ALPHA * h + merged @ w_out[i], ln1_g[i], ln1_b[i])
        moe_out = _moe(h, w_router[i], b_router[i], w_gate[i], b_gate[i], w_up[i], b_up[i],
                       w_down[i], b_down[i])
        ple = jax.nn.sigmoid(h @ w_ple_gate[i]) * (p[i] @ w_ple_proj[i])
        h = _layer_norm(DEEPNORM_ALPHA * h + moe_out + ple, ln2_g[i], ln2_b[i])
    return h
```

```cpp
#include <hip/hip_runtime.h>
#include <cstdio>
#include <cstdint>

#ifndef MK_PER_PHASE
#define MK_PER_PHASE 0
#endif

namespace pg8 {
#define PG8_LAS __attribute__((address_space(3)))
typedef unsigned short bf16_t;
typedef short bf16x8 __attribute__((ext_vector_type(8)));
typedef float f32x4 __attribute__((ext_vector_type(4)));
typedef float f32x2 __attribute__((ext_vector_type(2)));
typedef unsigned u32x4 __attribute__((ext_vector_type(4)));
typedef unsigned u32x2 __attribute__((ext_vector_type(2)));
constexpr int BM = 256, BK = 64, HALF = 128, HTB = HALF * BK * 2  , STAGE_BYTES = 8 * HTB, NXCD = 8, WGM = 8;

__host__ __device__ __forceinline__ int lds_byte(int r, int c) { const int st = (r >> 4) * 2 + (c >> 5), rr = r & 15, cc = c & 31, ob = rr * 64 + cc * 2; return st * 1024 + (ob ^ (((ob >> 9) & 1) << 5)); }
__host__ __device__ __forceinline__ void stage_rc(int b, int& R, int& C) { const int st = b / 1024, sb = b % 1024, swz = sb ^ (((sb >> 9) & 1) << 5); R = (st >> 1) * 16 + swz / 64; C = (st & 1) * 32 + (swz % 64) / 2; }
__host__ __device__ __forceinline__ int perm32(int rho) { const int n = rho >> 4, i = rho & 15; return 8 * (i >> 2) + 4 * n + (i & 3); }

struct Unit { int pm, pn, aux; };

struct Prob {
    const char* A; const char* B; const int* gidx;
    unsigned lda;
    unsigned ldb;
    unsigned kstepA;
    int nt;
    int bgn;
    int ib_off;
};

struct GridOrder {
    int nM, nN, nwg, G, c, gshift;
    __device__ void init(int nM_, int nN_, int G_, int c_, int gshift_) { nM = nM_; nN = nN_; nwg = nM * nN; G = G_; c = c_; gshift = gshift_; }
    __device__ bool next(int i, Unit& u) const {
        const long L = (long)i * G + c; if (L >= nwg) return false;
        int wgid = (int)L; { const int q = nwg / NXCD, r = nwg % NXCD, xcd = wgid % NXCD, off = wgid / NXCD; wgid = (xcd < r ? xcd * (q + 1) : r * (q + 1) + (xcd - r) * q) + off; }
        const int nig = WGM * nN, gid = wgid / nig, fm = gid * WGM, gsz = (nM - fm) < WGM ? (nM - fm) : WGM;
        u.pm = fm + ((wgid % nig) % gsz); u.pn = (wgid % nig) / gsz; u.aux = gshift >= 0 ? (u.pm >> gshift) : 0; return true;
    }
};
struct MoeOrder {
    const PG8_LAS int* tp; int nct, total, G, c;
    __device__ void init(const PG8_LAS int* tp_, int nct_, int G_, int c_) { tp = tp_; nct = nct_; G = G_; c = c_; total = __builtin_amdgcn_readfirstlane(tp_[32]) * nct_; }
    __device__ bool next(int i, Unit& u) const {
        const long L = (long)i * G + c; if (L >= total) return false;
        int wgid = (int)L; { const int q = total / NXCD, r = total % NXCD, xcd = wgid % NXCD, off = wgid / NXCD; wgid = (xcd < r ? xcd * (q + 1) : r * (q + 1) + (xcd - r) * q) + off; }
        int e = 0; while (e < 31 && wgid >= __builtin_amdgcn_readfirstlane(tp[e + 1]) * nct) ++e;
        const int t0 = __builtin_amdgcn_readfirstlane(tp[e]), nte = __builtin_amdgcn_readfirstlane(tp[e + 1]) - t0, local = wgid - t0 * nct;
        u.pn = __builtin_amdgcn_readfirstlane(local / nte); u.pm = __builtin_amdgcn_readfirstlane(t0 + local % nte); u.aux = e; return true;
    }
};

__device__ __forceinline__ unsigned cvt_pk_bf16(float lo, float hi) { unsigned r; asm volatile("v_cvt_pk_bf16_f32 %0, %1, %2" : "=v"(r) : "v"(lo), "v"(hi)); return r; }
__device__ __forceinline__ float bf_lo(unsigned w) { return __uint_as_float(w << 16); }
__device__ __forceinline__ float bf_hi(unsigned w) { return __uint_as_float(w & 0xffff0000u); }
__device__ __forceinline__ float sigmoid_f(float x) { return __builtin_amdgcn_rcpf(1.0f + __builtin_amdgcn_exp2f(-1.4426950409f * x)); }

template <int AMODE, class Epi, class Sched, bool ALIGN_EPI>
__device__ __forceinline__ void gemm_phase(PG8_LAS unsigned char* lds, const Prob P, const Sched& S, const Epi& E) {
    const int tid = threadIdx.x, wid = __builtin_amdgcn_readfirstlane(tid >> 6), lane = tid & 63, wr = wid >> 2, wc = wid & 3, fr = lane & 15, fq = lane >> 4;
    const int nt = P.nt;
    unsigned vo[2][2], voffB[2];
#pragma unroll
    for (int i = 0; i < 2; ++i) { int R, C; stage_rc(tid * 16 + i * 8192, R, C); const int Rb = Epi::PERM ? ((R & ~31) + perm32(R & 31)) : R;
        voffB[i] = (unsigned)Rb * P.ldb + (unsigned)C * 2u;
#pragma unroll
        for (int h = 0; h < 2; ++h) {
            if (AMODE == 0) vo[h][i] = (unsigned)(h * HALF + R) * P.lda + (unsigned)C * 2u;
            else if (AMODE == 1) vo[h][i] = (unsigned)(C >> 4) * P.lda + (unsigned)(h * HALF + R) * 32u + (unsigned)(C & 15) * 2u;
            else vo[h][i] = 0u; } }
    const size_t kstepA = (size_t)P.kstepA, kstepB = (size_t)(BK * 2);
    const size_t hstepB = (size_t)HALF * P.ldb;
    const unsigned ldsw = (unsigned)wid * 1024u;
    const int aoff = lds_byte(wr * 64 + fr, fq * 8), boff = lds_byte(wc * 32 + fr, fq * 8);
#define PG8_AOFF(u) ((size_t)(AMODE == 0 ? (size_t)(u).pm * BM * P.lda : (AMODE == 1 ? (size_t)(u).pm * BM * 32 : (size_t)0)))
#define PG8_BOFF(u) ((size_t)((size_t)(u).aux * P.bgn + (size_t)(u).pn * BM) * P.ldb)
#define PG8_GIDX(src, dst) do { _Pragma("unroll") for (int _i = 0; _i < 2; ++_i) { int _R, _C; stage_rc(tid * 16 + _i * 8192, _R, _C); _Pragma("unroll") for (int _h = 0; _h < 2; ++_h) \
        dst[_h][_i] = (unsigned)(src)[_h * HALF + _R] * P.lda + (unsigned)_C * 2u; } } while (0)
#define PG8_SA(b, h) (((b) * 2 + (h)) * HTB)
#define PG8_SB(b, h) ((4 + (b) * 2 + (h)) * HTB)
#define PG8_STAGE2(bufoff, gbase, v0, v1) do { \
        __builtin_amdgcn_global_load_lds((const unsigned*)((const char*)(gbase) + (v0)), (PG8_LAS unsigned*)(lds + (bufoff) + ldsw), 16, 0, 0); \
        __builtin_amdgcn_global_load_lds((const unsigned*)((const char*)(gbase) + (v1)), (PG8_LAS unsigned*)(lds + (bufoff) + ldsw + 8192), 16, 0, 0); } while (0)
#define PG8_STAGE_B(bufoff, gbase) PG8_STAGE2(bufoff, gbase, voffB[0], voffB[1])
#define PG8_LDA(dst, b, h) do { _Pragma("unroll") for (int m = 0; m < 4; ++m) _Pragma("unroll") for (int k = 0; k < 2; ++k) dst[m][k] = *(const PG8_LAS bf16x8*)(lds + PG8_SA(b, h) + aoff + m * 2048 + k * 1024); } while (0)
#define PG8_LDB(dst, b, h) do { _Pragma("unroll") for (int n = 0; n < 2; ++n) _Pragma("unroll") for (int k = 0; k < 2; ++k) dst[n][k] = *(const PG8_LAS bf16x8*)(lds + PG8_SB(b, h) + boff + n * 2048 + k * 1024); } while (0)
#define PG8_MMA(ai, bj, At, Bt) do { __builtin_amdgcn_s_setprio(1); _Pragma("unroll") for (int m = 0; m < 4; ++m) _Pragma("unroll") for (int n = 0; n < 2; ++n) _Pragma("unroll") for (int k = 0; k < 2; ++k) \
        acc[ai][bj][m][n] = __builtin_amdgcn_mfma_f32_16x16x32_bf16(Bt[n][k], At[m][k], acc[ai][bj][m][n], 0, 0, 0); __builtin_amdgcn_s_setprio(0); } while (0)
#define PG8_WAIT_V(n) asm volatile("s_waitcnt vmcnt(" #n ")" ::: "memory")
#define PG8_WAIT_L(n) asm volatile("s_waitcnt lgkmcnt(" #n ")" ::: "memory")
#define PG8_BAR __builtin_amdgcn_s_barrier()
#define PG8_SCHED __builtin_amdgcn_sched_barrier(0)
    Unit cur, nxt; int ui = 0;
    if (!S.next(0, cur)) return;
    f32x4 acc[2][2][4][2];
#pragma unroll
    for (int a = 0; a < 2; ++a)
#pragma unroll
        for (int b = 0; b < 2; ++b)
#pragma unroll
            for (int m = 0; m < 4; ++m)
#pragma unroll
                for (int n = 0; n < 2; ++n) acc[a][b][m][n] = (f32x4){0.f, 0.f, 0.f, 0.f};
    bf16x8 At[4][2], B0[2][2], B1[2][2];
    const char* cA = P.A + PG8_AOFF(cur); const char* cB = P.B + PG8_BOFF(cur);
    if (AMODE == 2) { const int* gi = P.gidx + cur.pm * BM; PG8_GIDX(gi, vo); }
    PG8_STAGE_B(PG8_SB(0, 0), cB); PG8_STAGE_B(PG8_SB(0, 1), cB + hstepB); PG8_STAGE2(PG8_SA(0, 0), cA, vo[0][0], vo[0][1]); PG8_STAGE2(PG8_SA(0, 1), cA, vo[1][0], vo[1][1]);
    if (wr == 1) PG8_BAR;
    PG8_WAIT_V(2); PG8_BAR;
    PG8_STAGE_B(PG8_SB(1, 0), cB + kstepB); PG8_STAGE2(PG8_SA(1, 0), cA + kstepA, vo[0][0], vo[0][1]); PG8_STAGE_B(PG8_SB(1, 1), cB + hstepB + kstepB);
    PG8_WAIT_V(6); PG8_BAR;
    for (;;) {
        const bool has_next = S.next(ui + 1, nxt);
        const char* nA = has_next ? P.A + PG8_AOFF(nxt) : cA; const char* nB = has_next ? P.B + PG8_BOFF(nxt) : cB;
#pragma nounroll
        for (int t = 0; t < nt; t += 2) {
            const bool last = (t == nt - 2);
            const char* a1 = cA + (size_t)(t + 1) * kstepA;
            const char* a2 = last ? nA : cA + (size_t)(t + 2) * kstepA; const char* b2 = last ? nB : cB + (size_t)(t + 2) * kstepB;
            const char* a3 = a2 + kstepA; const char* b3 = b2 + kstepB;
            if (AMODE == 2) { if (t == 0 && has_next && wid < 4)
                    __builtin_amdgcn_global_load_lds((const unsigned*)(P.gidx + nxt.pm * BM + wid * 64 + lane), (PG8_LAS unsigned*)(lds + P.ib_off + (((ui + 1) & 1) * 256 + wid * 64) * 4), 4, 0, 0); }
            PG8_LDB(B0, 0, 0); PG8_LDB(B1, 0, 1); PG8_SCHED; PG8_LDA(At, 0, 0); PG8_STAGE2(PG8_SA(1, 1), a1, vo[1][0], vo[1][1]);
            if (AMODE == 2) { if (last && has_next) { const PG8_LAS int* ib = (const PG8_LAS int*)(lds + P.ib_off) + ((ui + 1) & 1) * 256; PG8_GIDX(ib, vo); } }
            PG8_WAIT_V(8); PG8_WAIT_L(0); PG8_BAR; PG8_MMA(0, 0, At, B0); PG8_MMA(0, 1, At, B1); PG8_BAR; PG8_SCHED;
            PG8_LDA(At, 0, 1); PG8_STAGE_B(PG8_SB(0, 0), b2); PG8_STAGE_B(PG8_SB(0, 1), b2 + hstepB); PG8_STAGE2(PG8_SA(0, 0), a2, vo[0][0], vo[0][1]);
            PG8_WAIT_V(8); PG8_WAIT_L(0); PG8_BAR; PG8_MMA(1, 0, At, B0); PG8_MMA(1, 1, At, B1); PG8_BAR; PG8_SCHED;
            PG8_LDB(B0, 1, 0); PG8_LDB(B1, 1, 1); PG8_SCHED; PG8_LDA(At, 1, 0); PG8_STAGE2(PG8_SA(0, 1), a2, vo[1][0], vo[1][1]);
            PG8_WAIT_V(8); PG8_WAIT_L(0); PG8_BAR; PG8_MMA(0, 0, At, B0); PG8_MMA(0, 1, At, B1); PG8_BAR; PG8_SCHED;
            PG8_LDA(At, 1, 1); PG8_STAGE_B(PG8_SB(1, 0), b3); PG8_STAGE_B(PG8_SB(1, 1), b3 + hstepB); PG8_STAGE2(PG8_SA(1, 0), a3, vo[0][0], vo[0][1]);
            PG8_WAIT_V(8); PG8_WAIT_L(0); PG8_BAR; PG8_MMA(1, 0, At, B0); PG8_MMA(1, 1, At, B1); PG8_BAR; PG8_SCHED;
        }
        if constexpr (ALIGN_EPI) { if (wr == 0) PG8_BAR; }
        E(acc, cur, wr, wc, fr, fq);
        if (!has_next) break;
#pragma unroll
        for (int a = 0; a < 2; ++a)
#pragma unroll
            for (int b = 0; b < 2; ++b)
#pragma unroll
                for (int m = 0; m < 4; ++m)
#pragma unroll
                    for (int n = 0; n < 2; ++n) acc[a][b][m][n] = (f32x4){0.f, 0.f, 0.f, 0.f};
        cur = nxt; cA = nA; cB = nB; ++ui;
        if constexpr (ALIGN_EPI) { if (wr == 1) PG8_BAR; }
    }
    PG8_WAIT_V(0);
    if constexpr (!ALIGN_EPI) { if (wr == 0) PG8_BAR; }
    PG8_BAR;
#undef PG8_AOFF
#undef PG8_BOFF
#undef PG8_GIDX
#undef PG8_SA
#undef PG8_SB
#undef PG8_STAGE2
#undef PG8_STAGE_B
#undef PG8_LDA
#undef PG8_LDB
#undef PG8_MMA
#undef PG8_WAIT_V
#undef PG8_WAIT_L
#undef PG8_BAR
#undef PG8_SCHED
}
}

constexpr int NWAVES = 8;
constexpr int BATCH = 16, SEQ = 4096, D = 1024, T = BATCH * SEQ;
constexpr int PLE = 256, SSMW = 512, POOLW = 512, NG = 32, GH = 16, NP = 64;
constexpr int LC = 32, NCH = SEQ / LC, CHROWS = BATCH * NCH;
constexpr int UEXT_LD = 640;
constexpr int NEXP = 32, TOPK = 4, NIN = 3072;
constexpr int NSLAB = 2, SLAB_T = T / NSLAB, SLAB_ROWS = (SLAB_T * TOPK / 256 + NEXP) * 256;
constexpr float LN_EPS = 1e-5f, DN_ALPHA = 1.189207115002721f, SW_LIMIT = 7.0f, SW_ALPHA = 1.702f;
constexpr int NPHASE = 16;

constexpr size_t MiB = 1u << 20;
constexpr size_t WS_WGU = 0 * MiB;
constexpr size_t WS_WDN = 128 * MiB;
constexpr size_t WS_WIN = 192 * MiB;
constexpr size_t WS_WGLU = 198 * MiB;
constexpr size_t WS_WPOOL = 200 * MiB;
constexpr size_t WS_WOUT = 201 * MiB;
constexpr size_t WS_WPLE = 203 * MiB;
constexpr size_t WS_WPP = 206 * MiB;
constexpr size_t WS_WS = 207 * MiB;
constexpr size_t WS_TV = 215 * MiB;
constexpr size_t WS_CTL = 235 * MiB;
constexpr size_t WS_TOPE = 236 * MiB;
constexpr size_t WS_TOPW = 237 * MiB;
constexpr size_t WS_ROWTOK = 238 * MiB;
constexpr size_t WS_ROWSLOT = 240 * MiB;
constexpr size_t WS_CNT = 242 * MiB;
constexpr size_t WS_XB = 244 * MiB;
constexpr size_t WS_H1 = 244 * MiB;
constexpr size_t WS_UEXT = 372 * MiB;
constexpr size_t WS_UPOOL = 452 * MiB;
constexpr size_t WS_PP = 372 * MiB;
constexpr size_t WS_GA = 516 * MiB;
constexpr size_t WS_GB = 644 * MiB;
constexpr size_t WS_POOLED = 772 * MiB;
constexpr size_t WS_S = 836 * MiB;
constexpr size_t WS_Z = 868 * MiB;
constexpr size_t WS_PB = 932 * MiB;
constexpr size_t WS_ACT = 372 * MiB;
constexpr size_t WS_Y = 644 * MiB;
constexpr size_t WS_END = 964 * MiB;
static_assert(WS_ACT + (size_t)SLAB_ROWS * 2048 <= WS_Y && WS_Y + (size_t)SLAB_T * 4 * 2048 <= WS_END && WS_PB + (size_t)T * PLE * 2 <= WS_END, "ws map");
constexpr size_t CTL_ZERO_BYTES = 1 * MiB;
constexpr int CW_BAR = 4096;

constexpr int RING_BYTES = 131072;
constexpr int LDSCTL_OFF = RING_BYTES, MISC_OFF = LDSCTL_OFF + 320;
constexpr int TP_OFF = LDSCTL_OFF + 1024, IB_OFF = TP_OFF + 512, PTAB_OFF = IB_OFF + 2048;
constexpr int LDS_BYTES = 147456;

#define GAS __attribute__((address_space(1)))
#define LAS __attribute__((address_space(3)))
typedef unsigned short bf16;
typedef unsigned v4u __attribute__((ext_vector_type(4)));
typedef unsigned v2u __attribute__((ext_vector_type(2)));
typedef float f32x4 __attribute__((ext_vector_type(4)));
typedef GAS unsigned gu32;
#define RLX_AGENT __ATOMIC_RELAXED, __HIP_MEMORY_SCOPE_AGENT
#define LDS_WAIT() asm volatile("s_waitcnt lgkmcnt(0)" ::: "memory")
#define VM_WAIT() asm volatile("s_waitcnt vmcnt(0)" ::: "memory")
__device__ __forceinline__ unsigned f2bf(float f) { unsigned u = __builtin_bit_cast(unsigned, f); return (u + 0x7fffu + ((u >> 16) & 1u)) >> 16; }
__device__ __forceinline__ unsigned pk2(float lo, float hi) { return f2bf(lo) | (f2bf(hi) << 16); }
__device__ __forceinline__ float bf2f(unsigned short b) { return __uint_as_float(((unsigned)b) << 16); }

#define XB_TMO      128
#define XB_XCNT(j)  (256  + 64 * (j))
#define XB_XSUB(j)  (1280 + 64 * (j))
#define XB_XGEN(j)  (2304 + 64 * (j))
#define XB_TOP      3328
#define XB_TOPGEN   3392
#define XCD_BAR_WORDS 3456
#define XB_SPIN_CAP (1u << 18)

__device__ __forceinline__ unsigned xb_ld(unsigned* p)              { return __hip_atomic_load(p, __ATOMIC_RELAXED, __HIP_MEMORY_SCOPE_AGENT); }
__device__ __forceinline__ unsigned xb_add(unsigned* p, unsigned v) { return __hip_atomic_fetch_add(p, v, __ATOMIC_RELAXED, __HIP_MEMORY_SCOPE_AGENT); }
__device__ __forceinline__ unsigned xb_xcc_id() { return (unsigned)__builtin_amdgcn_s_getreg((3 << 11) | 20) & 0xFu; }
#define XB_SPIN(cond, bar) do { unsigned _sp = 0; while (cond) { __builtin_amdgcn_s_sleep(1); \
    if ((++_sp & 255u) == 0u) { if (xb_ld(&(bar)[XB_TMO])) break; if (_sp > XB_SPIN_CAP) { atomicAdd(&(bar)[XB_TMO], 1u); break; } } } } while (0)

struct XcdBarrier {
    unsigned* bar; unsigned x;
    volatile LAS unsigned* st;
};

__device__ __forceinline__ XcdBarrier xcd_barrier_post(unsigned* bar, volatile LAS unsigned* st) {
    XcdBarrier b; b.bar = bar; b.x = xb_xcc_id(); b.st = st;
    if (threadIdx.x == 0) (void)xb_add(&bar[XB_XCNT(b.x)], 1u);
    return b;
}
__device__ __forceinline__ void xcd_barrier_complete(unsigned* bar, unsigned x, unsigned& nloc, unsigned& nx) {
    const unsigned G = gridDim.x * gridDim.y * gridDim.z;
    unsigned sum, cnt, mine, sp = 0u;
    for (;;) {
        sum = 0u; cnt = 0u; mine = 0u;
#pragma unroll
        for (unsigned j = 0; j < 16; ++j) { const unsigned c = xb_ld(&bar[XB_XCNT(j)]); sum += c; cnt += (c > 0u) ? 1u : 0u; mine = (j == x) ? c : mine; }
        if (sum == G) break;
        __builtin_amdgcn_s_sleep(1);
        if ((++sp & 255u) == 0u) { if (xb_ld(&bar[XB_TMO])) break; if (sp > XB_SPIN_CAP) { atomicAdd(&bar[XB_TMO], 1u); break; } }
    }
    nloc = mine > 0u ? mine : 1u; nx = cnt > 0u ? cnt : 1u;
}

__device__ __forceinline__ void xcd_barrier(const XcdBarrier& b) {
    asm volatile("s_waitcnt vmcnt(0)" ::: "memory");
    __syncthreads();
    if (threadIdx.x == 0) {
        unsigned* bar = b.bar;
        __builtin_amdgcn_s_waitcnt(0);
        unsigned nloc = b.st[0], nx = b.st[1];
        if (nloc == 0u) { xcd_barrier_complete(bar, b.x, nloc, nx); b.st[0] = nloc; b.st[1] = nx; }
        const unsigned old = xb_add(&bar[XB_XSUB(b.x)], 1u);
        const unsigned gen = old / nloc;
        if (old + 1u == (gen + 1u) * nloc) {
            __builtin_amdgcn_fence(__ATOMIC_RELEASE, "agent");
            asm volatile("s_waitcnt vmcnt(0)" ::: "memory");
            const unsigned og = xb_add(&bar[XB_TOP], 1u);
            const unsigned tg = og / nx;
            if (og + 1u == (tg + 1u) * nx) xb_add(&bar[XB_TOPGEN], 1u);
            else XB_SPIN(xb_ld(&bar[XB_TOPGEN]) == tg, bar);
            __builtin_amdgcn_fence(__ATOMIC_ACQUIRE, "agent");
            xb_add(&bar[XB_XGEN(b.x)], 1u);
            asm volatile("s_waitcnt vmcnt(0)" ::: "memory");
        } else {
            XB_SPIN(xb_ld(&bar[XB_XGEN(b.x)]) == gen, bar);
            __builtin_amdgcn_fence(__ATOMIC_ACQUIRE, "agent");
            asm volatile("s_waitcnt vmcnt(0)" ::: "memory");
        }
    }
    __syncthreads();
}

namespace pg8 {
#define EPI_ROW(u, ai, m) ((u).pm * BM + (ai) * HALF + wr * 64 + (m) * 16 + fr)
#define EPI_COL8(u, bj) ((u).pn * BM + (bj) * HALF + wc * 32 + 8 * fq)
#define EPI_COL4(u, bj, n) ((u).pn * BM + (bj) * HALF + wc * 32 + 16 * (n) + 4 * fq)
__device__ __forceinline__ u32x4 pack8(const f32x4 a, const f32x4 b) { u32x4 w; w.x = cvt_pk_bf16(a[0], a[1]); w.y = cvt_pk_bf16(a[2], a[3]); w.z = cvt_pk_bf16(b[0], b[1]); w.w = cvt_pk_bf16(b[2], b[3]); return w; }
__device__ __forceinline__ void unpack8(const u32x4 w, f32x4& a, f32x4& b) { a = (f32x4){bf_lo(w.x), bf_hi(w.x), bf_lo(w.y), bf_hi(w.y)}; b = (f32x4){bf_lo(w.z), bf_hi(w.z), bf_lo(w.w), bf_hi(w.w)}; }
__device__ __forceinline__ f32x4 sig4(const f32x4 v) { return (f32x4){sigmoid_f(v[0]), sigmoid_f(v[1]), sigmoid_f(v[2]), sigmoid_f(v[3])}; }
__device__ __forceinline__ float gelu_tanh(float x) { return x * sigmoid_f(1.5957691216f * (x + 0.044715f * x * x * x)); }

struct EpiInProj {
    static constexpr bool PERM = true;
    bf16_t* uext; bf16_t* upool; bf16_t* ga; bf16_t* gb;
    __device__ __forceinline__ void operator()(const f32x4 (&acc)[2][2][4][2], const Unit& u, int wr, int wc, int fr, int fq) const {
#pragma unroll
        for (int ai = 0; ai < 2; ++ai)
#pragma unroll
            for (int m = 0; m < 4; ++m) { const int t = EPI_ROW(u, ai, m);
#pragma unroll
                for (int bj = 0; bj < 2; ++bj) { const int c = EPI_COL8(u, bj); f32x4 v0 = acc[ai][bj][m][0], v1 = acc[ai][bj][m][1]; bf16_t* dst;
                    if (u.pn < 2) { const int g = c >> 4, h0 = c & 15; dst = uext + ((size_t)g * 2048 + (size_t)(t >> 5)) * 640 + (size_t)((t & 31) * 16 + h0); }
                    else if (u.pn < 4) dst = upool + (size_t)t * 512 + (c - 512);
                    else { v0 = sig4(v0); v1 = sig4(v1); dst = (u.pn < 8) ? ga + (size_t)t * 1024 + (c - 1024) : gb + (size_t)t * 1024 + (c - 2048); }
                    *(u32x4*)dst = pack8(v0, v1); } }
    }
};
struct EpiS {
    static constexpr bool PERM = false;
    float* S;
    __device__ __forceinline__ void operator()(const f32x4 (&acc)[2][2][4][2], const Unit& u, int wr, int wc, int fr, int fq) const {
#pragma unroll
        for (int ai = 0; ai < 2; ++ai)
#pragma unroll
            for (int m = 0; m < 4; ++m) { float* rowp = S + (size_t)EPI_ROW(u, ai, m) * 128 + wc * 32 + 4 * fq;
#pragma unroll
                for (int n = 0; n < 2; ++n) *(f32x4*)(rowp + 16 * n) = acc[ai][0][m][n]; }
    }
};
template <int ACT> struct EpiBf16 {
    static constexpr bool PERM = true;
    bf16_t* O; int ldc;
    __device__ __forceinline__ void operator()(const f32x4 (&acc)[2][2][4][2], const Unit& u, int wr, int wc, int fr, int fq) const {
#pragma unroll
        for (int ai = 0; ai < 2; ++ai)
#pragma unroll
            for (int m = 0; m < 4; ++m) { bf16_t* rowp = O + (size_t)EPI_ROW(u, ai, m) * ldc;
#pragma unroll
                for (int bj = 0; bj < 2; ++bj) { f32x4 v0 = acc[ai][bj][m][0], v1 = acc[ai][bj][m][1];
                    if (ACT == 1) {
#pragma unroll
                        for (int j = 0; j < 4; ++j) { v0[j] = gelu_tanh(v0[j]); v1[j] = gelu_tanh(v1[j]); } }
                    *(u32x4*)(rowp + EPI_COL8(u, bj)) = pack8(v0, v1); } }
    }
};
struct EpiPool {
    static constexpr bool PERM = true;
    bf16_t* gb;
    __device__ __forceinline__ void operator()(const f32x4 (&acc)[2][2][4][2], const Unit& u, int wr, int wc, int fr, int fq) const {
#pragma unroll
        for (int ai = 0; ai < 2; ++ai)
#pragma unroll
            for (int m = 0; m < 4; ++m) { bf16_t* rowp = gb + (size_t)EPI_ROW(u, ai, m) * 1024;
#pragma unroll
                for (int bj = 0; bj < 2; ++bj) { u32x4* p = (u32x4*)(rowp + EPI_COL8(u, bj)); f32x4 g0, g1; unpack8(*p, g0, g1);
                    *p = pack8(g0 * acc[ai][bj][m][0], g1 * acc[ai][bj][m][1]); } }
    }
};
struct EpiGlu {
    static constexpr bool PERM = true;
    bf16_t* ga; const bf16_t* gb;
    __device__ __forceinline__ void operator()(const f32x4 (&acc)[2][2][4][2], const Unit& u, int wr, int wc, int fr, int fq) const {
#pragma unroll
        for (int ai = 0; ai < 2; ++ai)
#pragma unroll
            for (int m = 0; m < 4; ++m) { const size_t off = (size_t)EPI_ROW(u, ai, m) * 1024 + (size_t)(u.pn * HALF + wc * 32 + 8 * fq);
                u32x4* pa = (u32x4*)(ga + off); f32x4 a0, a1, t0, t1; unpack8(*pa, a0, a1); unpack8(*(const u32x4*)(gb + off), t0, t1);
                const f32x4 y0 = acc[ai][0][m][0] * sig4(acc[ai][1][m][0]), y1 = acc[ai][0][m][1] * sig4(acc[ai][1][m][1]);
                *pa = pack8(a0 * y0 + t0, a1 * y1 + t1); }
    }
};
struct EpiWout {
    static constexpr bool PERM = false;
    const float* x; float* s;
    __device__ __forceinline__ void operator()(const f32x4 (&acc)[2][2][4][2], const Unit& u, int wr, int wc, int fr, int fq) const {
#pragma unroll
        for (int ai = 0; ai < 2; ++ai)
#pragma unroll
            for (int m = 0; m < 4; ++m) { const size_t ro = (size_t)EPI_ROW(u, ai, m) * 1024;
#pragma unroll
                for (int bj = 0; bj < 2; ++bj)
#pragma unroll
                    for (int n = 0; n < 2; ++n) { const size_t o = ro + EPI_COL4(u, bj, n); *(f32x4*)(s + o) = *(const f32x4*)(x + o) * DN_ALPHA_C + acc[ai][bj][m][n]; }
                if (m & 1) asm volatile("" ::: "memory"); }
    }
    static constexpr float DN_ALPHA_C = 1.189207115002721f;
};
struct EpiPle {
    static constexpr bool PERM = false;
    const bf16_t* h1; const bf16_t* pp; float* base; const float* brouter; int* tope; float* topw;
    __device__ __forceinline__ void operator()(const f32x4 (&acc)[2][2][4][2], const Unit& u, int wr, int wc, int fr, int fq) const {
        if (u.pn < 4) {
#pragma unroll
            for (int ai = 0; ai < 2; ++ai)
#pragma unroll
                for (int m = 0; m < 4; ++m) { const size_t ro = (size_t)EPI_ROW(u, ai, m) * 1024;
#pragma unroll
                    for (int bj = 0; bj < 2; ++bj)
#pragma unroll
                        for (int n = 0; n < 2; ++n) { const size_t o = ro + EPI_COL4(u, bj, n); const u32x2 hw = *(const u32x2*)(h1 + o), pw = *(const u32x2*)(pp + o);
                            const f32x4 hv = (f32x4){bf_lo(hw.x), bf_hi(hw.x), bf_lo(hw.y), bf_hi(hw.y)}, pv = (f32x4){bf_lo(pw.x), bf_hi(pw.x), bf_lo(pw.y), bf_hi(pw.y)};
                            *(f32x4*)(base + o) = hv * 1.189207115002721f + sig4(acc[ai][bj][m][n]) * pv; }
                    if (m & 1) asm volatile("" ::: "memory"); }
        } else if (wc == 0) {
            f32x4 b0 = *(const f32x4*)(brouter + 4 * fq), b1 = *(const f32x4*)(brouter + 16 + 4 * fq);
#pragma unroll
            for (int ai = 0; ai < 2; ++ai)
#pragma unroll
                for (int m = 0; m < 4; ++m) {
                    float v[8]; const f32x4 l0 = acc[ai][0][m][0] + acc[ai][1][m][0] + b0, l1 = acc[ai][0][m][1] + acc[ai][1][m][1] + b1;
#pragma unroll
                    for (int i = 0; i < 4; ++i) { v[i] = l0[i]; v[4 + i] = l1[i]; }
                    float tv[4]; int te[4];
#pragma unroll
                    for (int r = 0; r < 4; ++r) {
                        float bv = -3.0e38f; int bi = 0;
#pragma unroll
                        for (int i = 0; i < 8; ++i) { if (v[i] > bv) { bv = v[i]; bi = i; } }
                        int be = (bi < 4) ? (4 * fq + bi) : (16 + 4 * fq + (bi - 4));
                        float gv = bv; int ge = be;
#pragma unroll
                        for (int o = 16; o <= 32; o <<= 1) { const float ov = __shfl_xor(gv, o); const int oe = __shfl_xor(ge, o); if (ov > gv || (ov == gv && oe < ge)) { gv = ov; ge = oe; } }
                        tv[r] = gv; te[r] = ge;
                        if (ge == be) {
#pragma unroll
                            for (int i = 0; i < 8; ++i) if (i == bi) v[i] = -3.0e38f; }
                    }
                    if (fq == 0) { const float e1 = __expf(tv[1] - tv[0]), e2 = __expf(tv[2] - tv[0]), e3 = __expf(tv[3] - tv[0]); const float inv = 1.0f / (1.0f + e1 + e2 + e3);
                        const int t = EPI_ROW(u, ai, m);
                        *(int4*)(tope + (size_t)t * 4) = make_int4(te[0], te[1], te[2], te[3]);
                        *(float4*)(topw + (size_t)t * 4) = make_float4(inv, e1 * inv, e2 * inv, e3 * inv); }
                }
        }
    }
};
struct EpiM1 {
    static constexpr bool PERM = true;
    bf16_t* act; const float* bgate; const float* bup;
    __device__ __forceinline__ void operator()(const f32x4 (&acc)[2][2][4][2], const Unit& u, int wr, int wc, int fr, int fq) const {
        const int col = u.pn * HALF + wc * 32 + 8 * fq; const float* bg = bgate + (size_t)u.aux * 1024 + col; const float* bu = bup + (size_t)u.aux * 1024 + col;
        const f32x4 g0 = *(const f32x4*)bg, g1 = *(const f32x4*)(bg + 4), u0 = *(const f32x4*)bu, u1 = *(const f32x4*)(bu + 4);
#pragma unroll
        for (int ai = 0; ai < 2; ++ai)
#pragma unroll
            for (int m = 0; m < 4; ++m) { f32x4 o[2];
#pragma unroll
                for (int n = 0; n < 2; ++n) { const f32x4 gg = acc[ai][0][m][n] + (n ? g1 : g0), uu = acc[ai][1][m][n] + (n ? u1 : u0);
#pragma unroll
                    for (int j = 0; j < 4; ++j) { const float g = fminf(gg[j], 7.0f), up = fminf(fmaxf(uu[j], -7.0f), 7.0f); o[n][j] = (up + 1.0f) * (g * sigmoid_f(1.702f * g)); } }
                *(u32x4*)(act + (size_t)EPI_ROW(u, ai, m) * 1024 + col) = pack8(o[0], o[1]); }
    }
};
struct EpiM2 {
    static constexpr bool PERM = true;
    bf16_t* y; const float* bdown; const int* rowslot;
    __device__ __forceinline__ void operator()(const f32x4 (&acc)[2][2][4][2], const Unit& u, int wr, int wc, int fr, int fq) const {
        f32x4 b[2][2];
#pragma unroll
        for (int bj = 0; bj < 2; ++bj) { const float* bp = bdown + (size_t)u.aux * 1024 + EPI_COL8(u, bj); b[bj][0] = *(const f32x4*)bp; b[bj][1] = *(const f32x4*)(bp + 4); }
#pragma unroll
        for (int ai = 0; ai < 2; ++ai)
#pragma unroll
            for (int m = 0; m < 4; ++m) { const int slot = rowslot[EPI_ROW(u, ai, m)];
                if (slot >= 0) { bf16_t* rowp = y + (size_t)slot * 1024;
#pragma unroll
                    for (int bj = 0; bj < 2; ++bj) *(u32x4*)(rowp + EPI_COL8(u, bj)) = pack8(acc[ai][bj][m][0] + b[bj][0], acc[ai][bj][m][1] + b[bj][1]); } }
    }
};
#undef EPI_ROW
#undef EPI_COL8
#undef EPI_COL4
}

struct Args { const float* in[31]; float* out; unsigned char* ws; int ph_lo, ph_hi, li, pad; };
struct Ctx { LAS unsigned char* lds; int tid, lane, wave, vcu, G, gw, ngw; };
struct PT { const LAS unsigned long long* t;
    __device__ __forceinline__ unsigned long long get(int k) const { const unsigned long long v = t[k]; const unsigned lo = __builtin_amdgcn_readfirstlane((unsigned)v), hi = __builtin_amdgcn_readfirstlane((unsigned)(v >> 32)); return ((unsigned long long)hi << 32) | lo; }
    __device__ __forceinline__ const float* in(int k) const { return (const float*)get(k); }
    __device__ __forceinline__ float* out() const { return (float*)get(31); }
    __device__ __forceinline__ unsigned char* ws() const { return (unsigned char*)get(32); } };

__device__ __forceinline__ float wave_sum(float v) {
#pragma unroll
    for (int o = 1; o < 64; o <<= 1) v += __shfl_xor(v, o);
    return v;
}
__device__ __forceinline__ void p0_transpose_item(const float* W, int K, int N, bf16* WT, int dst_row0, LAS float* scr, int kb, int nb, int lane) {
    const int k0 = 64 * kb, n0 = 32 * nb;
#pragma unroll 8
    for (int i = 0; i < 32; ++i) { const int kk = 2 * i + (lane >> 5); scr[kk * 33 + (lane & 31)] = W[(size_t)(k0 + kk) * N + n0 + (lane & 31)]; }
    LDS_WAIT(); asm volatile("" ::: "memory");
    const int c = lane & 7;
#pragma unroll
    for (int j = 0; j < 4; ++j) { const int n = (lane >> 3) + 8 * j; const LAS float* s = scr + (8 * c) * 33 + n;
        v4u o; o.x = pk2(s[0 * 33], s[1 * 33]); o.y = pk2(s[2 * 33], s[3 * 33]); o.z = pk2(s[4 * 33], s[5 * 33]); o.w = pk2(s[6 * 33], s[7 * 33]);
        *(v4u*)(WT + (size_t)(dst_row0 + n) * K + k0 + 8 * c) = o; }
    LDS_WAIT(); asm volatile("" ::: "memory");
}
__device__ __forceinline__ void cvt_row1024(const float* src, bf16* dst, int lane) {
    const f32x4* s = (const f32x4*)src + lane; f32x4 v[4];
#pragma unroll
    for (int j = 0; j < 4; ++j) v[j] = s[64 * j];
    v2u* o = (v2u*)dst + lane;
#pragma unroll
    for (int j = 0; j < 4; ++j) { v2u w; w.x = pk2(v[j].x, v[j].y); w.y = pk2(v[j].z, v[j].w); o[64 * j] = w; }
}
struct cplx { float re, im; };
__device__ __forceinline__ cplx cmul(cplx a, cplx b) { return cplx{a.re * b.re - a.im * b.im, a.re * b.im + a.im * b.re}; }
__device__ __forceinline__ cplx lam_pow(float lre, float lim, float step, float tau) { const float m = __expf(lre * step * tau); float s, c; sincosf(lim * step * tau, &s, &c); return cplx{m * c, m * s}; }
__device__ __forceinline__ cplx bbar_fac(float lre, float lim, float step) { const cplx lb = lam_pow(lre, lim, step, 1.0f); const float nr = lb.re - 1.0f, ni = lb.im, d = 1.0f / (lre * lre + lim * lim);
    return cplx{(nr * lre + ni * lim) * d, (ni * lre - nr * lim) * d}; }

__device__ __forceinline__ void phase_prologue(const PT a, const Ctx& c) {
    unsigned char* ws = a.ws();
    LAS float* scr = (LAS float*)(c.lds + c.wave * 16384);
    const float *w_in = a.in(2), *lre = a.in(3), *lim = a.in(4), *lstep = a.in(5), *bre = a.in(6), *bim = a.in(7), *cre = a.in(8), *cim = a.in(9), *dsk = a.in(10);
    const float *wval = a.in(11), *wgt = a.in(12), *wgrp = a.in(13), *pscale = a.in(14), *wpp = a.in(15), *wout = a.in(16), *wrt = a.in(19);
    const float *wgate = a.in(21), *wup = a.in(23), *wdown = a.in(25), *wpleg = a.in(27), *wplep = a.in(28);
    constexpr int I_IN = 16 * 96, I_GL = 8 * 32, I_SQ = 16 * 32, I_PP = 4 * 32, I_E = 32 * I_SQ;
    constexpr int NITEMS = I_IN + 2 * I_GL + 2 * I_SQ + I_PP + 3 * I_E;
    for (int it = c.gw; it < NITEMS; it += c.ngw) {
        int r = it;
        if (r < I_IN) { p0_transpose_item(w_in, 1024, 3072, (bf16*)(ws + WS_WIN), 32 * (r % 96), scr, r / 96, r % 96, c.lane); continue; } r -= I_IN;
        if (r < 2 * I_GL) { const int which = r / I_GL, q = r % I_GL, nb = q % 32, n0 = 32 * nb;
            p0_transpose_item(which ? wgt : wval, 512, 1024, (bf16*)(ws + WS_WGLU), (n0 >> 7) * 256 + (n0 & 127) + which * 128, scr, q / 32, nb, c.lane); continue; } r -= 2 * I_GL;
        if (r < I_SQ) { p0_transpose_item(wout, 1024, 1024, (bf16*)(ws + WS_WOUT), 32 * (r % 32), scr, r / 32, r % 32, c.lane); continue; } r -= I_SQ;
        if (r < I_SQ) { p0_transpose_item(wpleg, 1024, 1024, (bf16*)(ws + WS_WPLE), 32 * (r % 32), scr, r / 32, r % 32, c.lane); continue; } r -= I_SQ;
        if (r < I_PP) { p0_transpose_item(wplep, 256, 1024, (bf16*)(ws + WS_WPP), 32 * (r % 32), scr, r / 32, r % 32, c.lane); continue; } r -= I_PP;
        if (r < 2 * I_E) { const int which = r / I_E, q = r % I_E, e = q / I_SQ, qq = q % I_SQ, nb = qq % 32, n0 = 32 * nb;
            p0_transpose_item((which ? wup : wgate) + (size_t)e * 1048576, 1024, 1024, (bf16*)(ws + WS_WGU) + (size_t)e * 2048 * 1024, (n0 >> 7) * 256 + (n0 & 127) + which * 128, scr, qq / 32, nb, c.lane); continue; } r -= 2 * I_E;
        { const int e = r / I_SQ, qq = r % I_SQ; p0_transpose_item(wdown + (size_t)e * 1048576, 1024, 1024, (bf16*)(ws + WS_WDN) + (size_t)e * 1048576, 32 * (qq % 32), scr, qq / 32, qq % 32, c.lane); }
    }
    for (int m = c.gw; m < T; m += c.ngw) cvt_row1024(a.in(0) + (size_t)m * 1024, (bf16*)(ws + WS_XB) + (size_t)m * 1024, c.lane);
    for (int m = c.gw; m < T / 4; m += c.ngw) cvt_row1024(a.in(1) + (size_t)m * 1024, (bf16*)(ws + WS_PB) + (size_t)m * 1024, c.lane);
    { bf16* W = (bf16*)(ws + WS_WPLE) + (size_t)1024 * 1024;
      for (int ch = c.gw * 64 + c.lane; ch < 256 * 128; ch += c.ngw * 64) { const int r = ch >> 7, k0 = (ch & 127) * 8; unsigned o[4] = {0u, 0u, 0u, 0u};
          if (r < 32 || (r >= 128 && r < 160)) { const int e = r & 31; float f[8];
#pragma unroll
              for (int j = 0; j < 8; ++j) { const float w = wrt[(size_t)(k0 + j) * 32 + e]; const float hi = bf2f((unsigned short)f2bf(w)); f[j] = (r < 32) ? hi : (w - hi); }
#pragma unroll
              for (int j = 0; j < 4; ++j) o[j] = pk2(f[2 * j], f[2 * j + 1]); }
          *(v4u*)(W + (size_t)r * 1024 + k0) = (v4u){o[0], o[1], o[2], o[3]}; } }
    for (int it = c.gw; it < 64 * 16; it += c.ngw) { const int c0 = (it >> 4) * 8, d = (it & 15) * 64 + c.lane, g = c0 >> 7; float s[8];
#pragma unroll
        for (int i = 0; i < 8; ++i) s[i] = 0.f;
        for (int j = 0; j < 128; ++j) { const float pw = pscale[g * 128 + j] * wpp[(size_t)(g * 128 + j) * 1024 + d];
#pragma unroll
            for (int i = 0; i < 8; ++i) s[i] += wgrp[(size_t)(g * 128 + (c0 & 127) + i) * 128 + j] * pw; }
        *(v4u*)((bf16*)(ws + WS_WPOOL) + (size_t)d * 512 + c0) = (v4u){pk2(s[0], s[1]), pk2(s[2], s[3]), pk2(s[4], s[5]), pk2(s[6], s[7])}; }
    { bf16* TV = (bf16*)(ws + WS_TV);
      for (int it = c.gw; it < 128; it += c.ngw) { const int id = it * 64 + c.lane, g = id >> 8, h = (id >> 4) & 15, hp = id & 15; const float step = __expf(lstep[g]);
          float Kt[32];
#pragma unroll
          for (int tt = 0; tt < 32; ++tt) Kt[tt] = 0.f;
          for (int p = 0; p < 64; ++p) { const float lr = lre[g * 64 + p], li = lim[g * 64 + p]; const cplx lb = lam_pow(lr, li, step, 1.0f), bf = bbar_fac(lr, li, step);
              const cplx bb = cmul(bf, cplx{bre[(size_t)(g * 64 + p) * 16 + hp], bim[(size_t)(g * 64 + p) * 16 + hp]});
              cplx w = cmul(cplx{cre[(size_t)(g * 16 + h) * 64 + p], cim[(size_t)(g * 16 + h) * 64 + p]}, bb);
#pragma unroll
              for (int tt = 0; tt < 32; ++tt) { Kt[tt] += w.re; w = cmul(w, lb); } }
          if (h == hp) Kt[0] += dsk[g * 16 + h];
#pragma unroll
          for (int tt = 0; tt < 32; ++tt) { const bf16 v = (bf16)f2bf(Kt[tt]);
              for (int s = 0; s + tt < 32; ++s) TV[((size_t)g * 512 + (size_t)(s + tt) * 16 + h) * 640 + s * 16 + hp] = v; } }
      for (int it = c.gw; it < 32 * 512; it += c.ngw) { const int g = it >> 9, n = it & 511, j = n >> 4, h = n & 15; bf16* row = TV + (size_t)it * 640;
          if (c.lane * 8 >= (j + 1) * 16) *(v4u*)(row + c.lane * 8) = (v4u){0u, 0u, 0u, 0u};
          const int p = c.lane; const float step = __expf(lstep[g]); const cplx lp = lam_pow(lre[g * 64 + p], lim[g * 64 + p], step, (float)(j + 1));
          const cplx mv = cmul(cplx{cre[(size_t)(g * 16 + h) * 64 + p], cim[(size_t)(g * 16 + h) * 64 + p]}, lp);
          row[512 + p] = (bf16)f2bf(mv.re); row[576 + p] = (bf16)f2bf(-mv.im); }
      bf16* WS = (bf16*)(ws + WS_WS);
      for (int it = c.gw; it < 32 * 256; it += c.ngw) { const int g = it >> 8, n = it & 255; v4u o = (v4u){0u, 0u, 0u, 0u};
          if (n < 128) { const int p = n & 63, s = c.lane >> 1, h0 = (c.lane & 1) * 8; const float step = __expf(lstep[g]), lr = lre[g * 64 + p], li = lim[g * 64 + p];
              const cplx f = cmul(lam_pow(lr, li, step, (float)(31 - s)), bbar_fac(lr, li, step)); float v[8];
#pragma unroll
              for (int i = 0; i < 8; ++i) { const cplx r = cmul(f, cplx{bre[(size_t)(g * 64 + p) * 16 + h0 + i], bim[(size_t)(g * 64 + p) * 16 + h0 + i]}); v[i] = (n < 64) ? r.re : r.im; }
              o = (v4u){pk2(v[0], v[1]), pk2(v[2], v[3]), pk2(v[4], v[5]), pk2(v[6], v[7])}; }
          *(v4u*)(WS + (size_t)it * 512 + c.lane * 8) = o; } }
}

__device__ __forceinline__ void phase_pooling(const PT a, const Ctx& c) {
    const bf16* up = (const bf16*)(a.ws() + WS_UPOOL); bf16* po = (bf16*)(a.ws() + WS_POOLED);
    const int w = 2 << (c.lane >> 4);
    for (int t = c.gw; t < T; t += c.ngw) { const int pos = t & (SEQ - 1); const int cnt = (pos + 1 < w) ? pos + 1 : w;
        float s[8], u0[8];
#pragma unroll
        for (int i = 0; i < 8; ++i) s[i] = 0.f;
#pragma unroll
        for (int j = 0; j < 16; ++j) { if (j < cnt) { const v4u v = *(const v4u*)(up + (size_t)(t - j) * 512 + c.lane * 8); float f[8];
                f[0] = pg8::bf_lo(v.x); f[1] = pg8::bf_hi(v.x); f[2] = pg8::bf_lo(v.y); f[3] = pg8::bf_hi(v.y); f[4] = pg8::bf_lo(v.z); f[5] = pg8::bf_hi(v.z); f[6] = pg8::bf_lo(v.w); f[7] = pg8::bf_hi(v.w);
#pragma unroll
                for (int i = 0; i < 8; ++i) { s[i] += f[i]; if (j == 0) u0[i] = f[i]; } } }
        const float inv = 1.0f / (float)cnt;
#pragma unroll
        for (int i = 0; i < 8; ++i) s[i] = s[i] * inv - u0[i];
        *(v4u*)(po + (size_t)t * 512 + c.lane * 8) = (v4u){pk2(s[0], s[1]), pk2(s[2], s[3]), pk2(s[4], s[5]), pk2(s[6], s[7])}; }
}

__device__ __forceinline__ void phase_scan(const PT a, const Ctx& c) {
    const float* S = (const float*)(a.ws() + WS_S); bf16* ue = (bf16*)(a.ws() + WS_UEXT);
    const float *lre = a.in(3), *lim = a.in(4), *lstep = a.in(5);
    for (int it = c.gw; it < NG * BATCH; it += c.ngw) { const int g = it >> 4, b = it & 15, p = c.lane;
        const cplx l32 = lam_pow(lre[g * 64 + p], lim[g * 64 + p], __expf(lstep[g]), 32.0f);
        const float* sp = S + ((size_t)g * 2048 + (size_t)b * 128) * 128 + p; bf16* up = ue + ((size_t)g * 2048 + (size_t)b * 128) * 640 + 512 + p;
        cplx X{0.f, 0.f};
        for (int c0 = 0; c0 < NCH; c0 += 16) { float sr[16], si[16];
#pragma unroll
            for (int j = 0; j < 16; ++j) { sr[j] = sp[(size_t)(c0 + j) * 128]; si[j] = sp[(size_t)(c0 + j) * 128 + 64]; }
#pragma unroll
            for (int j = 0; j < 16; ++j) { up[(size_t)(c0 + j) * 640] = (bf16)f2bf(X.re); up[(size_t)(c0 + j) * 640 + 64] = (bf16)f2bf(X.im);
                const cplx n = cmul(l32, X); X.re = n.re + sr[j]; X.im = n.im + si[j]; } } }
}

__device__ __forceinline__ void phase_ln1(const PT a, const Ctx& c) {
    const float* s = a.out(); bf16* h1 = (bf16*)(a.ws() + WS_H1); const float *g1 = a.in(17), *b1 = a.in(18);
    f32x4 gv[4], bv[4];
#pragma unroll
    for (int j = 0; j < 4; ++j) { gv[j] = ((const f32x4*)g1)[c.lane + 64 * j]; bv[j] = ((const f32x4*)b1)[c.lane + 64 * j]; }
    for (int m = c.gw; m < T; m += c.ngw) { const f32x4* xr = (const f32x4*)(s + (size_t)m * 1024) + c.lane; f32x4 v[4]; float sm = 0.f;
#pragma unroll
        for (int j = 0; j < 4; ++j) { v[j] = xr[64 * j]; sm += (v[j].x + v[j].y) + (v[j].z + v[j].w); }
        const float mean = wave_sum(sm) * (1.f / 1024.f); float s2 = 0.f;
#pragma unroll
        for (int j = 0; j < 4; ++j) { v[j] = v[j] - mean; s2 += (v[j].x * v[j].x + v[j].y * v[j].y) + (v[j].z * v[j].z + v[j].w * v[j].w); }
        const float rstd = 1.f / sqrtf(wave_sum(s2) * (1.f / 1024.f) + LN_EPS);
        v2u* o = (v2u*)(h1 + (size_t)m * 1024) + c.lane;
#pragma unroll
        for (int j = 0; j < 4; ++j) { const f32x4 y = v[j] * rstd * gv[j] + bv[j]; v2u w; w.x = pk2(y.x, y.y); w.y = pk2(y.z, y.w); o[64 * j] = w; } }
}

__device__ __forceinline__ void phase_route_count(const PT a, const Ctx& c) {
    LAS int* hist = (LAS int*)c.lds; const int* tope = (const int*)(a.ws() + WS_TOPE); int* cnt = (int*)(a.ws() + WS_CNT);
    for (int w = blockIdx.x; w < 256; w += c.G) {
        if (c.tid < 32) hist[c.tid] = 0;
        __syncthreads();
        { const int slot = c.tid * 2; const int2 e2 = *(const int2*)(tope + (size_t)w * 1024 + slot); atomicAdd((int*)&hist[e2.x], 1); atomicAdd((int*)&hist[e2.y], 1); }
        __syncthreads();
        if (c.tid < 32) cnt[w * 32 + c.tid] = hist[c.tid];
        __syncthreads();
    }
}
__device__ __forceinline__ void phase_route_place(const PT a, const Ctx& c) {
    LAS int* L = (LAS int*)c.lds;
    const int* tope = (const int*)(a.ws() + WS_TOPE); const int* cnt = (const int*)(a.ws() + WS_CNT); int* tpg = (int*)(a.ws() + WS_CNT + 65536);
    for (int w = blockIdx.x; w < 256; w += c.G) { const int s = w >> 7, wl = w & 127;
        int* rowtok = (int*)(a.ws() + WS_ROWTOK) + (size_t)s * SLAB_ROWS; int* rowslot = (int*)(a.ws() + WS_ROWSLOT) + (size_t)s * SLAB_ROWS;
        if (c.tid < 32) { int tot = 0, pre = 0; for (int q = 0; q < 128; ++q) { const int v = cnt[(s * 128 + q) * 32 + c.tid]; tot += v; pre += (q < wl) ? v : 0; } L[c.tid] = tot; L[32 + c.tid] = pre; L[96 + c.tid] = 0; }
        __syncthreads();
        if (c.tid == 0) { int acc = 0; for (int e = 0; e < 32; ++e) { L[128 + e] = acc; L[64 + e] = acc * 256; acc += (L[e] + 255) >> 8; } L[160] = acc;
            if (wl == 0) for (int e = 0; e <= 32; ++e) tpg[s * 64 + e] = L[128 + e]; }
        __syncthreads();
        { const int slot = c.tid * 2, tok = w * 256 + (slot >> 2); const int2 e2 = *(const int2*)(tope + (size_t)w * 1024 + slot);
#pragma unroll
          for (int q = 0; q < 2; ++q) { const int e = q ? e2.y : e2.x; const int r = atomicAdd((int*)&L[96 + e], 1); const int pos = L[64 + e] + L[32 + e] + r;
              rowtok[pos] = tok; rowslot[pos] = (tok - s * SLAB_T) * 4 + ((slot + q) & 3); } }
        if (wl < 32) { const int e = wl, tot = L[e], end = ((tot + 255) >> 8) << 8; for (int r = tot + c.tid; r < end; r += 512) { rowtok[L[64 + e] + r] = s * SLAB_T; rowslot[L[64 + e] + r] = -1; } }
        __syncthreads();
    }
}
__device__ __forceinline__ void phase_combine(const PT a, const Ctx& c, int s) {
    const bf16* y = (const bf16*)(a.ws() + WS_Y); const float* topw = (const float*)(a.ws() + WS_TOPW); float* out = a.out(); const float *g2 = a.in(29), *b2 = a.in(30);
    f32x4 gv[4], bv[4];
#pragma unroll
    for (int j = 0; j < 4; ++j) { gv[j] = ((const f32x4*)g2)[c.lane + 64 * j]; bv[j] = ((const f32x4*)b2)[c.lane + 64 * j]; }
    for (int tl = c.gw; tl < SLAB_T; tl += c.ngw) { const int t = s * SLAB_T + tl; f32x4* xr = (f32x4*)(out + (size_t)t * 1024) + c.lane; f32x4 v[4];
        const float4 wk = *(const float4*)(topw + (size_t)t * 4); const float wv[4] = {wk.x, wk.y, wk.z, wk.w};
#pragma unroll
        for (int j = 0; j < 4; ++j) v[j] = xr[64 * j];
#pragma unroll
        for (int k = 0; k < 4; ++k) { const v2u* yr = (const v2u*)(y + ((size_t)tl * 4 + k) * 1024) + c.lane;
#pragma unroll
            for (int j = 0; j < 4; ++j) { const v2u q = yr[64 * j]; v[j] = v[j] + (f32x4){pg8::bf_lo(q.x), pg8::bf_hi(q.x), pg8::bf_lo(q.y), pg8::bf_hi(q.y)} * wv[k]; } }
        float sm = 0.f;
#pragma unroll
        for (int j = 0; j < 4; ++j) sm += (v[j].x + v[j].y) + (v[j].z + v[j].w);
        const float mean = wave_sum(sm) * (1.f / 1024.f); float s2 = 0.f;
#pragma unroll
        for (int j = 0; j < 4; ++j) { v[j] = v[j] - mean; s2 += (v[j].x * v[j].x + v[j].y * v[j].y) + (v[j].z * v[j].z + v[j].w * v[j].w); }
        const float rstd = 1.f / sqrtf(wave_sum(s2) * (1.f / 1024.f) + LN_EPS);
#pragma unroll
        for (int j = 0; j < 4; ++j) xr[64 * j] = v[j] * rstd * gv[j] + bv[j]; }
}

__global__ void __launch_bounds__(NWAVES * 64, 2) mega_fwd(Args args) {
    extern __shared__ __attribute__((aligned(16))) unsigned char lds_raw[];
    Ctx c;
    c.lds = (LAS unsigned char*)lds_raw;
    c.tid = threadIdx.x; c.lane = c.tid & 63; c.wave = __builtin_amdgcn_readfirstlane(c.tid >> 6);
    c.G = gridDim.x; { const int bx = blockIdx.x; c.vcu = (c.G % 8 == 0) ? (bx % 8) * (c.G / 8) + bx / 8 : bx; }
    c.gw = c.vcu * NWAVES + c.wave; c.ngw = c.G * NWAVES;
    volatile LAS unsigned* MISC = (volatile LAS unsigned*)(c.lds + MISC_OFF);
    for (int u = c.tid; u < (LDS_BYTES - LDSCTL_OFF) / 4; u += NWAVES * 64) ((LAS unsigned*)(c.lds + LDSCTL_OFF))[u] = 0u;
    __syncthreads();
    { LAS unsigned long long* ptw = (LAS unsigned long long*)(c.lds + PTAB_OFF);
      if (c.tid < 31) ptw[c.tid] = (unsigned long long)args.in[c.tid]; else if (c.tid == 31) ptw[31] = (unsigned long long)args.out; else if (c.tid == 32) ptw[32] = (unsigned long long)args.ws; }
    __syncthreads();
    const PT pt{(const LAS unsigned long long*)(c.lds + PTAB_OFF)};
    unsigned char* ws = pt.ws();
    XcdBarrier bar; bar.bar = (unsigned*)(ws + WS_CTL) + CW_BAR + args.li * XCD_BAR_WORDS; bar.x = 0; bar.st = nullptr;
    if (!MK_PER_PHASE) bar = xcd_barrier_post((unsigned*)(ws + WS_CTL) + CW_BAR + args.li * XCD_BAR_WORDS, MISC + 8);
    const int lo = args.ph_lo, hi = args.ph_hi;
#ifndef PH_MASK
#define PH_MASK 0xFFFFFFFFu
#endif
#define IN(k) (((PH_MASK >> (k)) & 1u) && lo <= (k) && (k) < hi)
#define SEAM(k) do { if (IN(k) && IN((k) + 1)) xcd_barrier(bar); } while (0)
    LAS unsigned char* ring = c.lds;
    const int bid = (int)blockIdx.x;
    using namespace pg8;

    if (IN(0)) { phase_prologue(pt, c); }
    SEAM(0);
    if (IN(1)) {
        Prob P{(const char*)(ws + WS_XB), (const char*)(ws + WS_WIN), nullptr, 2048u, 2048u, 128u, 16, 0, 0};
        GridOrder S; S.init(T / 256, NIN / 256, c.G, bid, -1);
        EpiInProj E{(bf16_t*)(ws + WS_UEXT), (bf16_t*)(ws + WS_UPOOL), (bf16_t*)(ws + WS_GA), (bf16_t*)(ws + WS_GB)};
        gemm_phase<0, EpiInProj, GridOrder, true>(ring, P, S, E);
    }
    SEAM(1);
    if (IN(2)) {
        Prob P{(const char*)(ws + WS_UEXT), (const char*)(ws + WS_WS), nullptr, (unsigned)(UEXT_LD * 2), 1024u, 128u, 8, 256, 0};
        GridOrder S; S.init(NG * CHROWS / 256, 1, c.G, bid, 3);
        EpiS E{(float*)(ws + WS_S)};
        gemm_phase<0, EpiS, GridOrder, true>(ring, P, S, E);
        phase_pooling(pt, c);
    }
    SEAM(2);
    if (IN(3)) {
        phase_scan(pt, c);
        Prob P{(const char*)(ws + WS_POOLED), (const char*)(ws + WS_WPOOL), nullptr, 1024u, 1024u, 128u, 8, 0, 0};
        GridOrder S; S.init(T / 256, 4, c.G, bid, -1);
        EpiPool E{(bf16_t*)(ws + WS_GB)};
        gemm_phase<0, EpiPool, GridOrder, true>(ring, P, S, E);
    }
    SEAM(3);
    if (IN(4)) {
        Prob P{(const char*)(ws + WS_UEXT), (const char*)(ws + WS_TV), nullptr, (unsigned)(UEXT_LD * 2), (unsigned)(UEXT_LD * 2), 128u, 10, 512, 0};
        GridOrder S; S.init(NG * CHROWS / 256, 2, c.G, bid, 3);
        EpiBf16<1> E{(bf16_t*)(ws + WS_Z), 512};
        gemm_phase<0, EpiBf16<1>, GridOrder, true>(ring, P, S, E);
    }
    SEAM(4);
    if (IN(5)) {
        Prob P{(const char*)(ws + WS_Z), (const char*)(ws + WS_WGLU), nullptr, (unsigned)(2 * MiB), 1024u, (unsigned)(8 * MiB), 8, 0, 0};
        GridOrder S; S.init(T / 256, 8, c.G, bid, -1);
        EpiGlu E{(bf16_t*)(ws + WS_GA), (const bf16_t*)(ws + WS_GB)};
        gemm_phase<1, EpiGlu, GridOrder, true>(ring, P, S, E);
    }
    SEAM(5);
    if (IN(6)) {
        Prob P{(const char*)(ws + WS_GA), (const char*)(ws + WS_WOUT), nullptr, 2048u, 2048u, 128u, 16, 0, 0};
        GridOrder S; S.init(T / 256, 4, c.G, bid, -1);
        EpiWout E{pt.in(0), pt.out()};
        gemm_phase<0, EpiWout, GridOrder, true>(ring, P, S, E);
    }
    SEAM(6);
    if (IN(7)) {
        phase_ln1(pt, c);
        Prob P{(const char*)(ws + WS_PB), (const char*)(ws + WS_WPP), nullptr, 512u, 512u, 128u, 4, 0, 0};
        GridOrder S; S.init(T / 256, 4, c.G, bid, -1);
        EpiBf16<0> E{(bf16_t*)(ws + WS_PP), 1024};
        gemm_phase<0, EpiBf16<0>, GridOrder, true>(ring, P, S, E);
    }
    SEAM(7);
    if (IN(8)) {
        Prob P{(const char*)(ws + WS_H1), (const char*)(ws + WS_WPLE), nullptr, 2048u, 2048u, 128u, 16, 0, 0};
        GridOrder S; S.init(T / 256, 5, c.G, bid, -1);
        EpiPle E{(const bf16_t*)(ws + WS_H1), (const bf16_t*)(ws + WS_PP), pt.out(), pt.in(20), (int*)(ws + WS_TOPE), (float*)(ws + WS_TOPW)};
        gemm_phase<0, EpiPle, GridOrder, true>(ring, P, S, E);
    }
    SEAM(8);
    if (IN(9)) phase_route_count(pt, c);
    SEAM(9);
    if (IN(10)) phase_route_place(pt, c);
    SEAM(10);
#define MOE_SLAB(s) do { constexpr int pa = 11 + 2 * (s), pb = 12 + 2 * (s); \
        LAS int* tp = (LAS int*)(c.lds + TP_OFF); \
        if (IN(pa) || IN(pb)) { __syncthreads(); if (c.tid < 33) tp[c.tid] = ((const int*)(ws + WS_CNT + 65536))[(s) * 64 + c.tid]; __syncthreads(); } \
        if (IN(pa)) { \
            if ((s) > 0) phase_combine(pt, c, (s) - 1); \
            Prob P{(const char*)(ws + WS_H1), (const char*)(ws + WS_WGU), (const int*)(ws + WS_ROWTOK) + (size_t)(s) * SLAB_ROWS, 2048u, 2048u, 128u, 16, 2048, IB_OFF}; \
            MoeOrder S; S.init((const PG8_LAS int*)tp, 8, c.G, bid); \
            EpiM1 E{(bf16_t*)(ws + WS_ACT), pt.in(22), pt.in(24)}; \
            gemm_phase<2, EpiM1, MoeOrder, true>(ring, P, S, E); \
        } \
        SEAM(pa); \
        if (IN(pb)) { \
            Prob P{(const char*)(ws + WS_ACT), (const char*)(ws + WS_WDN), nullptr, 2048u, 2048u, 128u, 16, 1024, 0}; \
            MoeOrder S; S.init((const PG8_LAS int*)tp, 4, c.G, bid); \
            EpiM2 E{(bf16_t*)(ws + WS_Y), pt.in(26), (const int*)(ws + WS_ROWSLOT) + (size_t)(s) * SLAB_ROWS}; \
            gemm_phase<0, EpiM2, MoeOrder, true>(ring, P, S, E); \
        } \
        SEAM(pb); } while (0)
    MOE_SLAB(0);
    MOE_SLAB(1);
#undef MOE_SLAB
    if (IN(15)) phase_combine(pt, c, NSLAB - 1);
#undef IN
#undef SEAM
}

extern "C" void kernel_launch(void* const* d_in, const int* in_sizes, int n_in, void* d_out, int out_size, void* d_ws, size_t ws_size, hipStream_t stream) {
    static int grid = 0;
    if (grid == 0) {
        if (n_in != 31 || in_sizes[0] != T * D || out_size != T * D || ws_size < WS_END) { fprintf(stderr, "kernel_launch: unexpected problem (n_in %d, in0 %d, out %d, ws %zu); nothing launched\n", n_in, n_in > 0 ? in_sizes[0] : -1, out_size, ws_size); grid = -1; return; }
        int dev = 0, cus = 0, per_cu = 0;
        if (hipGetDevice(&dev) != hipSuccess || hipDeviceGetAttribute(&cus, hipDeviceAttributeMultiprocessorCount, dev) != hipSuccess) { grid = -1; return; }
        if (hipFuncSetAttribute((const void*)mega_fwd, hipFuncAttributeMaxDynamicSharedMemorySize, LDS_BYTES) != hipSuccess) { fprintf(stderr, "kernel_launch: hipFuncSetAttribute failed\n"); grid = -1; return; }
        if (hipOccupancyMaxActiveBlocksPerMultiprocessor(&per_cu, (const void*)mega_fwd, NWAVES * 64, LDS_BYTES) != hipSuccess || per_cu < 1) { fprintf(stderr, "kernel_launch: occupancy query reports %d workgroups per CU\n", per_cu); }
        (void)hipGetLastError();
        grid = cus;
    }
    if (grid < 0) return;
    if (hipMemsetAsync((char*)d_ws + WS_CTL, 0, CTL_ZERO_BYTES, stream) != hipSuccess) return;
    Args a{};
    for (int i = 0; i < 31; ++i) a.in[i] = (const float*)d_in[i];
    a.out = (float*)d_out; a.ws = (unsigned char*)d_ws; a.pad = 0;
#if MK_PER_PHASE
    for (int ph = 0; ph < NPHASE; ++ph) { a.ph_lo = ph; a.ph_hi = ph + 1; a.li = 0; hipLaunchKernelGGL(mega_fwd, dim3(grid), dim3(NWAVES * 64), LDS_BYTES, stream, a); }
#else
    a.ph_lo = 0; a.ph_hi = NPHASE; a.li = 0;
    hipLaunchKernelGGL(mega_fwd, dim3(grid), dim3(NWAVES * 64), LDS_BYTES, stream, a);
#endif
}
```

```cpp
#include <hip/hip_runtime.h>
#include <cstdio>
#include <cstdint>

#ifndef SHADOW
#define SHADOW 0
#endif
#ifndef MOE_FP8
#define MOE_FP8 1
#endif
#ifndef MK_PER_PHASE
#define MK_PER_PHASE 0
#endif

namespace pg8 {
#define PG8_LAS __attribute__((address_space(3)))
typedef unsigned short bf16_t;
typedef short bf16x8 __attribute__((ext_vector_type(8)));
typedef float f32x4 __attribute__((ext_vector_type(4)));
typedef float f32x2 __attribute__((ext_vector_type(2)));
typedef unsigned u32x4 __attribute__((ext_vector_type(4)));
typedef unsigned u32x2 __attribute__((ext_vector_type(2)));
constexpr int BM = 256, BK = 64, HALF = 128, HTB = HALF * BK * 2  , STAGE_BYTES = 8 * HTB, NXCD = 8, WGM = 8;

__host__ __device__ __forceinline__ int lds_byte(int r, int c) { const int st = (r >> 4) * 2 + (c >> 5), rr = r & 15, cc = c & 31, ob = rr * 64 + cc * 2; return st * 1024 + (ob ^ (((ob >> 9) & 1) << 5)); }
__host__ __device__ __forceinline__ void stage_rc(int b, int& R, int& C) { const int st = b / 1024, sb = b % 1024, swz = sb ^ (((sb >> 9) & 1) << 5); R = (st >> 1) * 16 + swz / 64; C = (st & 1) * 32 + (swz % 64) / 2; }
__host__ __device__ __forceinline__ int perm32(int rho) { const int n = rho >> 4, i = rho & 15; return 8 * (i >> 2) + 4 * n + (i & 3); }

struct Unit { int pm, pn, aux; };

struct Prob {
    const char* A; const char* B; const int* gidx;
    unsigned lda;
    unsigned ldb;
    unsigned kstepA;
    int nt;
    int bgn;
    int ib_off;
    int wid;
};

struct GridOrder {
    int nM, nN, nwg, G, c, gshift;
    __device__ void init(int nM_, int nN_, int G_, int c_, int gshift_) { nM = nM_; nN = nN_; nwg = nM * nN; G = G_; c = c_; gshift = gshift_; }
    __device__ bool next(int i, Unit& u) const {
        const long L = (long)i * G + c; if (L >= nwg) return false;
        int wgid = (int)L; { const int q = nwg / NXCD, r = nwg % NXCD, xcd = wgid % NXCD, off = wgid / NXCD; wgid = (xcd < r ? xcd * (q + 1) : r * (q + 1) + (xcd - r) * q) + off; }
        const int nig = WGM * nN, gid = wgid / nig, fm = gid * WGM, gsz = (nM - fm) < WGM ? (nM - fm) : WGM;
        u.pm = fm + ((wgid % nig) % gsz); u.pn = (wgid % nig) / gsz; u.aux = gshift >= 0 ? (u.pm >> gshift) : 0; return true;
    }
};
struct MoeOrder {
    const PG8_LAS int* tp; int nct, total, G, c;
    __device__ void init(const PG8_LAS int* tp_, int nct_, int G_, int c_) { tp = tp_; nct = nct_; G = G_; c = c_; total = __builtin_amdgcn_readfirstlane(tp_[32]) * nct_; }
    __device__ bool next(int i, Unit& u) const {
        const long L = (long)i * G + c; if (L >= total) return false;
        int wgid = (int)L; { const int q = total / NXCD, r = total % NXCD, xcd = wgid % NXCD, off = wgid / NXCD; wgid = (xcd < r ? xcd * (q + 1) : r * (q + 1) + (xcd - r) * q) + off; }
        int ln = (int)__builtin_amdgcn_mbcnt_hi(~0u, __builtin_amdgcn_mbcnt_lo(~0u, 0u)); asm volatile("" : "+v"(ln));
        int e = __builtin_popcountll(__ballot(ln < 31 && wgid >= tp[(ln < 31 ? ln : 30) + 1] * nct)); e = __builtin_amdgcn_readfirstlane(e);
        const int t0 = __builtin_amdgcn_readfirstlane(tp[e]), nte = __builtin_amdgcn_readfirstlane(tp[e + 1]) - t0, local = wgid - t0 * nct;
        u.pn = __builtin_amdgcn_readfirstlane(local / nte); u.pm = __builtin_amdgcn_readfirstlane(t0 + local % nte); u.aux = e; return true;
    }
};

__device__ __forceinline__ unsigned cvt_pk_bf16(float lo, float hi) { unsigned r; asm volatile("v_cvt_pk_bf16_f32 %0, %1, %2" : "=v"(r) : "v"(lo), "v"(hi)); return r; }
__device__ __forceinline__ float bf_lo(unsigned w) { return __uint_as_float(w << 16); }
__device__ __forceinline__ float bf_hi(unsigned w) { return __uint_as_float(w & 0xffff0000u); }
__device__ __forceinline__ float sigmoid_f(float x) { return __builtin_amdgcn_rcpf(1.0f + __builtin_amdgcn_exp2f(-1.4426950409f * x)); }

typedef int v4i __attribute__((ext_vector_type(4)));
typedef int v8i __attribute__((ext_vector_type(8)));
template <bool FP8> __device__ __forceinline__ void stage_map(int p, int& R, int& Cb) {
    if (FP8) { R = (p >> 11) * 16 + ((p & 255) >> 4); Cb = ((p & 2047) >> 8) * 16; }
    else { int C; stage_rc(p, R, C); Cb = 2 * C; }
}
template <int AMODE, bool FP8, class Epi, class Sched, bool ALIGN_EPI>
__device__ __forceinline__ void gemm_phase(PG8_LAS unsigned char* lds, const Prob P, const Sched& S, const Epi& E) {
    const int wid = P.wid, lane = (int)__builtin_amdgcn_mbcnt_hi(~0u, __builtin_amdgcn_mbcnt_lo(~0u, 0u)), tid = wid * 64 + lane, wr = wid >> 2, wc = wid & 3, fr = lane & 15, fq = lane >> 4;
    const int nt = P.nt;
    unsigned vo[2][2], voffB[2];
#pragma unroll
    for (int i = 0; i < 2; ++i) { int R, Cb; stage_map<FP8>(tid * 16 + i * 8192, R, Cb); const int Rb = Epi::PERM ? ((R & ~31) + perm32(R & 31)) : R;
        voffB[i] = (unsigned)Rb * P.ldb + (unsigned)Cb;
#pragma unroll
        for (int h = 0; h < 2; ++h) {
            if (AMODE == 0) vo[h][i] = (unsigned)(h * HALF + R) * P.lda + (unsigned)Cb;
            else if (AMODE == 1) vo[h][i] = (unsigned)(Cb >> 5) * P.lda + (unsigned)(h * HALF + R) * 32u + (unsigned)(Cb & 31);
            else vo[h][i] = 0u; } }
    const unsigned kstepA = P.kstepA, kstepB = (unsigned)(BK * 2);
    const unsigned hstepB = (unsigned)HALF * P.ldb;
    const unsigned ldsw = (unsigned)wid * 1024u;
    const int aoff = FP8 ? (wr * 4 * 2048 + 2 * fq * 256 + fr * 16) : lds_byte(wr * 64 + fr, fq * 8), boff = FP8 ? (wc * 2 * 2048 + 2 * fq * 256 + fr * 16) : lds_byte(wc * 32 + fr, fq * 8);
    constexpr int KOFF = FP8 ? 256 : 1024;
    const int sc1 = 0x7F7F7F7F;
#define PG8_AOFF(u) ((unsigned)(AMODE == 0 ? (unsigned)(u).pm * BM * P.lda : (AMODE == 1 ? (unsigned)(u).pm * BM * 32u : 0u)))
#define PG8_BOFF(u) ((unsigned)(((unsigned)(u).aux * P.bgn + (unsigned)(u).pn * BM) * P.ldb))
#define PG8_GIDX(src, dst) do { _Pragma("unroll") for (int _i = 0; _i < 2; ++_i) { int _R, _C; stage_map<FP8>(tid * 16 + _i * 8192, _R, _C); _Pragma("unroll") for (int _h = 0; _h < 2; ++_h) \
        dst[_h][_i] = (unsigned)(src)[_h * HALF + _R] * P.lda + (unsigned)_C; } } while (0)
#define PG8_SA(b, h) (((b) * 2 + (h)) * HTB)
#define PG8_SB(b, h) ((4 + (b) * 2 + (h)) * HTB)
    const __amdgpu_buffer_rsrc_t rsA = __builtin_amdgcn_make_buffer_rsrc((void*)P.A, 0, 0xFFFFFFFF, 0x00020000);
    const __amdgpu_buffer_rsrc_t rsB = __builtin_amdgcn_make_buffer_rsrc((void*)P.B, 0, 0xFFFFFFFF, 0x00020000);
#define PG8_STAGE2(bufoff, rs, so, v0, v1) do { \
        __builtin_amdgcn_raw_ptr_buffer_load_lds(rs, (PG8_LAS void*)(lds + (bufoff) + ldsw), 16, (int)(v0), (int)(so), 0, 0); \
        __builtin_amdgcn_raw_ptr_buffer_load_lds(rs, (PG8_LAS void*)(lds + (bufoff) + ldsw + 8192), 16, (int)(v1), (int)(so), 0, 0); } while (0)
#define PG8_STAGE_A(bufoff, so, h) PG8_STAGE2(bufoff, rsA, so, vo[h][0], vo[h][1])
#define PG8_STAGE_B(bufoff, so) PG8_STAGE2(bufoff, rsB, so, voffB[0], voffB[1])
#define PG8_LDA(dst, b, h) do { _Pragma("unroll") for (int m = 0; m < 4; ++m) _Pragma("unroll") for (int k = 0; k < 2; ++k) dst[m][k] = *(const PG8_LAS bf16x8*)(lds + PG8_SA(b, h) + aoff + m * 2048 + k * KOFF); } while (0)
#define PG8_LDB(dst, b, h) do { _Pragma("unroll") for (int n = 0; n < 2; ++n) _Pragma("unroll") for (int k = 0; k < 2; ++k) dst[n][k] = *(const PG8_LAS bf16x8*)(lds + PG8_SB(b, h) + boff + n * 2048 + k * KOFF); } while (0)
#define PG8_MMA(ai, bj, At, Bt) do { __builtin_amdgcn_s_setprio(1); _Pragma("unroll") for (int m = 0; m < 4; ++m) _Pragma("unroll") for (int n = 0; n < 2; ++n) { \
        if constexpr (FP8) { acc[ai][bj][m][n] = __builtin_amdgcn_mfma_scale_f32_16x16x128_f8f6f4( \
                __builtin_shufflevector(__builtin_bit_cast(v4i, Bt[n][0]), __builtin_bit_cast(v4i, Bt[n][1]), 0, 1, 2, 3, 4, 5, 6, 7), \
                __builtin_shufflevector(__builtin_bit_cast(v4i, At[m][0]), __builtin_bit_cast(v4i, At[m][1]), 0, 1, 2, 3, 4, 5, 6, 7), acc[ai][bj][m][n], 0, 0, 0, sc1, 0, sc1); } \
        else { _Pragma("unroll") for (int k = 0; k < 2; ++k) acc[ai][bj][m][n] = __builtin_amdgcn_mfma_f32_16x16x32_bf16(Bt[n][k], At[m][k], acc[ai][bj][m][n], 0, 0, 0); } } \
        __builtin_amdgcn_s_setprio(0); } while (0)
#define PG8_WAIT_V(n) asm volatile("s_waitcnt vmcnt(" #n ")" ::: "memory")
#define PG8_WAIT_L(n) asm volatile("s_waitcnt lgkmcnt(" #n ")" ::: "memory")
#define PG8_BAR __builtin_amdgcn_s_barrier()
#define PG8_SCHED __builtin_amdgcn_sched_barrier(0)
    Unit cur, nxt; int ui = 0;
    if (!S.next(0, cur)) return;
    f32x4 acc[2][2][4][2];
#pragma unroll
    for (int a = 0; a < 2; ++a)
#pragma unroll
        for (int b = 0; b < 2; ++b)
#pragma unroll
            for (int m = 0; m < 4; ++m)
#pragma unroll
                for (int n = 0; n < 2; ++n) acc[a][b][m][n] = (f32x4){0.f, 0.f, 0.f, 0.f};
    bf16x8 At[4][2], B0[2][2], B1[2][2];
    unsigned cA = PG8_AOFF(cur), cB = PG8_BOFF(cur);
    if (AMODE == 2) { const int* gi = P.gidx + cur.pm * BM; PG8_GIDX(gi, vo); }
    PG8_STAGE_B(PG8_SB(0, 0), cB); PG8_STAGE_B(PG8_SB(0, 1), cB + hstepB); PG8_STAGE_A(PG8_SA(0, 0), cA, 0); PG8_STAGE_A(PG8_SA(0, 1), cA, 1);
    if (wr == 1) PG8_BAR;
    PG8_WAIT_V(2); PG8_BAR;
    PG8_STAGE_B(PG8_SB(1, 0), cB + kstepB); PG8_STAGE_A(PG8_SA(1, 0), cA + kstepA, 0); PG8_STAGE_B(PG8_SB(1, 1), cB + hstepB + kstepB);
    PG8_WAIT_V(6); PG8_BAR;
    for (;;) {
        const bool has_next = S.next(ui + 1, nxt);
        const unsigned nA = has_next ? PG8_AOFF(nxt) : cA, nB = has_next ? PG8_BOFF(nxt) : cB;
#pragma nounroll
        for (int t = 0; t < nt; t += 2) {
            const bool last = (t == nt - 2);
            const unsigned a1 = cA + (unsigned)(t + 1) * kstepA;
            const unsigned a2 = last ? nA : cA + (unsigned)(t + 2) * kstepA, b2 = last ? nB : cB + (unsigned)(t + 2) * kstepB;
            const unsigned a3 = a2 + kstepA, b3 = b2 + kstepB;
            if (AMODE == 2) { if (t == 0 && has_next && wid < 4)
                    __builtin_amdgcn_global_load_lds((const unsigned*)(P.gidx + nxt.pm * BM + wid * 64 + lane), (PG8_LAS unsigned*)(lds + P.ib_off + (((ui + 1) & 1) * 256 + wid * 64) * 4), 4, 0, 0); }
            PG8_LDB(B0, 0, 0); PG8_LDB(B1, 0, 1); PG8_SCHED; PG8_LDA(At, 0, 0); PG8_STAGE_A(PG8_SA(1, 1), a1, 1);
            if (AMODE == 2) { if (last && has_next) { const PG8_LAS int* ib = (const PG8_LAS int*)(lds + P.ib_off) + ((ui + 1) & 1) * 256; PG8_GIDX(ib, vo); } }
            PG8_WAIT_V(8); PG8_WAIT_L(0); PG8_BAR; PG8_MMA(0, 0, At, B0); PG8_MMA(0, 1, At, B1); PG8_BAR; PG8_SCHED;
            PG8_LDA(At, 0, 1); PG8_STAGE_B(PG8_SB(0, 0), b2); PG8_STAGE_B(PG8_SB(0, 1), b2 + hstepB); PG8_STAGE_A(PG8_SA(0, 0), a2, 0);
            PG8_WAIT_V(8); PG8_WAIT_L(0); PG8_BAR; PG8_MMA(1, 0, At, B0); PG8_MMA(1, 1, At, B1); PG8_BAR; PG8_SCHED;
            PG8_LDB(B0, 1, 0); PG8_LDB(B1, 1, 1); PG8_SCHED; PG8_LDA(At, 1, 0); PG8_STAGE_A(PG8_SA(0, 1), a2, 1);
            PG8_WAIT_V(8); PG8_WAIT_L(0); PG8_BAR; PG8_MMA(0, 0, At, B0); PG8_MMA(0, 1, At, B1); PG8_BAR; PG8_SCHED;
            PG8_LDA(At, 1, 1); PG8_STAGE_B(PG8_SB(1, 0), b3); PG8_STAGE_B(PG8_SB(1, 1), b3 + hstepB); PG8_STAGE_A(PG8_SA(1, 0), a3, 0);
            PG8_WAIT_V(8); PG8_WAIT_L(0); PG8_BAR; PG8_MMA(1, 0, At, B0); PG8_MMA(1, 1, At, B1); PG8_BAR; PG8_SCHED;
        }
        if constexpr (ALIGN_EPI) { if (wr == 0) PG8_BAR; }
        { int fr2 = fr, fq2 = fq; asm volatile("" : "+v"(fr2), "+v"(fq2));
          E(acc, cur, wr, wc, fr2, fq2); }
        if (!has_next) break;
#pragma unroll
        for (int a = 0; a < 2; ++a)
#pragma unroll
            for (int b = 0; b < 2; ++b)
#pragma unroll
                for (int m = 0; m < 4; ++m)
#pragma unroll
                    for (int n = 0; n < 2; ++n) acc[a][b][m][n] = (f32x4){0.f, 0.f, 0.f, 0.f};
        cur = nxt; cA = nA; cB = nB; ++ui;
        if constexpr (ALIGN_EPI) { if (wr == 1) PG8_BAR; }
    }
    PG8_WAIT_V(0);
    if constexpr (!ALIGN_EPI) { if (wr == 0) PG8_BAR; }
    PG8_BAR;
#undef PG8_AOFF
#undef PG8_BOFF
#undef PG8_GIDX
#undef PG8_SA
#undef PG8_SB
#undef PG8_STAGE2
#undef PG8_STAGE_B
#undef PG8_STAGE_A
#undef PG8_LDA
#undef PG8_LDB
#undef PG8_MMA
#undef PG8_WAIT_V
#undef PG8_WAIT_L
#undef PG8_BAR
#undef PG8_SCHED
}
}

constexpr int NWAVES = 8;
constexpr int BATCH = 16, SEQ = 4096, D = 1024, T = BATCH * SEQ;
constexpr int PLE = 256, SSMW = 512, POOLW = 512, NG = 32, GH = 16, NP = 64;
constexpr int LC = 32, NCH = SEQ / LC, CHROWS = BATCH * NCH;
constexpr int UEXT_LD = 640;
constexpr int NEXP = 32, TOPK = 4, NIN = 3072;
constexpr int NSLAB = 2, SLAB_T = T / NSLAB, SLAB_ROWS = (SLAB_T * TOPK / 256 + NEXP) * 256;
constexpr float LN_EPS = 1e-5f, DN_ALPHA = 1.189207115002721f, SW_LIMIT = 7.0f, SW_ALPHA = 1.702f;
constexpr int NPHASE = 16;

constexpr size_t MiB = 1u << 20;
constexpr size_t WS_WGU = 0 * MiB;
constexpr size_t WS_WDN = 128 * MiB;
constexpr size_t WS_WIN = 192 * MiB;
constexpr size_t WS_WGLU = 198 * MiB;
constexpr size_t WS_WPOOL = 200 * MiB;
constexpr size_t WS_WOUT = 201 * MiB;
constexpr size_t WS_WPLE = 203 * MiB;
constexpr size_t WS_WPP = 206 * MiB;
constexpr size_t WS_WS = 207 * MiB;
constexpr size_t WS_TV = 215 * MiB;
constexpr size_t WS_CTL = 235 * MiB;
constexpr size_t WS_TOPE = 236 * MiB;
constexpr size_t WS_TOPW = 237 * MiB;
constexpr size_t WS_ROWTOK = 238 * MiB;
constexpr size_t WS_SLOTPOS = 240 * MiB;
constexpr size_t WS_CNT = 242 * MiB;
constexpr size_t WS_XB = 244 * MiB;
constexpr size_t WS_H1 = 244 * MiB;
constexpr size_t WS_UEXT = 372 * MiB;
constexpr size_t WS_UPOOL = 452 * MiB;
constexpr size_t WS_PP = 372 * MiB;
constexpr size_t WS_GA = 516 * MiB;
constexpr size_t WS_GB = 644 * MiB;
constexpr size_t WS_POOLED = 772 * MiB;
constexpr size_t WS_S = 836 * MiB;
constexpr size_t WS_Z = 868 * MiB;
constexpr size_t WS_PB = 932 * MiB;
constexpr size_t WS_ACT = 372 * MiB;
constexpr size_t WS_BASE = 580 * MiB;
constexpr size_t WS_Y = 752 * MiB;
constexpr size_t WS_H1Q = 516 * MiB;
constexpr size_t WS_END = 1024 * MiB;
static_assert(WS_BASE + (size_t)T * 2048 <= WS_Y && WS_H1Q + (size_t)T * 1024 <= WS_BASE && WS_ACT + (size_t)SLAB_ROWS * 2048 <= WS_Y && WS_Y + (size_t)SLAB_ROWS * 2048 <= WS_END && WS_PB + (size_t)T * PLE * 2 <= WS_END, "ws map");
constexpr size_t CTL_ZERO_BYTES = 1 * MiB;
constexpr int CW_BAR = 4096;

constexpr int RING_BYTES = 131072;
constexpr int LDSCTL_OFF = RING_BYTES, MISC_OFF = LDSCTL_OFF + 320;
constexpr int TP_OFF = LDSCTL_OFF + 1024, IB_OFF = TP_OFF + 512, PTAB_OFF = IB_OFF + 2048;
constexpr int LDS_BYTES = 147456;

#define GAS __attribute__((address_space(1)))
#define LAS __attribute__((address_space(3)))
typedef unsigned short bf16;
typedef unsigned v4u __attribute__((ext_vector_type(4)));
typedef unsigned v2u __attribute__((ext_vector_type(2)));
typedef float f32x4 __attribute__((ext_vector_type(4)));
typedef GAS unsigned gu32;
#define RLX_AGENT __ATOMIC_RELAXED, __HIP_MEMORY_SCOPE_AGENT
#define LDS_WAIT() asm volatile("s_waitcnt lgkmcnt(0)" ::: "memory")
#define VM_WAIT() asm volatile("s_waitcnt vmcnt(0)" ::: "memory")
__device__ __forceinline__ unsigned f2bf(float f) { unsigned u = __builtin_bit_cast(unsigned, f); return (u + 0x7fffu + ((u >> 16) & 1u)) >> 16; }
__device__ __forceinline__ unsigned pk2(float lo, float hi) { return f2bf(lo) | (f2bf(hi) << 16); }
__device__ __forceinline__ float bf2f(unsigned short b) { return __uint_as_float(((unsigned)b) << 16); }

#define XB_TMO      128
#define XB_XCNT(j)  (256  + 64 * (j))
#define XB_XSUB(j)  (1280 + 64 * (j))
#define XB_XGEN(j)  (2304 + 64 * (j))
#define XB_TOP      3328
#define XB_TOPGEN   3392
#define XCD_BAR_WORDS 3456
#define XB_SPIN_CAP (1u << 18)

__device__ __forceinline__ unsigned xb_ld(unsigned* p)              { return __hip_atomic_load(p, __ATOMIC_RELAXED, __HIP_MEMORY_SCOPE_AGENT); }
__device__ __forceinline__ unsigned xb_add(unsigned* p, unsigned v) { return __hip_atomic_fetch_add(p, v, __ATOMIC_RELAXED, __HIP_MEMORY_SCOPE_AGENT); }
__device__ __forceinline__ unsigned xb_xcc_id() { return (unsigned)__builtin_amdgcn_s_getreg((3 << 11) | 20) & 0xFu; }
#define XB_SPIN(cond, bar) do { unsigned _sp = 0; while (cond) { __builtin_amdgcn_s_sleep(1); \
    if ((++_sp & 255u) == 0u) { if (xb_ld(&(bar)[XB_TMO])) break; if (_sp > XB_SPIN_CAP) { atomicAdd(&(bar)[XB_TMO], 1u); break; } } } } while (0)

struct XcdBarrier {
    unsigned* bar; unsigned x;
    volatile LAS unsigned* st;
};

__device__ __forceinline__ XcdBarrier xcd_barrier_post(unsigned* bar, volatile LAS unsigned* st) {
    XcdBarrier b; b.bar = bar; b.x = xb_xcc_id(); b.st = st;
    if (threadIdx.x == 0) (void)xb_add(&bar[XB_XCNT(b.x)], 1u);
    return b;
}
__device__ __forceinline__ void xcd_barrier_complete(unsigned* bar, unsigned x, unsigned& nloc, unsigned& nx) {
    const unsigned G = gridDim.x * gridDim.y * gridDim.z;
    unsigned sum, cnt, mine, sp = 0u;
    for (;;) {
        sum = 0u; cnt = 0u; mine = 0u;
#pragma unroll
        for (unsigned j = 0; j < 16; ++j) { const unsigned c = xb_ld(&bar[XB_XCNT(j)]); sum += c; cnt += (c > 0u) ? 1u : 0u; mine = (j == x) ? c : mine; }
        if (sum == G) break;
        __builtin_amdgcn_s_sleep(1);
        if ((++sp & 255u) == 0u) { if (xb_ld(&bar[XB_TMO])) break; if (sp > XB_SPIN_CAP) { atomicAdd(&bar[XB_TMO], 1u); break; } }
    }
    nloc = mine > 0u ? mine : 1u; nx = cnt > 0u ? cnt : 1u;
}

__device__ __forceinline__ void xcd_barrier(const XcdBarrier& b) {
    asm volatile("s_waitcnt vmcnt(0)" ::: "memory");
    __syncthreads();
    if (threadIdx.x == 0) {
        unsigned* bar = b.bar;
        __builtin_amdgcn_s_waitcnt(0);
        unsigned nloc = b.st[0], nx = b.st[1];
        if (nloc == 0u) { xcd_barrier_complete(bar, b.x, nloc, nx); b.st[0] = nloc; b.st[1] = nx; }
        const unsigned old = xb_add(&bar[XB_XSUB(b.x)], 1u);
        const unsigned gen = old / nloc;
        if (old + 1u == (gen + 1u) * nloc) {
            __builtin_amdgcn_fence(__ATOMIC_RELEASE, "agent");
            asm volatile("s_waitcnt vmcnt(0)" ::: "memory");
            const unsigned og = xb_add(&bar[XB_TOP], 1u);
            const unsigned tg = og / nx;
            if (og + 1u == (tg + 1u) * nx) xb_add(&bar[XB_TOPGEN], 1u);
            else XB_SPIN(xb_ld(&bar[XB_TOPGEN]) == tg, bar);
            __builtin_amdgcn_fence(__ATOMIC_ACQUIRE, "agent");
            xb_add(&bar[XB_XGEN(b.x)], 1u);
            asm volatile("s_waitcnt vmcnt(0)" ::: "memory");
        } else {
            XB_SPIN(xb_ld(&bar[XB_XGEN(b.x)]) == gen, bar);
            __builtin_amdgcn_fence(__ATOMIC_ACQUIRE, "agent");
            asm volatile("s_waitcnt vmcnt(0)" ::: "memory");
        }
    }
    __syncthreads();
}

namespace pg8 {
#define EPI_ROW(u, ai, m) ((u).pm * BM + (ai) * HALF + wr * 64 + (m) * 16 + fr)
#define EPI_COL8(u, bj) ((u).pn * BM + (bj) * HALF + wc * 32 + 8 * fq)
#define EPI_COL4(u, bj, n) ((u).pn * BM + (bj) * HALF + wc * 32 + 16 * (n) + 4 * fq)
__device__ __forceinline__ u32x4 pack8(const f32x4 a, const f32x4 b) { u32x4 w; w.x = cvt_pk_bf16(a[0], a[1]); w.y = cvt_pk_bf16(a[2], a[3]); w.z = cvt_pk_bf16(b[0], b[1]); w.w = cvt_pk_bf16(b[2], b[3]); return w; }
__device__ __forceinline__ void unpack8(const u32x4 w, f32x4& a, f32x4& b) { a = (f32x4){bf_lo(w.x), bf_hi(w.x), bf_lo(w.y), bf_hi(w.y)}; b = (f32x4){bf_lo(w.z), bf_hi(w.z), bf_lo(w.w), bf_hi(w.w)}; }
__device__ __forceinline__ f32x4 sig4(const f32x4 v) { return (f32x4){sigmoid_f(v[0]), sigmoid_f(v[1]), sigmoid_f(v[2]), sigmoid_f(v[3])}; }
__device__ __forceinline__ float gelu_tanh(float x) { return x * sigmoid_f(1.5957691216f * (x + 0.044715f * x * x * x)); }

template <bool PERM_> struct EpiNull {
    static constexpr bool PERM = PERM_;
    __device__ __forceinline__ void operator()(const f32x4 (&acc)[2][2][4][2], const Unit& u, int wr, int wc, int fr, int fq) const {
#pragma unroll
        for (int ai = 0; ai < 2; ++ai)
#pragma unroll
            for (int bj = 0; bj < 2; ++bj)
#pragma unroll
                for (int m = 0; m < 4; ++m)
#pragma unroll
                    for (int n = 0; n < 2; ++n) asm volatile("" :: "v"(acc[ai][bj][m][n]));
    }
};
struct EpiInProj {
    static constexpr bool PERM = true;
    bf16_t* uext; bf16_t* upool; bf16_t* ga; bf16_t* gb;
    __device__ __forceinline__ void operator()(const f32x4 (&acc)[2][2][4][2], const Unit& u, int wr, int wc, int fr, int fq) const {
#pragma unroll
        for (int ai = 0; ai < 2; ++ai)
#pragma unroll
            for (int m = 0; m < 4; ++m) { const int t = EPI_ROW(u, ai, m);
#pragma unroll
                for (int bj = 0; bj < 2; ++bj) { const int c = EPI_COL8(u, bj); f32x4 v0 = acc[ai][bj][m][0], v1 = acc[ai][bj][m][1]; bf16_t* dst;
                    if (u.pn < 2) { const int g = c >> 4, h0 = c & 15; dst = uext + ((size_t)g * 2048 + (size_t)(t >> 5)) * 640 + (size_t)((t & 31) * 16 + h0); }
                    else if (u.pn < 4) dst = upool + (size_t)t * 512 + (c - 512);
                    else { v0 = sig4(v0); v1 = sig4(v1); dst = (u.pn < 8) ? ga + (size_t)t * 1024 + (c - 1024) : gb + (size_t)t * 1024 + (c - 2048); }
                    *(u32x4*)dst = pack8(v0, v1); } }
    }
};
struct EpiS {
    static constexpr bool PERM = false;
    float* S;
    __device__ __forceinline__ void operator()(const f32x4 (&acc)[2][2][4][2], const Unit& u, int wr, int wc, int fr, int fq) const {
#pragma unroll
        for (int ai = 0; ai < 2; ++ai)
#pragma unroll
            for (int m = 0; m < 4; ++m) { float* rowp = S + (size_t)EPI_ROW(u, ai, m) * 128 + wc * 32 + 4 * fq;
#pragma unroll
                for (int n = 0; n < 2; ++n) *(f32x4*)(rowp + 16 * n) = acc[ai][0][m][n]; }
    }
};
template <int ACT> struct EpiBf16 {
    static constexpr bool PERM = true;
    bf16_t* O; int ldc;
    __device__ __forceinline__ void operator()(const f32x4 (&acc)[2][2][4][2], const Unit& u, int wr, int wc, int fr, int fq) const {
#pragma unroll
        for (int ai = 0; ai < 2; ++ai)
#pragma unroll
            for (int m = 0; m < 4; ++m) { bf16_t* rowp = O + (size_t)EPI_ROW(u, ai, m) * ldc;
#pragma unroll
                for (int bj = 0; bj < 2; ++bj) { f32x4 v0 = acc[ai][bj][m][0], v1 = acc[ai][bj][m][1];
                    if (ACT == 1) {
#pragma unroll
                        for (int j = 0; j < 4; ++j) { v0[j] = gelu_tanh(v0[j]); v1[j] = gelu_tanh(v1[j]); } }
                    *(u32x4*)(rowp + EPI_COL8(u, bj)) = pack8(v0, v1); } }
    }
};
struct EpiPool {
    static constexpr bool PERM = true;
    bf16_t* gb;
    __device__ __forceinline__ void operator()(const f32x4 (&acc)[2][2][4][2], const Unit& u, int wr, int wc, int fr, int fq) const {
#pragma unroll
        for (int ai = 0; ai < 2; ++ai)
#pragma unroll
            for (int m = 0; m < 4; ++m) { bf16_t* rowp = gb + (size_t)EPI_ROW(u, ai, m) * 1024;
#pragma unroll
                for (int bj = 0; bj < 2; ++bj) { u32x4* p = (u32x4*)(rowp + EPI_COL8(u, bj)); f32x4 g0, g1; unpack8(*p, g0, g1);
                    *p = pack8(g0 * acc[ai][bj][m][0], g1 * acc[ai][bj][m][1]); } }
    }
};
struct EpiGlu {
    static constexpr bool PERM = true;
    bf16_t* ga; const bf16_t* gb;
    __device__ __forceinline__ void operator()(const f32x4 (&acc)[2][2][4][2], const Unit& u, int wr, int wc, int fr, int fq) const {
#pragma unroll
        for (int ai = 0; ai < 2; ++ai)
#pragma unroll
            for (int m = 0; m < 4; ++m) { const size_t off = (size_t)EPI_ROW(u, ai, m) * 1024 + (size_t)(u.pn * HALF + wc * 32 + 8 * fq);
                u32x4* pa = (u32x4*)(ga + off); f32x4 a0, a1, t0, t1; unpack8(*pa, a0, a1); unpack8(*(const u32x4*)(gb + off), t0, t1);
                const f32x4 y0 = acc[ai][0][m][0] * sig4(acc[ai][1][m][0]), y1 = acc[ai][0][m][1] * sig4(acc[ai][1][m][1]);
                *pa = pack8(a0 * y0 + t0, a1 * y1 + t1); }
    }
};
struct EpiWout {
    static constexpr bool PERM = true;
    const float* x; bf16_t* s;
    __device__ __forceinline__ void operator()(const f32x4 (&acc)[2][2][4][2], const Unit& u, int wr, int wc, int fr, int fq) const {
#pragma unroll
        for (int ai = 0; ai < 2; ++ai)
#pragma unroll
            for (int m = 0; m < 4; ++m) { const size_t ro = (size_t)EPI_ROW(u, ai, m) * 1024;
#pragma unroll
                for (int bj = 0; bj < 2; ++bj) { const size_t o = ro + EPI_COL8(u, bj); const f32x4 x0 = *(const f32x4*)(x + o), x1 = *(const f32x4*)(x + o + 4);
                    *(u32x4*)(s + o) = pack8(x0 * 1.189207115002721f + acc[ai][bj][m][0], x1 * 1.189207115002721f + acc[ai][bj][m][1]); }
                if (m & 1) asm volatile("" ::: "memory"); }
    }
};
struct EpiPle {
    static constexpr bool PERM = false;
    const bf16_t* h1; const bf16_t* pp; bf16_t* base; const float* brouter; int* tope; float* topw;
    __device__ __forceinline__ void operator()(const f32x4 (&acc)[2][2][4][2], const Unit& u, int wr, int wc, int fr, int fq) const {
        if (u.pn < 4) {
#pragma unroll
            for (int ai = 0; ai < 2; ++ai)
#pragma unroll
                for (int m = 0; m < 4; ++m) { const size_t ro = (size_t)EPI_ROW(u, ai, m) * 1024;
#pragma unroll
                    for (int bj = 0; bj < 2; ++bj)
#pragma unroll
                        for (int n = 0; n < 2; ++n) { const size_t o = ro + EPI_COL4(u, bj, n); const u32x2 hw = *(const u32x2*)(h1 + o), pw = *(const u32x2*)(pp + o);
                            const f32x4 hv = (f32x4){bf_lo(hw.x), bf_hi(hw.x), bf_lo(hw.y), bf_hi(hw.y)}, pv = (f32x4){bf_lo(pw.x), bf_hi(pw.x), bf_lo(pw.y), bf_hi(pw.y)};
                            const f32x4 r = hv * 1.189207115002721f + sig4(acc[ai][bj][m][n]) * pv; *(u32x2*)(base + o) = (u32x2){cvt_pk_bf16(r[0], r[1]), cvt_pk_bf16(r[2], r[3])}; }
                    if (m & 1) asm volatile("" ::: "memory"); }
        } else if (wc == 0) {
            f32x4 b0 = *(const f32x4*)(brouter + 4 * fq), b1 = *(const f32x4*)(brouter + 16 + 4 * fq);
#pragma unroll
            for (int ai = 0; ai < 2; ++ai)
#pragma unroll
                for (int m = 0; m < 4; ++m) {
                    float v[8]; const f32x4 l0 = acc[ai][0][m][0] + acc[ai][1][m][0] + b0, l1 = acc[ai][0][m][1] + acc[ai][1][m][1] + b1;
#pragma unroll
                    for (int i = 0; i < 4; ++i) { v[i] = l0[i]; v[4 + i] = l1[i]; }
                    float tv[4]; int te[4];
#pragma unroll
                    for (int r = 0; r < 4; ++r) {
                        float bv = -3.0e38f; int bi = 0;
#pragma unroll
                        for (int i = 0; i < 8; ++i) { if (v[i] > bv) { bv = v[i]; bi = i; } }
                        int be = (bi < 4) ? (4 * fq + bi) : (16 + 4 * fq + (bi - 4));
                        float gv = bv; int ge = be;
#pragma unroll
                        for (int o = 16; o <= 32; o <<= 1) { const float ov = __shfl_xor(gv, o); const int oe = __shfl_xor(ge, o); if (ov > gv || (ov == gv && oe < ge)) { gv = ov; ge = oe; } }
                        tv[r] = gv; te[r] = ge;
                        if (ge == be) {
#pragma unroll
                            for (int i = 0; i < 8; ++i) if (i == bi) v[i] = -3.0e38f; }
                    }
                    if (fq == 0) { const float e1 = __expf(tv[1] - tv[0]), e2 = __expf(tv[2] - tv[0]), e3 = __expf(tv[3] - tv[0]); const float inv = 1.0f / (1.0f + e1 + e2 + e3);
                        const int t = EPI_ROW(u, ai, m);
                        *(int4*)(tope + (size_t)t * 4) = make_int4(te[0], te[1], te[2], te[3]);
                        *(float4*)(topw + (size_t)t * 4) = make_float4(inv, e1 * inv, e2 * inv, e3 * inv); }
                }
        }
    }
};
struct EpiM1 {
    static constexpr bool PERM = true;
    bf16_t* act; const float* bgate; const float* bup;
    __device__ __forceinline__ void operator()(const f32x4 (&acc)[2][2][4][2], const Unit& u, int wr, int wc, int fr, int fq) const {
        const int col = u.pn * HALF + wc * 32 + 8 * fq; const float* bg = bgate + (size_t)u.aux * 1024 + col; const float* bu = bup + (size_t)u.aux * 1024 + col;
        const f32x4 g0 = *(const f32x4*)bg, g1 = *(const f32x4*)(bg + 4), u0 = *(const f32x4*)bu, u1 = *(const f32x4*)(bu + 4);
#pragma unroll
        for (int ai = 0; ai < 2; ++ai)
#pragma unroll
            for (int m = 0; m < 4; ++m) { f32x4 o[2];
#pragma unroll
                for (int n = 0; n < 2; ++n) { const f32x4 gg = acc[ai][0][m][n] + (n ? g1 : g0), uu = acc[ai][1][m][n] + (n ? u1 : u0);
#pragma unroll
                    for (int j = 0; j < 4; ++j) { const float g = fminf(gg[j], 7.0f), up = fminf(fmaxf(uu[j], -7.0f), 7.0f); o[n][j] = (up + 1.0f) * (g * sigmoid_f(1.702f * g)); } }
                *(u32x4*)(act + (size_t)EPI_ROW(u, ai, m) * 1024 + col) = pack8(o[0], o[1]); }
    }
};
__device__ __forceinline__ u32x2 pack8_fp8(const f32x4 a, const f32x4 b) { int w0 = 0, w1 = 0;
    w0 = __builtin_amdgcn_cvt_pk_fp8_f32(a[0], a[1], w0, false); w0 = __builtin_amdgcn_cvt_pk_fp8_f32(a[2], a[3], w0, true);
    w1 = __builtin_amdgcn_cvt_pk_fp8_f32(b[0], b[1], w1, false); w1 = __builtin_amdgcn_cvt_pk_fp8_f32(b[2], b[3], w1, true); return (u32x2){(unsigned)w0, (unsigned)w1}; }
struct EpiM1F8 {
    static constexpr bool PERM = true;
    unsigned char* act; const float* bgate; const float* bup;
    __device__ __forceinline__ void operator()(const f32x4 (&acc)[2][2][4][2], const Unit& u, int wr, int wc, int fr, int fq) const {
        const int col = u.pn * HALF + wc * 32 + 8 * fq; const float* bg = bgate + (size_t)u.aux * 1024 + col; const float* bu = bup + (size_t)u.aux * 1024 + col;
        const f32x4 g0 = *(const f32x4*)bg, g1 = *(const f32x4*)(bg + 4), u0 = *(const f32x4*)bu, u1 = *(const f32x4*)(bu + 4);
#pragma unroll
        for (int ai = 0; ai < 2; ++ai)
#pragma unroll
            for (int m = 0; m < 4; ++m) { f32x4 o[2];
#pragma unroll
                for (int n = 0; n < 2; ++n) { const f32x4 gg = acc[ai][0][m][n] * 0.03125f + (n ? g1 : g0), uu = acc[ai][1][m][n] * 0.03125f + (n ? u1 : u0);
#pragma unroll
                    for (int j = 0; j < 4; ++j) { const float g = fminf(gg[j], 7.0f), up = fminf(fmaxf(uu[j], -7.0f), 7.0f); o[n][j] = (up + 1.0f) * (g * sigmoid_f(1.702f * g)); } }
                *(u32x2*)(act + (size_t)(u.pm * BM + ai * HALF + wr * 64 + m * 16 + fr) * 1024 + col) = pack8_fp8(o[0], o[1]); }
    }
};
struct EpiM2 {
    static constexpr bool PERM = true;
    bf16_t* y; const float* bdown; float sc;
    __device__ __forceinline__ void operator()(const f32x4 (&acc)[2][2][4][2], const Unit& u, int wr, int wc, int fr, int fq) const {
        f32x4 b[2][2];
#pragma unroll
        for (int bj = 0; bj < 2; ++bj) { const float* bp = bdown + (size_t)u.aux * 1024 + EPI_COL8(u, bj); b[bj][0] = *(const f32x4*)bp; b[bj][1] = *(const f32x4*)(bp + 4); }
#pragma unroll
        for (int ai = 0; ai < 2; ++ai)
#pragma unroll
            for (int m = 0; m < 4; ++m) { bf16_t* rowp = y + (size_t)EPI_ROW(u, ai, m) * 1024;
#pragma unroll
                for (int bj = 0; bj < 2; ++bj) *(u32x4*)(rowp + EPI_COL8(u, bj)) = pack8(acc[ai][bj][m][0] * sc + b[bj][0], acc[ai][bj][m][1] * sc + b[bj][1]); }
    }
};
#undef EPI_ROW
#undef EPI_COL8
#undef EPI_COL4
}

struct Args { const float* in[31]; float* out; unsigned char* ws; int ph_lo, ph_hi, li, pad; };
struct Ctx { LAS unsigned char* lds; int tid, lane, wave, vcu, G, gw, ngw; };
__device__ __forceinline__ int lane_id() { return (int)__builtin_amdgcn_mbcnt_hi(~0u, __builtin_amdgcn_mbcnt_lo(~0u, 0u)); }
struct PT { const LAS unsigned long long* t;
    __device__ __forceinline__ unsigned long long get(int k) const { const unsigned long long v = t[k]; const unsigned lo = __builtin_amdgcn_readfirstlane((unsigned)v), hi = __builtin_amdgcn_readfirstlane((unsigned)(v >> 32)); return ((unsigned long long)hi << 32) | lo; }
    __device__ __forceinline__ const float* in(int k) const { return (const float*)get(k); }
    __device__ __forceinline__ float* out() const { return (float*)get(31); }
    __device__ __forceinline__ unsigned char* ws() const { return (unsigned char*)get(32); } };

__device__ __forceinline__ float wave_sum(float v) {
#pragma unroll
    for (int o = 1; o < 64; o <<= 1) v += __shfl_xor(v, o);
    return v;
}
__device__ __forceinline__ void p0_transpose_item(const float* W, int K, int N, bf16* WT, int dst_row0, LAS unsigned char* scr, int kb, int nb, int lane) {
    const int k0 = 64 * kb, n0 = 64 * nb, kr = lane >> 4, nq = lane & 15;
    f32x4 v[16];
#pragma unroll
    for (int i = 0; i < 16; ++i) v[i] = *(const f32x4*)(W + (size_t)(k0 + 4 * i + kr) * N + n0 + 4 * nq);
#pragma unroll
    for (int i = 0; i < 16; ++i) { const int k = 4 * i + kr;
#pragma unroll
        for (int j = 0; j < 4; ++j) *(LAS unsigned short*)(scr + (4 * nq + j) * 144 + 2 * k) = (unsigned short)f2bf(v[i][j]); }
    LDS_WAIT(); asm volatile("" ::: "memory");
    const int c = lane & 7;
#pragma unroll
    for (int j = 0; j < 8; ++j) { const int n = (lane >> 3) + 8 * j; const v4u o = *(const LAS v4u*)(scr + n * 144 + 16 * c);
        *(v4u*)(WT + (size_t)(dst_row0 + n) * K + k0 + 8 * c) = o; }
    LDS_WAIT(); asm volatile("" ::: "memory");
}
__device__ __forceinline__ unsigned char f2fp8(float x) { return (unsigned char)(__builtin_amdgcn_cvt_pk_fp8_f32(x, x, 0, false) & 0xff); }
__device__ __forceinline__ void p0_transpose_item8(const float* W, int K, int N, unsigned char* WT, int dst_row0, LAS unsigned char* scr, int kb, int nb, int lane, float sc) {
    const int k0 = 128 * kb, n0 = 32 * nb, kr = lane >> 3, nq = lane & 7;
    f32x4 v[16];
#pragma unroll
    for (int i = 0; i < 16; ++i) v[i] = *(const f32x4*)(W + (size_t)(k0 + 8 * i + kr) * N + n0 + 4 * nq);
#pragma unroll
    for (int i = 0; i < 16; ++i) { const int k = 8 * i + kr;
#pragma unroll
        for (int j = 0; j < 4; ++j) *(LAS unsigned char*)(scr + (4 * nq + j) * 144 + k) = f2fp8(v[i][j] * sc); }
    LDS_WAIT(); asm volatile("" ::: "memory");
#pragma unroll
    for (int j = 0; j < 4; ++j) { const int q = lane + 64 * j, n = q >> 3, c = q & 7; const v4u o = *(const LAS v4u*)(scr + n * 144 + 16 * c);
        *(v4u*)(WT + (size_t)(dst_row0 + n) * K + k0 + 16 * c) = o; }
    LDS_WAIT(); asm volatile("" ::: "memory");
}
__device__ __forceinline__ void cvt_4096(const float* src, bf16* dst, int lane) {
    const f32x4* s = (const f32x4*)src + lane; f32x4 v[16];
#pragma unroll
    for (int j = 0; j < 16; ++j) v[j] = s[64 * j];
    v2u* o = (v2u*)dst + lane;
#pragma unroll
    for (int j = 0; j < 16; ++j) { v2u w; w.x = pk2(v[j].x, v[j].y); w.y = pk2(v[j].z, v[j].w); o[64 * j] = w; }
}
struct cplx { float re, im; };
__device__ __forceinline__ cplx cmul(cplx a, cplx b) { return cplx{a.re * b.re - a.im * b.im, a.re * b.im + a.im * b.re}; }
__device__ __forceinline__ cplx lam_pow(float lre, float lim, float step, float tau) { const float m = __expf(lre * step * tau); float s, c; sincosf(lim * step * tau, &s, &c); return cplx{m * c, m * s}; }
__device__ __forceinline__ cplx bbar_fac(float lre, float lim, float step) { const cplx lb = lam_pow(lre, lim, step, 1.0f); const float nr = lb.re - 1.0f, ni = lb.im, d = 1.0f / (lre * lre + lim * lim);
    return cplx{(nr * lre + ni * lim) * d, (ni * lre - nr * lim) * d}; }

__device__ __forceinline__ void phase_prologue(const PT a, const Ctx& c0) {
    Ctx c = c0; c.lane = lane_id(); c.tid = c.wave * 64 + c.lane;
    unsigned char* ws = a.ws();
    LAS float* scr = (LAS float*)(c.lds + c.wave * 16384);
    const float *w_in = a.in(2), *lre = a.in(3), *lim = a.in(4), *lstep = a.in(5), *bre = a.in(6), *bim = a.in(7), *cre = a.in(8), *cim = a.in(9), *dsk = a.in(10);
    const float *wval = a.in(11), *wgt = a.in(12), *wgrp = a.in(13), *pscale = a.in(14), *wpp = a.in(15), *wout = a.in(16), *wrt = a.in(19);
    const float *wgate = a.in(21), *wup = a.in(23), *wdown = a.in(25), *wpleg = a.in(27), *wplep = a.in(28);
    constexpr int I_IN = 16 * 48, I_GL = 8 * 16, I_SQ = 16 * 16, I_PP = 4 * 16, I_E = 32 * I_SQ;
    constexpr int NITEMS = I_IN + 2 * I_GL + 2 * I_SQ + I_PP + 3 * I_E;
    LAS unsigned char* scrb = (LAS unsigned char*)scr;
    for (int it = c.gw; it < NITEMS; it += c.ngw) {
        int r = it;
        if (r < I_IN) { p0_transpose_item(w_in, 1024, 3072, (bf16*)(ws + WS_WIN), 64 * (r % 48), scrb, r / 48, r % 48, c.lane); continue; } r -= I_IN;
        if (r < 2 * I_GL) { const int which = r / I_GL, q = r % I_GL, nb = q % 16, n0 = 64 * nb;
            p0_transpose_item(which ? wgt : wval, 512, 1024, (bf16*)(ws + WS_WGLU), (n0 >> 7) * 256 + (n0 & 127) + which * 128, scrb, q / 16, nb, c.lane); continue; } r -= 2 * I_GL;
        if (r < I_SQ) { p0_transpose_item(wout, 1024, 1024, (bf16*)(ws + WS_WOUT), 64 * (r % 16), scrb, r / 16, r % 16, c.lane); continue; } r -= I_SQ;
        if (r < I_SQ) { p0_transpose_item(wpleg, 1024, 1024, (bf16*)(ws + WS_WPLE), 64 * (r % 16), scrb, r / 16, r % 16, c.lane); continue; } r -= I_SQ;
        if (r < I_PP) { p0_transpose_item(wplep, 256, 1024, (bf16*)(ws + WS_WPP), 64 * (r % 16), scrb, r / 16, r % 16, c.lane); continue; } r -= I_PP;
#if MOE_FP8
        if (r < 2 * I_E) { const int which = r / I_E, q = r % I_E, e = q / I_SQ, qq = q % I_SQ, nb = qq % 32, n0 = 32 * nb;
            p0_transpose_item8((which ? wup : wgate) + (size_t)e * 1048576, 1024, 1024, (unsigned char*)(ws + WS_WGU) + (size_t)e * 2048 * 1024, (n0 >> 7) * 256 + (n0 & 127) + which * 128, scrb, qq / 32, nb, c.lane, 32.0f); continue; } r -= 2 * I_E;
        { const int e = r / I_SQ, qq = r % I_SQ; p0_transpose_item8(wdown + (size_t)e * 1048576, 1024, 1024, (unsigned char*)(ws + WS_WDN) + (size_t)e * 1048576, 32 * (qq % 32), scrb, qq / 32, qq % 32, c.lane, 64.0f); }
#else
        if (r < 2 * I_E) { const int which = r / I_E, q = r % I_E, e = q / I_SQ, qq = q % I_SQ, nb = qq % 16, n0 = 64 * nb;
            p0_transpose_item((which ? wup : wgate) + (size_t)e * 1048576, 1024, 1024, (bf16*)(ws + WS_WGU) + (size_t)e * 2048 * 1024, (n0 >> 7) * 256 + (n0 & 127) + which * 128, scrb, qq / 16, nb, c.lane); continue; } r -= 2 * I_E;
        { const int e = r / I_SQ, qq = r % I_SQ; p0_transpose_item(wdown + (size_t)e * 1048576, 1024, 1024, (bf16*)(ws + WS_WDN) + (size_t)e * 1048576, 64 * (qq % 16), scrb, qq / 16, qq % 16, c.lane); }
#endif
    }
    for (int m = c.gw; m < T / 4; m += c.ngw) cvt_4096(a.in(0) + (size_t)m * 4096, (bf16*)(ws + WS_XB) + (size_t)m * 4096, c.lane);
    for (int m = c.gw; m < T / 16; m += c.ngw) cvt_4096(a.in(1) + (size_t)m * 4096, (bf16*)(ws + WS_PB) + (size_t)m * 4096, c.lane);
    { bf16* W = (bf16*)(ws + WS_WPLE) + (size_t)1024 * 1024;
      for (int ch = c.gw * 64 + c.lane; ch < 256 * 128; ch += c.ngw * 64) { const int r = ch >> 7, k0 = (ch & 127) * 8; unsigned o[4] = {0u, 0u, 0u, 0u};
          if (r < 32 || (r >= 128 && r < 160)) { const int e = r & 31; float f[8];
#pragma unroll
              for (int j = 0; j < 8; ++j) { const float w = wrt[(size_t)(k0 + j) * 32 + e]; const float hi = bf2f((unsigned short)f2bf(w)); f[j] = (r < 32) ? hi : (w - hi); }
#pragma unroll
              for (int j = 0; j < 4; ++j) o[j] = pk2(f[2 * j], f[2 * j + 1]); }
          *(v4u*)(W + (size_t)r * 1024 + k0) = (v4u){o[0], o[1], o[2], o[3]}; } }
    for (int it = c.gw; it < 64 * 16; it += c.ngw) { const int c0 = (it >> 4) * 8, d = (it & 15) * 64 + c.lane, g = c0 >> 7; float s[8];
#pragma unroll
        for (int i = 0; i < 8; ++i) s[i] = 0.f;
        for (int j = 0; j < 128; ++j) { const float pw = pscale[g * 128 + j] * wpp[(size_t)(g * 128 + j) * 1024 + d];
#pragma unroll
            for (int i = 0; i < 8; ++i) s[i] += wgrp[(size_t)(g * 128 + (c0 & 127) + i) * 128 + j] * pw; }
        *(v4u*)((bf16*)(ws + WS_WPOOL) + (size_t)d * 512 + c0) = (v4u){pk2(s[0], s[1]), pk2(s[2], s[3]), pk2(s[4], s[5]), pk2(s[6], s[7])}; }
    { bf16* TV = (bf16*)(ws + WS_TV);
      for (int it = c.gw; it < 128; it += c.ngw) { const int id = it * 64 + c.lane, g = id >> 8, h = (id >> 4) & 15, hp = id & 15; const float step = __expf(lstep[g]);
          float Kt[32];
#pragma unroll
          for (int tt = 0; tt < 32; ++tt) Kt[tt] = 0.f;
          for (int p = 0; p < 64; ++p) { const float lr = lre[g * 64 + p], li = lim[g * 64 + p]; const cplx lb = lam_pow(lr, li, step, 1.0f), bf = bbar_fac(lr, li, step);
              const cplx bb = cmul(bf, cplx{bre[(size_t)(g * 64 + p) * 16 + hp], bim[(size_t)(g * 64 + p) * 16 + hp]});
              cplx w = cmul(cplx{cre[(size_t)(g * 16 + h) * 64 + p], cim[(size_t)(g * 16 + h) * 64 + p]}, bb);
#pragma unroll
              for (int tt = 0; tt < 32; ++tt) { Kt[tt] += w.re; w = cmul(w, lb); } }
          if (h == hp) Kt[0] += dsk[g * 16 + h];
#pragma unroll
          for (int tt = 0; tt < 32; ++tt) { const bf16 v = (bf16)f2bf(Kt[tt]);
              for (int s = 0; s + tt < 32; ++s) TV[((size_t)g * 512 + (size_t)(s + tt) * 16 + h) * 640 + s * 16 + hp] = v; } }
      for (int it = c.gw; it < 32 * 512; it += c.ngw) { const int g = it >> 9, n = it & 511, j = n >> 4, h = n & 15; bf16* row = TV + (size_t)it * 640;
          if (c.lane * 8 >= (j + 1) * 16) *(v4u*)(row + c.lane * 8) = (v4u){0u, 0u, 0u, 0u};
          const int p = c.lane; const float step = __expf(lstep[g]); const cplx lp = lam_pow(lre[g * 64 + p], lim[g * 64 + p], step, (float)(j + 1));
          const cplx mv = cmul(cplx{cre[(size_t)(g * 16 + h) * 64 + p], cim[(size_t)(g * 16 + h) * 64 + p]}, lp);
          row[512 + p] = (bf16)f2bf(mv.re); row[576 + p] = (bf16)f2bf(-mv.im); }
      bf16* WS = (bf16*)(ws + WS_WS);
      for (int it = c.gw; it < 32 * 256; it += c.ngw) { const int g = it >> 8, n = it & 255; v4u o = (v4u){0u, 0u, 0u, 0u};
          if (n < 128) { const int p = n & 63, s = c.lane >> 1, h0 = (c.lane & 1) * 8; const float step = __expf(lstep[g]), lr = lre[g * 64 + p], li = lim[g * 64 + p];
              const cplx f = cmul(lam_pow(lr, li, step, (float)(31 - s)), bbar_fac(lr, li, step)); float v[8];
#pragma unroll
              for (int i = 0; i < 8; ++i) { const cplx r = cmul(f, cplx{bre[(size_t)(g * 64 + p) * 16 + h0 + i], bim[(size_t)(g * 64 + p) * 16 + h0 + i]}); v[i] = (n < 64) ? r.re : r.im; }
              o = (v4u){pk2(v[0], v[1]), pk2(v[2], v[3]), pk2(v[4], v[5]), pk2(v[6], v[7])}; }
          *(v4u*)(WS + (size_t)it * 512 + c.lane * 8) = o; } }
}

__device__ __forceinline__ void unpack8f(const v4u v, float (&f)[8]) { f[0] = pg8::bf_lo(v.x); f[1] = pg8::bf_hi(v.x); f[2] = pg8::bf_lo(v.y); f[3] = pg8::bf_hi(v.y); f[4] = pg8::bf_lo(v.z); f[5] = pg8::bf_hi(v.z); f[6] = pg8::bf_lo(v.w); f[7] = pg8::bf_hi(v.w); }
__device__ __forceinline__ void phase_pooling(const PT a, const Ctx& c0) {
    Ctx c = c0; c.lane = lane_id(); c.tid = c.wave * 64 + c.lane;
    const bf16* up = (const bf16*)(a.ws() + WS_UPOOL) + c.lane * 8; bf16* po = (bf16*)(a.ws() + WS_POOLED) + c.lane * 8;
    const int w = 2 << (c.lane >> 4);
    for (int run = c.gw; run < T / 32; run += c.ngw) { const int t0 = run * 32, pos0 = t0 & (SEQ - 1);
        float s[8];
#pragma unroll
        for (int i = 0; i < 8; ++i) s[i] = 0.f;
        for (int j = 1; j < w; ++j) { if (pos0 - j >= 0) { float f[8]; unpack8f(*(const v4u*)(up + (size_t)(t0 - j) * 512), f);
#pragma unroll
                for (int i = 0; i < 8; ++i) s[i] += f[i]; } }
#pragma unroll 4
        for (int q = 0; q < 32; ++q) { const int t = t0 + q, pos = pos0 + q; float f[8], o[8]; unpack8f(*(const v4u*)(up + (size_t)t * 512), f);
            const int cnt = (pos + 1 < w) ? pos + 1 : w; const float inv = 1.0f / (float)cnt;
#pragma unroll
            for (int i = 0; i < 8; ++i) { s[i] += f[i]; o[i] = s[i] * inv - f[i]; }
            *(v4u*)(po + (size_t)t * 512) = (v4u){pk2(o[0], o[1]), pk2(o[2], o[3]), pk2(o[4], o[5]), pk2(o[6], o[7])};
            if (pos - w + 1 >= 0) { float g[8]; unpack8f(*(const v4u*)(up + (size_t)(t - w + 1) * 512), g);
#pragma unroll
                for (int i = 0; i < 8; ++i) s[i] -= g[i]; } } }
}

__device__ __forceinline__ void phase_scan(const PT a, const Ctx& c0) {
    Ctx c = c0; c.lane = lane_id(); c.tid = c.wave * 64 + c.lane;
    const float* S = (const float*)(a.ws() + WS_S); bf16* ue = (bf16*)(a.ws() + WS_UEXT);
    const float *lre = a.in(3), *lim = a.in(4), *lstep = a.in(5);
    for (int it = c.gw; it < NG * BATCH; it += c.ngw) { const int g = it >> 4, b = it & 15, p = c.lane;
        const cplx l32 = lam_pow(lre[g * 64 + p], lim[g * 64 + p], __expf(lstep[g]), 32.0f);
        const float* sp = S + ((size_t)g * 2048 + (size_t)b * 128) * 128 + p; bf16* up = ue + ((size_t)g * 2048 + (size_t)b * 128) * 640 + 512 + p;
        cplx X{0.f, 0.f};
        for (int c0 = 0; c0 < NCH; c0 += 16) { float sr[16], si[16];
#pragma unroll
            for (int j = 0; j < 16; ++j) { sr[j] = sp[(size_t)(c0 + j) * 128]; si[j] = sp[(size_t)(c0 + j) * 128 + 64]; }
#pragma unroll
            for (int j = 0; j < 16; ++j) { up[(size_t)(c0 + j) * 640] = (bf16)f2bf(X.re); up[(size_t)(c0 + j) * 640 + 64] = (bf16)f2bf(X.im);
                const cplx n = cmul(l32, X); X.re = n.re + sr[j]; X.im = n.im + si[j]; } } }
}

__device__ __forceinline__ void phase_ln1(const PT a, const Ctx& c0) {
    Ctx c = c0; c.lane = lane_id(); c.tid = c.wave * 64 + c.lane;
    bf16* h1 = (bf16*)(a.ws() + WS_H1); const float *g1 = a.in(17), *b1 = a.in(18);
    f32x4 gv[4], bv[4];
#pragma unroll
    for (int j = 0; j < 4; ++j) { gv[j] = ((const f32x4*)g1)[c.lane + 64 * j]; bv[j] = ((const f32x4*)b1)[c.lane + 64 * j]; }
    for (int m0 = c.gw * 4; m0 < T; m0 += c.ngw * 4) {
        v2u q[4][4];
#pragma unroll
        for (int r = 0; r < 4; ++r) { const v2u* xr = (const v2u*)(h1 + (size_t)(m0 + r) * 1024) + c.lane;
#pragma unroll
            for (int j = 0; j < 4; ++j) q[r][j] = xr[64 * j]; }
#pragma unroll
        for (int r = 0; r < 4; ++r) { const int m = m0 + r; f32x4 v[4]; float sm = 0.f;
#pragma unroll
            for (int j = 0; j < 4; ++j) { v[j] = (f32x4){pg8::bf_lo(q[r][j].x), pg8::bf_hi(q[r][j].x), pg8::bf_lo(q[r][j].y), pg8::bf_hi(q[r][j].y)}; sm += (v[j].x + v[j].y) + (v[j].z + v[j].w); }
            const float mean = wave_sum(sm) * (1.f / 1024.f); float s2 = 0.f;
#pragma unroll
            for (int j = 0; j < 4; ++j) { v[j] = v[j] - mean; s2 += (v[j].x * v[j].x + v[j].y * v[j].y) + (v[j].z * v[j].z + v[j].w * v[j].w); }
            const float rstd = 1.f / sqrtf(wave_sum(s2) * (1.f / 1024.f) + LN_EPS);
            v2u* o = (v2u*)(h1 + (size_t)m * 1024) + c.lane; unsigned* oq = (unsigned*)(a.ws() + WS_H1Q + (size_t)m * 1024) + c.lane;
#pragma unroll
            for (int j = 0; j < 4; ++j) { const f32x4 y = v[j] * rstd * gv[j] + bv[j]; v2u w; w.x = pk2(y.x, y.y); w.y = pk2(y.z, y.w); o[64 * j] = w;
                if (MOE_FP8) { int qq = 0; qq = __builtin_amdgcn_cvt_pk_fp8_f32(y.x, y.y, qq, false); qq = __builtin_amdgcn_cvt_pk_fp8_f32(y.z, y.w, qq, true); oq[64 * j] = (unsigned)qq; } } } }
}

__device__ __forceinline__ void phase_route_count(const PT a, const Ctx& c0) {
    Ctx c = c0; c.lane = lane_id(); c.tid = c.wave * 64 + c.lane;
    LAS int* hist = (LAS int*)c.lds; const int* tope = (const int*)(a.ws() + WS_TOPE); int* cnt = (int*)(a.ws() + WS_CNT);
    for (int w = blockIdx.x; w < 256; w += c.G) {
        if (c.tid < 32) hist[c.tid] = 0;
        __syncthreads();
        { const int slot = c.tid * 2; const int2 e2 = *(const int2*)(tope + (size_t)w * 1024 + slot); atomicAdd((int*)&hist[e2.x], 1); atomicAdd((int*)&hist[e2.y], 1); }
        __syncthreads();
        if (c.tid < 32) cnt[w * 32 + c.tid] = hist[c.tid];
        __syncthreads();
    }
}
__device__ __forceinline__ void phase_route_place(const PT a, const Ctx& c0) {
    Ctx c = c0; c.lane = lane_id(); c.tid = c.wave * 64 + c.lane;
    LAS int* L = (LAS int*)c.lds;
    const int* tope = (const int*)(a.ws() + WS_TOPE); const int* cnt = (const int*)(a.ws() + WS_CNT); int* tpg = (int*)(a.ws() + WS_CNT + 65536);
    for (int w = blockIdx.x; w < 256; w += c.G) { const int s = w >> 7, wl = w & 127;
        int* rowtok = (int*)(a.ws() + WS_ROWTOK) + (size_t)s * SLAB_ROWS; int* slotpos = (int*)(a.ws() + WS_SLOTPOS);
        if (c.tid < 32) { int tot = 0, pre = 0; for (int q = 0; q < 128; ++q) { const int v = cnt[(s * 128 + q) * 32 + c.tid]; tot += v; pre += (q < wl) ? v : 0; } L[c.tid] = tot; L[32 + c.tid] = pre; L[96 + c.tid] = 0; }
        __syncthreads();
        if (c.tid == 0) { int acc = 0; for (int e = 0; e < 32; ++e) { L[128 + e] = acc; L[64 + e] = acc * 256; acc += (L[e] + 255) >> 8; } L[160] = acc;
            if (wl == 0) for (int e = 0; e <= 32; ++e) tpg[s * 64 + e] = L[128 + e]; }
        __syncthreads();
        { const int slot = c.tid * 2, tok = w * 256 + (slot >> 2); const int2 e2 = *(const int2*)(tope + (size_t)w * 1024 + slot);
#pragma unroll
          for (int q = 0; q < 2; ++q) { const int e = q ? e2.y : e2.x; const int r = atomicAdd((int*)&L[96 + e], 1); const int pos = L[64 + e] + L[32 + e] + r;
              rowtok[pos] = tok; slotpos[(size_t)tok * 4 + ((slot + q) & 3)] = pos; } }
        if (wl < 32) { const int e = wl, tot = L[e], end = ((tot + 255) >> 8) << 8; for (int r = tot + c.tid; r < end; r += 512) rowtok[L[64 + e] + r] = s * SLAB_T; }
        __syncthreads();
    }
}
__device__ __forceinline__ void phase_combine(const PT a, const Ctx& c0, int s) {
    Ctx c = c0; c.lane = lane_id(); c.tid = c.wave * 64 + c.lane;
    const bf16* y = (const bf16*)(a.ws() + WS_Y); const float* topw = (const float*)(a.ws() + WS_TOPW); float* out = a.out(); const float *g2 = a.in(29), *b2 = a.in(30);
    f32x4 gv[4], bv[4];
#pragma unroll
    for (int j = 0; j < 4; ++j) { gv[j] = ((const f32x4*)g2)[c.lane + 64 * j]; bv[j] = ((const f32x4*)b2)[c.lane + 64 * j]; }
    const bf16* base = (const bf16*)(a.ws() + WS_BASE);
    for (int tl = c.gw; tl < SLAB_T; tl += c.ngw) { const int t = s * SLAB_T + tl; f32x4* xr = (f32x4*)(out + (size_t)t * 1024) + c.lane; f32x4 v[4]; const v2u* br = (const v2u*)(base + (size_t)t * 1024) + c.lane;
        const float4 wk = *(const float4*)(topw + (size_t)t * 4); const float wv[4] = {wk.x, wk.y, wk.z, wk.w};
        const int4 pk = *(const int4*)((const int*)(a.ws() + WS_SLOTPOS) + (size_t)t * 4); const int pv[4] = {pk.x, pk.y, pk.z, pk.w};
#pragma unroll
        for (int j = 0; j < 4; ++j) { const v2u q = br[64 * j]; v[j] = (f32x4){pg8::bf_lo(q.x), pg8::bf_hi(q.x), pg8::bf_lo(q.y), pg8::bf_hi(q.y)}; }
#pragma unroll
        for (int k = 0; k < 4; ++k) { const v2u* yr = (const v2u*)(y + (size_t)pv[k] * 1024) + c.lane;
#pragma unroll
            for (int j = 0; j < 4; ++j) { const v2u q = yr[64 * j]; v[j] = v[j] + (f32x4){pg8::bf_lo(q.x), pg8::bf_hi(q.x), pg8::bf_lo(q.y), pg8::bf_hi(q.y)} * wv[k]; } }
        float sm = 0.f;
#pragma unroll
        for (int j = 0; j < 4; ++j) sm += (v[j].x + v[j].y) + (v[j].z + v[j].w);
        const float mean = wave_sum(sm) * (1.f / 1024.f); float s2 = 0.f;
#pragma unroll
        for (int j = 0; j < 4; ++j) { v[j] = v[j] - mean; s2 += (v[j].x * v[j].x + v[j].y * v[j].y) + (v[j].z * v[j].z + v[j].w * v[j].w); }
        const float rstd = 1.f / sqrtf(wave_sum(s2) * (1.f / 1024.f) + LN_EPS);
#pragma unroll
        for (int j = 0; j < 4; ++j) xr[64 * j] = v[j] * rstd * gv[j] + bv[j]; }
}

__global__ void __launch_bounds__(NWAVES * 64, 2) mega_fwd(Args args) {
    extern __shared__ __attribute__((aligned(16))) unsigned char lds_raw[];
    Ctx c;
    c.lds = (LAS unsigned char*)lds_raw;
    c.tid = threadIdx.x; c.lane = c.tid & 63; c.wave = __builtin_amdgcn_readfirstlane(c.tid >> 6);
    c.G = gridDim.x; { const int bx = blockIdx.x; c.vcu = (c.G % 8 == 0) ? (bx % 8) * (c.G / 8) + bx / 8 : bx; }
    c.gw = c.vcu * NWAVES + c.wave; c.ngw = c.G * NWAVES;
    volatile LAS unsigned* MISC = (volatile LAS unsigned*)(c.lds + MISC_OFF);
    for (int u = c.tid; u < (LDS_BYTES - LDSCTL_OFF) / 4; u += NWAVES * 64) ((LAS unsigned*)(c.lds + LDSCTL_OFF))[u] = 0u;
    __syncthreads();
    { LAS unsigned long long* ptw = (LAS unsigned long long*)(c.lds + PTAB_OFF);
      if (c.tid < 31) ptw[c.tid] = (unsigned long long)args.in[c.tid]; else if (c.tid == 31) ptw[31] = (unsigned long long)args.out; else if (c.tid == 32) ptw[32] = (unsigned long long)args.ws; }
    __syncthreads();
    const PT pt{(const LAS unsigned long long*)(c.lds + PTAB_OFF)};
    unsigned char* ws = pt.ws();
    XcdBarrier bar; bar.bar = (unsigned*)(ws + WS_CTL) + CW_BAR + args.li * XCD_BAR_WORDS; bar.x = 0; bar.st = nullptr;
    if (!MK_PER_PHASE) bar = xcd_barrier_post((unsigned*)(ws + WS_CTL) + CW_BAR + args.li * XCD_BAR_WORDS, MISC + 8);
    const int lo = args.ph_lo, hi = args.ph_hi;
#ifndef PH_MASK
#define PH_MASK 0xFFFFFFFFu
#endif
#define IN(k) (((PH_MASK >> (k)) & 1u) && lo <= (k) && (k) < hi)
#define SEAM(k) do { if (IN(k) && IN((k) + 1)) xcd_barrier(bar); } while (0)
    LAS unsigned char* ring = c.lds;
    const int bid = (int)blockIdx.x;
    using namespace pg8;

    if (IN(0)) { phase_prologue(pt, c); }
    SEAM(0);
    if (IN(1)) {
        Prob P{(const char*)(ws + WS_XB), (const char*)(ws + WS_WIN), nullptr, 2048u, 2048u, 128u, 16, 0, 0, c.wave};
        GridOrder S; S.init(T / 256, NIN / 256, c.G, bid, -1);
        EpiInProj E{(bf16_t*)(ws + WS_UEXT), (bf16_t*)(ws + WS_UPOOL), (bf16_t*)(ws + WS_GA), (bf16_t*)(ws + WS_GB)};
#if defined(SHADOW) && SHADOW == 1
        { EpiNull<true> E0; gemm_phase<0, false, EpiNull<true>, GridOrder, true>(ring, P, S, E0); }
#endif
        gemm_phase<0, false, EpiInProj, GridOrder, true>(ring, P, S, E);
    }
    SEAM(1);
    if (IN(2)) {
        Prob P{(const char*)(ws + WS_UEXT), (const char*)(ws + WS_WS), nullptr, (unsigned)(UEXT_LD * 2), 1024u, 128u, 8, 256, 0, c.wave};
        GridOrder S; S.init(NG * CHROWS / 256, 1, c.G, bid, 3);
        EpiS E{(float*)(ws + WS_S)};
        gemm_phase<0, false, EpiS, GridOrder, true>(ring, P, S, E);
        phase_pooling(pt, c);
    }
    SEAM(2);
    if (IN(3)) {
        phase_scan(pt, c);
        Prob P{(const char*)(ws + WS_POOLED), (const char*)(ws + WS_WPOOL), nullptr, 1024u, 1024u, 128u, 8, 0, 0, c.wave};
        GridOrder S; S.init(T / 256, 4, c.G, bid, -1);
        EpiPool E{(bf16_t*)(ws + WS_GB)};
        gemm_phase<0, false, EpiPool, GridOrder, true>(ring, P, S, E);
    }
    SEAM(3);
    if (IN(4)) {
        Prob P{(const char*)(ws + WS_UEXT), (const char*)(ws + WS_TV), nullptr, (unsigned)(UEXT_LD * 2), (unsigned)(UEXT_LD * 2), 128u, 10, 512, 0, c.wave};
        GridOrder S; S.init(NG * CHROWS / 256, 2, c.G, bid, 3);
        EpiBf16<1> E{(bf16_t*)(ws + WS_Z), 512};
        gemm_phase<0, false, EpiBf16<1>, GridOrder, true>(ring, P, S, E);
    }
    SEAM(4);
    if (IN(5)) {
        Prob P{(const char*)(ws + WS_Z), (const char*)(ws + WS_WGLU), nullptr, (unsigned)(2 * MiB), 1024u, (unsigned)(8 * MiB), 8, 0, 0, c.wave};
        GridOrder S; S.init(T / 256, 8, c.G, bid, -1);
        EpiGlu E{(bf16_t*)(ws + WS_GA), (const bf16_t*)(ws + WS_GB)};
        gemm_phase<1, false, EpiGlu, GridOrder, true>(ring, P, S, E);
    }
    SEAM(5);
    if (IN(6)) {
        Prob P{(const char*)(ws + WS_GA), (const char*)(ws + WS_WOUT), nullptr, 2048u, 2048u, 128u, 16, 0, 0, c.wave};
        GridOrder S; S.init(T / 256, 4, c.G, bid, -1);
        EpiWout E{pt.in(0), (bf16_t*)(ws + WS_H1)};
        gemm_phase<0, false, EpiWout, GridOrder, true>(ring, P, S, E);
    }
    SEAM(6);
    if (IN(7)) {
        phase_ln1(pt, c);
        Prob P{(const char*)(ws + WS_PB), (const char*)(ws + WS_WPP), nullptr, 512u, 512u, 128u, 4, 0, 0, c.wave};
        GridOrder S; S.init(T / 256, 4, c.G, bid, -1);
        EpiBf16<0> E{(bf16_t*)(ws + WS_PP), 1024};
        gemm_phase<0, false, EpiBf16<0>, GridOrder, true>(ring, P, S, E);
    }
    SEAM(7);
    if (IN(8)) {
        Prob P{(const char*)(ws + WS_H1), (const char*)(ws + WS_WPLE), nullptr, 2048u, 2048u, 128u, 16, 0, 0, c.wave};
        GridOrder S; S.init(T / 256, 5, c.G, bid, -1);
        EpiPle E{(const bf16_t*)(ws + WS_H1), (const bf16_t*)(ws + WS_PP), (bf16_t*)(ws + WS_BASE), pt.in(20), (int*)(ws + WS_TOPE), (float*)(ws + WS_TOPW)};
        gemm_phase<0, false, EpiPle, GridOrder, true>(ring, P, S, E);
    }
    SEAM(8);
    if (IN(9)) phase_route_count(pt, c);
    SEAM(9);
    if (IN(10)) phase_route_place(pt, c);
    SEAM(10);
#define MOE_SLAB(s) do { constexpr int pa = 11 + 2 * (s), pb = 12 + 2 * (s); \
        LAS int* tp = (LAS int*)(c.lds + TP_OFF); \
        if (IN(pa) || IN(pb)) { const int tid_ = c.wave * 64 + lane_id(); __syncthreads(); if (tid_ < 33) tp[tid_] = ((const int*)(ws + WS_CNT + 65536))[(s) * 64 + tid_]; __syncthreads(); } \
        if (IN(pa)) { \
            if ((s) > 0) phase_combine(pt, c, (s) - 1); \
            MoeOrder S; S.init((const PG8_LAS int*)tp, 8, c.G, bid); \
            if (MOE_FP8) { \
                Prob P{(const char*)(ws + WS_H1Q), (const char*)(ws + WS_WGU), (const int*)(ws + WS_ROWTOK) + (size_t)(s) * SLAB_ROWS, 1024u, 1024u, 128u, 8, 2048, IB_OFF, c.wave}; \
                EpiM1F8 E{(unsigned char*)(ws + WS_ACT), pt.in(22), pt.in(24)}; \
                gemm_phase<2, true, EpiM1F8, MoeOrder, true>(ring, P, S, E); \
            } else { \
                Prob P{(const char*)(ws + WS_H1), (const char*)(ws + WS_WGU), (const int*)(ws + WS_ROWTOK) + (size_t)(s) * SLAB_ROWS, 2048u, 2048u, 128u, 16, 2048, IB_OFF, c.wave}; \
                EpiM1 E{(bf16_t*)(ws + WS_ACT), pt.in(22), pt.in(24)}; \
                gemm_phase<2, false, EpiM1, MoeOrder, true>(ring, P, S, E); \
            } \
        } \
        SEAM(pa); \
        if (IN(pb)) { \
            MoeOrder S; S.init((const PG8_LAS int*)tp, 4, c.G, bid); \
            if (MOE_FP8) { \
                Prob P{(const char*)(ws + WS_ACT), (const char*)(ws + WS_WDN), nullptr, 1024u, 1024u, 128u, 8, 1024, 0, c.wave}; \
                EpiM2 E{(bf16_t*)(ws + WS_Y), pt.in(26), 0.015625f}; \
                gemm_phase<0, true, EpiM2, MoeOrder, true>(ring, P, S, E); \
            } else { \
                Prob P{(const char*)(ws + WS_ACT), (const char*)(ws + WS_WDN), nullptr, 2048u, 2048u, 128u, 16, 1024, 0, c.wave}; \
                EpiM2 E{(bf16_t*)(ws + WS_Y), pt.in(26), 1.0f}; \
                gemm_phase<0, false, EpiM2, MoeOrder, true>(ring, P, S, E); \
            } \
        } \
        SEAM(pb); } while (0)
    MOE_SLAB(0);
    MOE_SLAB(1);
#undef MOE_SLAB
    if (IN(15)) phase_combine(pt, c, NSLAB - 1);
#undef IN
#undef SEAM
}

extern "C" void kernel_launch(void* const* d_in, const int* in_sizes, int n_in, void* d_out, int out_size, void* d_ws, size_t ws_size, hipStream_t stream) {
    static int grid = 0;
    if (grid == 0) {
        if (n_in != 31 || in_sizes[0] != T * D || out_size != T * D || ws_size < WS_END) { fprintf(stderr, "kernel_launch: unexpected problem (n_in %d, in0 %d, out %d, ws %zu); nothing launched\n", n_in, n_in > 0 ? in_sizes[0] : -1, out_size, ws_size); grid = -1; return; }
        int dev = 0, cus = 0, per_cu = 0;
        if (hipGetDevice(&dev) != hipSuccess || hipDeviceGetAttribute(&cus, hipDeviceAttributeMultiprocessorCount, dev) != hipSuccess) { grid = -1; return; }
        if (hipFuncSetAttribute((const void*)mega_fwd, hipFuncAttributeMaxDynamicSharedMemorySize, LDS_BYTES) != hipSuccess) { fprintf(stderr, "kernel_launch: hipFuncSetAttribute failed\n"); grid = -1; return; }
        if (hipOccupancyMaxActiveBlocksPerMultiprocessor(&per_cu, (const void*)mega_fwd, NWAVES * 64, LDS_BYTES) != hipSuccess || per_cu < 1) { fprintf(stderr, "kernel_launch: occupancy query reports %d workgroups per CU\n", per_cu); }
        (void)hipGetLastError();
        grid = cus;
    }
    if (grid < 0) return;
    if (hipMemsetAsync((char*)d_ws + WS_CTL, 0, CTL_ZERO_BYTES, stream) != hipSuccess) return;
    Args a{};
    for (int i = 0; i < 31; ++i) a.in[i] = (const float*)d_in[i];
    a.out = (float*)d_out; a.ws = (unsigned char*)d_ws; a.pad = 0;
#if MK_PER_PHASE
    for (int ph = 0; ph < NPHASE; ++ph) { a.ph_lo = ph; a.ph_hi = ph + 1; a.li = 0; hipLaunchKernelGGL(mega_fwd, dim3(grid), dim3(NWAVES * 64), LDS_BYTES, stream, a); }
#elif defined(PROBE_REPEAT)
    a.ph_lo = 0; a.ph_hi = PROBE_REPEAT + 1; a.li = 0; hipLaunchKernelGGL(mega_fwd, dim3(grid), dim3(NWAVES * 64), LDS_BYTES, stream, a);
    a.ph_lo = PROBE_REPEAT; a.ph_hi = NPHASE; a.li = 1; hipLaunchKernelGGL(mega_fwd, dim3(grid), dim3(NWAVES * 64), LDS_BYTES, stream, a);
#else
    a.ph_lo = 0; a.ph_hi = NPHASE; a.li = 0;
    hipLaunchKernelGGL(mega_fwd, dim3(grid), dim3(NWAVES * 64), LDS_BYTES, stream, a);
#endif
}
```

```cpp
#include <hip/hip_runtime.h>
#include <cstdio>
#include <cstdint>

#ifndef SHADOW
#define SHADOW 0
#endif
#ifndef MOE_FP8
#define MOE_FP8 1
#endif
#ifndef Y_FP8
#define Y_FP8 1
#endif
#ifndef STAGGER_US
#define STAGGER_US 0
#endif
#ifndef MK_PER_PHASE
#define MK_PER_PHASE 0
#endif

namespace pg8 {
#define PG8_LAS __attribute__((address_space(3)))
typedef unsigned short bf16_t;
typedef short bf16x8 __attribute__((ext_vector_type(8)));
typedef float f32x4 __attribute__((ext_vector_type(4)));
typedef float f32x2 __attribute__((ext_vector_type(2)));
typedef unsigned u32x4 __attribute__((ext_vector_type(4)));
typedef unsigned u32x2 __attribute__((ext_vector_type(2)));
constexpr int BM = 256, BK = 64, HALF = 128, HTB = HALF * BK * 2  , STAGE_BYTES = 8 * HTB, NXCD = 8, WGM = 8;

__host__ __device__ __forceinline__ int lds_byte(int r, int c) { const int st = (r >> 4) * 2 + (c >> 5), rr = r & 15, cc = c & 31, ob = rr * 64 + cc * 2; return st * 1024 + (ob ^ (((ob >> 9) & 1) << 5)); }
__host__ __device__ __forceinline__ void stage_rc(int b, int& R, int& C) { const int st = b / 1024, sb = b % 1024, swz = sb ^ (((sb >> 9) & 1) << 5); R = (st >> 1) * 16 + swz / 64; C = (st & 1) * 32 + (swz % 64) / 2; }
__host__ __device__ __forceinline__ int perm32(int rho) { const int n = rho >> 4, i = rho & 15; return 8 * (i >> 2) + 4 * n + (i & 3); }

struct Unit { int pm, pn, aux; };

struct Prob {
    const char* A; const char* B; const int* gidx;
    unsigned lda;
    unsigned ldb;
    unsigned kstepA;
    int nt;
    int bgn;
    int ib_off;
    int wid;
};

struct GridOrder {
    int nM, nN, nwg, G, c, gshift;
    __device__ void init(int nM_, int nN_, int G_, int c_, int gshift_) { nM = nM_; nN = nN_; nwg = nM * nN; G = G_; c = c_; gshift = gshift_; }
    __device__ bool next(int i, Unit& u) const {
        const long L = (long)i * G + c; if (L >= nwg) return false;
        int wgid = (int)L; { const int q = nwg / NXCD, r = nwg % NXCD, xcd = wgid % NXCD, off = wgid / NXCD; wgid = (xcd < r ? xcd * (q + 1) : r * (q + 1) + (xcd - r) * q) + off; }
        const int nig = WGM * nN, gid = wgid / nig, fm = gid * WGM, gsz = (nM - fm) < WGM ? (nM - fm) : WGM;
        u.pm = fm + ((wgid % nig) % gsz); u.pn = (wgid % nig) / gsz; u.aux = gshift >= 0 ? (u.pm >> gshift) : 0; return true;
    }
};
struct MoeOrder {
    const PG8_LAS int* tp; int nct, total, G, c;
    __device__ void init(const PG8_LAS int* tp_, int nct_, int G_, int c_) { tp = tp_; nct = nct_; G = G_; c = c_; total = __builtin_amdgcn_readfirstlane(tp_[32]) * nct_; }
    __device__ bool next(int i, Unit& u) const {
        const long L = (long)i * G + c; if (L >= total) return false;
        int wgid = (int)L; { const int q = total / NXCD, r = total % NXCD, xcd = wgid % NXCD, off = wgid / NXCD; wgid = (xcd < r ? xcd * (q + 1) : r * (q + 1) + (xcd - r) * q) + off; }
        int ln = (int)__builtin_amdgcn_mbcnt_hi(~0u, __builtin_amdgcn_mbcnt_lo(~0u, 0u)); asm volatile("" : "+v"(ln));
        int e = __builtin_popcountll(__ballot(ln < 31 && wgid >= tp[(ln < 31 ? ln : 30) + 1] * nct)); e = __builtin_amdgcn_readfirstlane(e);
        const int t0 = __builtin_amdgcn_readfirstlane(tp[e]), nte = __builtin_amdgcn_readfirstlane(tp[e + 1]) - t0, local = wgid - t0 * nct;
        u.pn = __builtin_amdgcn_readfirstlane(local / nte); u.pm = __builtin_amdgcn_readfirstlane(t0 + local % nte); u.aux = e; return true;
    }
};

__device__ __forceinline__ unsigned cvt_pk_bf16(float lo, float hi) { unsigned r; asm volatile("v_cvt_pk_bf16_f32 %0, %1, %2" : "=v"(r) : "v"(lo), "v"(hi)); return r; }
__device__ __forceinline__ float bf_lo(unsigned w) { return __uint_as_float(w << 16); }
__device__ __forceinline__ float bf_hi(unsigned w) { return __uint_as_float(w & 0xffff0000u); }
__device__ __forceinline__ float sigmoid_f(float x) { return __builtin_amdgcn_rcpf(1.0f + __builtin_amdgcn_exp2f(-1.4426950409f * x)); }

typedef int v4i __attribute__((ext_vector_type(4)));
typedef int v8i __attribute__((ext_vector_type(8)));
template <bool FP8> __device__ __forceinline__ void stage_map(int p, int& R, int& Cb) {
    if (FP8) { R = (p >> 11) * 16 + ((p & 255) >> 4); Cb = ((p & 2047) >> 8) * 16; }
    else { int C; stage_rc(p, R, C); Cb = 2 * C; }
}
template <int AMODE, bool FP8, class Epi, class Sched, bool ALIGN_EPI>
__device__ __forceinline__ void gemm_phase(PG8_LAS unsigned char* lds, const Prob P, const Sched& S, const Epi& E) {
    const int wid = P.wid, lane = (int)__builtin_amdgcn_mbcnt_hi(~0u, __builtin_amdgcn_mbcnt_lo(~0u, 0u)), tid = wid * 64 + lane, wr = wid >> 2, wc = wid & 3, fr = lane & 15, fq = lane >> 4;
    const int nt = P.nt;
    unsigned vo[2][2], voffB[2];
#pragma unroll
    for (int i = 0; i < 2; ++i) { int R, Cb; stage_map<FP8>(tid * 16 + i * 8192, R, Cb); const int Rb = Epi::PERM ? ((R & ~31) + perm32(R & 31)) : R;
        voffB[i] = (unsigned)Rb * P.ldb + (unsigned)Cb;
#pragma unroll
        for (int h = 0; h < 2; ++h) {
            if (AMODE == 0) vo[h][i] = (unsigned)(h * HALF + R) * P.lda + (unsigned)Cb;
            else if (AMODE == 1) vo[h][i] = (unsigned)(Cb >> 5) * P.lda + (unsigned)(h * HALF + R) * 32u + (unsigned)(Cb & 31);
            else vo[h][i] = 0u; } }
    const unsigned kstepA = P.kstepA, kstepB = (unsigned)(BK * 2);
    const unsigned hstepB = (unsigned)HALF * P.ldb;
    const unsigned ldsw = (unsigned)wid * 1024u;
    const int aoff = FP8 ? (wr * 4 * 2048 + 2 * fq * 256 + fr * 16) : lds_byte(wr * 64 + fr, fq * 8), boff = FP8 ? (wc * 2 * 2048 + 2 * fq * 256 + fr * 16) : lds_byte(wc * 32 + fr, fq * 8);
    constexpr int KOFF = FP8 ? 256 : 1024;
    const int sc1 = 0x7F7F7F7F;
#define PG8_AOFF(u) ((unsigned)(AMODE == 0 ? (unsigned)(u).pm * BM * P.lda : (AMODE == 1 ? (unsigned)(u).pm * BM * 32u : 0u)))
#define PG8_BOFF(u) ((unsigned)(((unsigned)(u).aux * P.bgn + (unsigned)(u).pn * BM) * P.ldb))
#define PG8_GIDX(src, dst) do { _Pragma("unroll") for (int _i = 0; _i < 2; ++_i) { int _R, _C; stage_map<FP8>(tid * 16 + _i * 8192, _R, _C); _Pragma("unroll") for (int _h = 0; _h < 2; ++_h) \
        dst[_h][_i] = (unsigned)(src)[_h * HALF + _R] * P.lda + (unsigned)_C; } } while (0)
#define PG8_SA(b, h) (((b) * 2 + (h)) * HTB)
#define PG8_SB(b, h) ((4 + (b) * 2 + (h)) * HTB)
    const __amdgpu_buffer_rsrc_t rsA = __builtin_amdgcn_make_buffer_rsrc((void*)P.A, 0, 0xFFFFFFFF, 0x00020000);
    const __amdgpu_buffer_rsrc_t rsB = __builtin_amdgcn_make_buffer_rsrc((void*)P.B, 0, 0xFFFFFFFF, 0x00020000);
#define PG8_STAGE2(bufoff, rs, so, v0, v1) do { \
        __builtin_amdgcn_raw_ptr_buffer_load_lds(rs, (PG8_LAS void*)(lds + (bufoff) + ldsw), 16, (int)(v0), (int)(so), 0, 0); \
        __builtin_amdgcn_raw_ptr_buffer_load_lds(rs, (PG8_LAS void*)(lds + (bufoff) + ldsw + 8192), 16, (int)(v1), (int)(so), 0, 0); } while (0)
#define PG8_STAGE_A(bufoff, so, h) PG8_STAGE2(bufoff, rsA, so, vo[h][0], vo[h][1])
#define PG8_STAGE_B(bufoff, so) PG8_STAGE2(bufoff, rsB, so, voffB[0], voffB[1])
#define PG8_LDA(dst, b, h) do { _Pragma("unroll") for (int m = 0; m < 4; ++m) _Pragma("unroll") for (int k = 0; k < 2; ++k) dst[m][k] = *(const PG8_LAS bf16x8*)(lds + PG8_SA(b, h) + aoff + m * 2048 + k * KOFF); } while (0)
#define PG8_LDB(dst, b, h) do { _Pragma("unroll") for (int n = 0; n < 2; ++n) _Pragma("unroll") for (int k = 0; k < 2; ++k) dst[n][k] = *(const PG8_LAS bf16x8*)(lds + PG8_SB(b, h) + boff + n * 2048 + k * KOFF); } while (0)
#define PG8_MMA(ai, bj, At, Bt) do { __builtin_amdgcn_s_setprio(1); _Pragma("unroll") for (int m = 0; m < 4; ++m) _Pragma("unroll") for (int n = 0; n < 2; ++n) { \
        if constexpr (FP8) { acc[ai][bj][m][n] = __builtin_amdgcn_mfma_scale_f32_16x16x128_f8f6f4( \
                __builtin_shufflevector(__builtin_bit_cast(v4i, Bt[n][0]), __builtin_bit_cast(v4i, Bt[n][1]), 0, 1, 2, 3, 4, 5, 6, 7), \
                __builtin_shufflevector(__builtin_bit_cast(v4i, At[m][0]), __builtin_bit_cast(v4i, At[m][1]), 0, 1, 2, 3, 4, 5, 6, 7), acc[ai][bj][m][n], 0, 0, 0, 0, 0, 0); } \
        else { _Pragma("unroll") for (int k = 0; k < 2; ++k) acc[ai][bj][m][n] = __builtin_amdgcn_mfma_f32_16x16x32_bf16(Bt[n][k], At[m][k], acc[ai][bj][m][n], 0, 0, 0); } } \
        __builtin_amdgcn_s_setprio(0); } while (0)
#define PG8_WAIT_V(n) asm volatile("s_waitcnt vmcnt(" #n ")" ::: "memory")
#define PG8_WAIT_L(n) asm volatile("s_waitcnt lgkmcnt(" #n ")" ::: "memory")
#define PG8_BAR __builtin_amdgcn_s_barrier()
#define PG8_SCHED __builtin_amdgcn_sched_barrier(0)
    Unit cur, nxt; int ui = 0;
    if (!S.next(0, cur)) return;
    f32x4 acc[2][2][4][2];
#pragma unroll
    for (int a = 0; a < 2; ++a)
#pragma unroll
        for (int b = 0; b < 2; ++b)
#pragma unroll
            for (int m = 0; m < 4; ++m)
#pragma unroll
                for (int n = 0; n < 2; ++n) acc[a][b][m][n] = (f32x4){0.f, 0.f, 0.f, 0.f};
    bf16x8 At[4][2], B0[2][2], B1[2][2];
    unsigned cA = PG8_AOFF(cur), cB = PG8_BOFF(cur);
    if (AMODE == 2) { const int* gi = P.gidx + cur.pm * BM; PG8_GIDX(gi, vo); }
    PG8_STAGE_B(PG8_SB(0, 0), cB); PG8_STAGE_B(PG8_SB(0, 1), cB + hstepB); PG8_STAGE_A(PG8_SA(0, 0), cA, 0); PG8_STAGE_A(PG8_SA(0, 1), cA, 1);
    if (wr == 1) PG8_BAR;
    PG8_WAIT_V(2); PG8_BAR;
    PG8_STAGE_B(PG8_SB(1, 0), cB + kstepB); PG8_STAGE_A(PG8_SA(1, 0), cA + kstepA, 0); PG8_STAGE_B(PG8_SB(1, 1), cB + hstepB + kstepB);
    PG8_WAIT_V(6); PG8_BAR;
    for (;;) {
        const bool has_next = S.next(ui + 1, nxt);
        const unsigned nA = has_next ? PG8_AOFF(nxt) : cA, nB = has_next ? PG8_BOFF(nxt) : cB;
#pragma nounroll
        for (int t = 0; t < nt; t += 2) {
            const bool last = (t == nt - 2);
            const unsigned a1 = cA + (unsigned)(t + 1) * kstepA;
            const unsigned a2 = last ? nA : cA + (unsigned)(t + 2) * kstepA, b2 = last ? nB : cB + (unsigned)(t + 2) * kstepB;
            const unsigned a3 = a2 + kstepA, b3 = b2 + kstepB;
            if (AMODE == 2) { if (t == 0 && has_next && wid < 4)
                    __builtin_amdgcn_global_load_lds((const unsigned*)(P.gidx + nxt.pm * BM + wid * 64 + lane), (PG8_LAS unsigned*)(lds + P.ib_off + (((ui + 1) & 1) * 256 + wid * 64) * 4), 4, 0, 0); }
            PG8_LDB(B0, 0, 0); PG8_LDB(B1, 0, 1); PG8_SCHED; PG8_LDA(At, 0, 0); PG8_STAGE_A(PG8_SA(1, 1), a1, 1);
            if (AMODE == 2) { if (last && has_next) { const PG8_LAS int* ib = (const PG8_LAS int*)(lds + P.ib_off) + ((ui + 1) & 1) * 256; PG8_GIDX(ib, vo); } }
            PG8_WAIT_V(8); PG8_WAIT_L(0); PG8_BAR; PG8_MMA(0, 0, At, B0); PG8_MMA(0, 1, At, B1); PG8_BAR; PG8_SCHED;
            PG8_LDA(At, 0, 1); PG8_STAGE_B(PG8_SB(0, 0), b2); PG8_STAGE_B(PG8_SB(0, 1), b2 + hstepB); PG8_STAGE_A(PG8_SA(0, 0), a2, 0);
            PG8_WAIT_V(8); PG8_WAIT_L(0); PG8_BAR; PG8_MMA(1, 0, At, B0); PG8_MMA(1, 1, At, B1); PG8_BAR; PG8_SCHED;
            PG8_LDB(B0, 1, 0); PG8_LDB(B1, 1, 1); PG8_SCHED; PG8_LDA(At, 1, 0); PG8_STAGE_A(PG8_SA(0, 1), a2, 1);
            PG8_WAIT_V(8); PG8_WAIT_L(0); PG8_BAR; PG8_MMA(0, 0, At, B0); PG8_MMA(0, 1, At, B1); PG8_BAR; PG8_SCHED;
            PG8_LDA(At, 1, 1); PG8_STAGE_B(PG8_SB(1, 0), b3); PG8_STAGE_B(PG8_SB(1, 1), b3 + hstepB); PG8_STAGE_A(PG8_SA(1, 0), a3, 0);
            PG8_WAIT_V(8); PG8_WAIT_L(0); PG8_BAR; PG8_MMA(1, 0, At, B0); PG8_MMA(1, 1, At, B1); PG8_BAR; PG8_SCHED;
        }
        if constexpr (ALIGN_EPI) { if (wr == 0) PG8_BAR; }
        { int fr2 = fr, fq2 = fq; asm volatile("" : "+v"(fr2), "+v"(fq2));
          E(acc, cur, wr, wc, fr2, fq2); }
        if (!has_next) break;
#pragma unroll
        for (int a = 0; a < 2; ++a)
#pragma unroll
            for (int b = 0; b < 2; ++b)
#pragma unroll
                for (int m = 0; m < 4; ++m)
#pragma unroll
                    for (int n = 0; n < 2; ++n) acc[a][b][m][n] = (f32x4){0.f, 0.f, 0.f, 0.f};
        cur = nxt; cA = nA; cB = nB; ++ui;
        if constexpr (ALIGN_EPI) { if (wr == 1) PG8_BAR; }
    }
    PG8_WAIT_V(0);
    if constexpr (!ALIGN_EPI) { if (wr == 0) PG8_BAR; }
    PG8_BAR;
#undef PG8_AOFF
#undef PG8_BOFF
#undef PG8_GIDX
#undef PG8_SA
#undef PG8_SB
#undef PG8_STAGE2
#undef PG8_STAGE_B
#undef PG8_STAGE_A
#undef PG8_LDA
#undef PG8_LDB
#undef PG8_MMA
#undef PG8_WAIT_V
#undef PG8_WAIT_L
#undef PG8_BAR
#undef PG8_SCHED
}
}

constexpr int NWAVES = 8;
constexpr int BATCH = 16, SEQ = 4096, D = 1024, T = BATCH * SEQ;
constexpr int PLE = 256, SSMW = 512, POOLW = 512, NG = 32, GH = 16, NP = 64;
constexpr int LC = 32, NCH = SEQ / LC, CHROWS = BATCH * NCH;
constexpr int UEXT_LD = 640;
constexpr int NEXP = 32, TOPK = 4, NIN = 3072;
#ifndef MOE_NSLAB
#define MOE_NSLAB 1
#endif
constexpr int NSLAB = MOE_NSLAB, WPS = 256 / NSLAB  , SLAB_T = T / NSLAB, SLAB_ROWS = (SLAB_T * TOPK / 256 + NEXP) * 256;
constexpr float LN_EPS = 1e-5f, DN_ALPHA = 1.189207115002721f, SW_LIMIT = 7.0f, SW_ALPHA = 1.702f;
constexpr int NPHASE = 12 + 2 * NSLAB;

constexpr size_t MiB = 1u << 20;
constexpr size_t WS_WGU = 0 * MiB;
constexpr size_t WS_WDN = 128 * MiB;
constexpr size_t WS_WIN = 192 * MiB;
constexpr size_t WS_WGLU = 198 * MiB;
constexpr size_t WS_WPOOL = 200 * MiB;
constexpr size_t WS_WOUT = 201 * MiB;
constexpr size_t WS_WPLE = 203 * MiB;
constexpr size_t WS_WPP = 206 * MiB;
constexpr size_t WS_WS = 207 * MiB;
constexpr size_t WS_TV = 215 * MiB;
constexpr size_t WS_CTL = 235 * MiB;
constexpr size_t WS_TOPE = 236 * MiB;
constexpr size_t WS_TOPW = 237 * MiB;
constexpr size_t WS_ROWTOK = 238 * MiB;
constexpr size_t WS_SLOTPOS = 240 * MiB;
constexpr size_t WS_CNT = 242 * MiB;
constexpr size_t WS_XB = 244 * MiB;
constexpr size_t WS_H1 = 244 * MiB;
constexpr size_t WS_UEXT = 372 * MiB;
constexpr size_t WS_UPOOL = 452 * MiB;
constexpr size_t WS_PP = 372 * MiB;
constexpr size_t WS_GA = 516 * MiB;
constexpr size_t WS_GB = 644 * MiB;
constexpr size_t WS_POOLED = 772 * MiB;
constexpr size_t WS_S = 836 * MiB;
constexpr size_t WS_Z = 868 * MiB;
constexpr size_t WS_PB = 932 * MiB;
constexpr size_t WS_ACT = (NSLAB == 1 ? 244 : 372) * MiB;
constexpr size_t WS_BASE = 580 * MiB;
constexpr size_t WS_Y = (NSLAB == 1 ? 708 : 752) * MiB;
constexpr size_t WS_H1Q = 516 * MiB;
constexpr size_t WS_END = 1024 * MiB;
static_assert(MOE_FP8 && Y_FP8, "the workspace map below assumes e4m3 act and y");
static_assert(WS_BASE + (size_t)T * 2048 <= WS_Y && WS_H1Q + (size_t)T * 1024 <= WS_BASE && WS_ACT + (size_t)SLAB_ROWS * 1024 <= WS_H1Q && WS_Y + (size_t)SLAB_ROWS * 1024 <= WS_END && (size_t)NSLAB * SLAB_ROWS * 4 <= 2 * MiB && WS_PB + (size_t)T * PLE * 2 <= WS_END, "ws map");
constexpr size_t CTL_ZERO_BYTES = 1 * MiB;
constexpr int CW_BAR = 4096;

constexpr int RING_BYTES = 131072;
constexpr int LDSCTL_OFF = RING_BYTES, MISC_OFF = LDSCTL_OFF + 320;
constexpr int TP_OFF = LDSCTL_OFF + 1024, IB_OFF = TP_OFF + 512, PTAB_OFF = IB_OFF + 2048;
constexpr int LDS_BYTES = 147456;

#define GAS __attribute__((address_space(1)))
#define LAS __attribute__((address_space(3)))
typedef unsigned short bf16;
typedef unsigned v4u __attribute__((ext_vector_type(4)));
typedef unsigned v2u __attribute__((ext_vector_type(2)));
typedef float f32x4 __attribute__((ext_vector_type(4)));
typedef GAS unsigned gu32;
#define RLX_AGENT __ATOMIC_RELAXED, __HIP_MEMORY_SCOPE_AGENT
#define LDS_WAIT() asm volatile("s_waitcnt lgkmcnt(0)" ::: "memory")
#define VM_WAIT() asm volatile("s_waitcnt vmcnt(0)" ::: "memory")
__device__ __forceinline__ unsigned f2bf(float f) { unsigned u = __builtin_bit_cast(unsigned, f); return (u + 0x7fffu + ((u >> 16) & 1u)) >> 16; }
__device__ __forceinline__ unsigned pk2(float lo, float hi) { return f2bf(lo) | (f2bf(hi) << 16); }
__device__ __forceinline__ float bf2f(unsigned short b) { return __uint_as_float(((unsigned)b) << 16); }

#define XB_TMO      128
#define XB_XCNT(j)  (256  + 64 * (j))
#define XB_XSUB(j)  (1280 + 64 * (j))
#define XB_XGEN(j)  (2304 + 64 * (j))
#define XB_TOP      3328
#define XB_TOPGEN   3392
#define XCD_BAR_WORDS 3456
#define XB_SPIN_CAP (1u << 18)

__device__ __forceinline__ unsigned xb_ld(unsigned* p)              { return __hip_atomic_load(p, __ATOMIC_RELAXED, __HIP_MEMORY_SCOPE_AGENT); }
__device__ __forceinline__ unsigned xb_add(unsigned* p, unsigned v) { return __hip_atomic_fetch_add(p, v, __ATOMIC_RELAXED, __HIP_MEMORY_SCOPE_AGENT); }
__device__ __forceinline__ unsigned xb_xcc_id() { return (unsigned)__builtin_amdgcn_s_getreg((3 << 11) | 20) & 0xFu; }
#define XB_SPIN(cond, bar) do { unsigned _sp = 0; while (cond) { __builtin_amdgcn_s_sleep(1); \
    if ((++_sp & 255u) == 0u) { if (xb_ld(&(bar)[XB_TMO])) break; if (_sp > XB_SPIN_CAP) { atomicAdd(&(bar)[XB_TMO], 1u); break; } } } } while (0)

struct XcdBarrier {
    unsigned* bar; unsigned x;
    volatile LAS unsigned* st;
};

__device__ __forceinline__ XcdBarrier xcd_barrier_post(unsigned* bar, volatile LAS unsigned* st) {
    XcdBarrier b; b.bar = bar; b.x = xb_xcc_id(); b.st = st;
    if (threadIdx.x == 0) (void)xb_add(&bar[XB_XCNT(b.x)], 1u);
    return b;
}
__device__ __forceinline__ void xcd_barrier_complete(unsigned* bar, unsigned x, unsigned& nloc, unsigned& nx) {
    const unsigned G = gridDim.x * gridDim.y * gridDim.z;
    unsigned sum, cnt, mine, sp = 0u;
    for (;;) {
        sum = 0u; cnt = 0u; mine = 0u;
#pragma unroll
        for (unsigned j = 0; j < 16; ++j) { const unsigned c = xb_ld(&bar[XB_XCNT(j)]); sum += c; cnt += (c > 0u) ? 1u : 0u; mine = (j == x) ? c : mine; }
        if (sum == G) break;
        __builtin_amdgcn_s_sleep(1);
        if ((++sp & 255u) == 0u) { if (xb_ld(&bar[XB_TMO])) break; if (sp > XB_SPIN_CAP) { atomicAdd(&bar[XB_TMO], 1u); break; } }
    }
    nloc = mine > 0u ? mine : 1u; nx = cnt > 0u ? cnt : 1u;
}

__device__ __forceinline__ void xcd_barrier(const XcdBarrier& b) {
    asm volatile("s_waitcnt vmcnt(0)" ::: "memory");
    __syncthreads();
    if (threadIdx.x == 0) {
        unsigned* bar = b.bar;
        __builtin_amdgcn_s_waitcnt(0);
        unsigned nloc = b.st[0], nx = b.st[1];
        if (nloc == 0u) { xcd_barrier_complete(bar, b.x, nloc, nx); b.st[0] = nloc; b.st[1] = nx; }
        const unsigned old = xb_add(&bar[XB_XSUB(b.x)], 1u);
        const unsigned gen = old / nloc;
        if (old + 1u == (gen + 1u) * nloc) {
            __builtin_amdgcn_fence(__ATOMIC_RELEASE, "agent");
            asm volatile("s_waitcnt vmcnt(0)" ::: "memory");
            const unsigned og = xb_add(&bar[XB_TOP], 1u);
            const unsigned tg = og / nx;
            if (og + 1u == (tg + 1u) * nx) xb_add(&bar[XB_TOPGEN], 1u);
            else XB_SPIN(xb_ld(&bar[XB_TOPGEN]) == tg, bar);
            __builtin_amdgcn_fence(__ATOMIC_ACQUIRE, "agent");
            xb_add(&bar[XB_XGEN(b.x)], 1u);
            asm volatile("s_waitcnt vmcnt(0)" ::: "memory");
        } else {
            XB_SPIN(xb_ld(&bar[XB_XGEN(b.x)]) == gen, bar);
            __builtin_amdgcn_fence(__ATOMIC_ACQUIRE, "agent");
            asm volatile("s_waitcnt vmcnt(0)" ::: "memory");
        }
    }
    __syncthreads();
}

namespace pg8 {
#define EPI_ROW(u, ai, m) ((u).pm * BM + (ai) * HALF + wr * 64 + (m) * 16 + fr)
#define EPI_COL8(u, bj) ((u).pn * BM + (bj) * HALF + wc * 32 + 8 * fq)
#define EPI_COL4(u, bj, n) ((u).pn * BM + (bj) * HALF + wc * 32 + 16 * (n) + 4 * fq)
__device__ __forceinline__ u32x4 pack8(const f32x4 a, const f32x4 b) { u32x4 w; w.x = cvt_pk_bf16(a[0], a[1]); w.y = cvt_pk_bf16(a[2], a[3]); w.z = cvt_pk_bf16(b[0], b[1]); w.w = cvt_pk_bf16(b[2], b[3]); return w; }
__device__ __forceinline__ void unpack8(const u32x4 w, f32x4& a, f32x4& b) { a = (f32x4){bf_lo(w.x), bf_hi(w.x), bf_lo(w.y), bf_hi(w.y)}; b = (f32x4){bf_lo(w.z), bf_hi(w.z), bf_lo(w.w), bf_hi(w.w)}; }
__device__ __forceinline__ f32x4 sig4(const f32x4 v) { return (f32x4){sigmoid_f(v[0]), sigmoid_f(v[1]), sigmoid_f(v[2]), sigmoid_f(v[3])}; }
__device__ __forceinline__ float gelu_tanh(float x) { return x * sigmoid_f(1.5957691216f * (x + 0.044715f * x * x * x)); }

template <bool PERM_> struct EpiNull {
    static constexpr bool PERM = PERM_;
    __device__ __forceinline__ void operator()(const f32x4 (&acc)[2][2][4][2], const Unit& u, int wr, int wc, int fr, int fq) const {
#pragma unroll
        for (int ai = 0; ai < 2; ++ai)
#pragma unroll
            for (int bj = 0; bj < 2; ++bj)
#pragma unroll
                for (int m = 0; m < 4; ++m)
#pragma unroll
                    for (int n = 0; n < 2; ++n) asm volatile("" :: "v"(acc[ai][bj][m][n]));
    }
};
struct EpiInProj {
    static constexpr bool PERM = true;
    bf16_t* uext; bf16_t* upool; bf16_t* ga; bf16_t* gb;
    __device__ __forceinline__ void operator()(const f32x4 (&acc)[2][2][4][2], const Unit& u, int wr, int wc, int fr, int fq) const {
#pragma unroll
        for (int ai = 0; ai < 2; ++ai)
#pragma unroll
            for (int m = 0; m < 4; ++m) { const int t = EPI_ROW(u, ai, m);
#pragma unroll
                for (int bj = 0; bj < 2; ++bj) { const int c = EPI_COL8(u, bj); f32x4 v0 = acc[ai][bj][m][0], v1 = acc[ai][bj][m][1]; bf16_t* dst;
                    if (u.pn < 2) { const int g = c >> 4, h0 = c & 15; dst = uext + ((size_t)g * 2048 + (size_t)(t >> 5)) * 640 + (size_t)((t & 31) * 16 + h0); }
                    else if (u.pn < 4) dst = upool + (size_t)t * 512 + (c - 512);
                    else { v0 = sig4(v0); v1 = sig4(v1); dst = (u.pn < 8) ? ga + (size_t)t * 1024 + (c - 1024) : gb + (size_t)t * 1024 + (c - 2048); }
                    *(u32x4*)dst = pack8(v0, v1); } }
    }
};
struct EpiS {
    static constexpr bool PERM = false;
    float* S;
    __device__ __forceinline__ void operator()(const f32x4 (&acc)[2][2][4][2], const Unit& u, int wr, int wc, int fr, int fq) const {
#pragma unroll
        for (int ai = 0; ai < 2; ++ai)
#pragma unroll
            for (int m = 0; m < 4; ++m) { float* rowp = S + (size_t)EPI_ROW(u, ai, m) * 128 + wc * 32 + 4 * fq;
#pragma unroll
                for (int n = 0; n < 2; ++n) *(f32x4*)(rowp + 16 * n) = acc[ai][0][m][n]; }
    }
};
template <int ACT> struct EpiBf16 {
    static constexpr bool PERM = true;
    bf16_t* O; int ldc;
    __device__ __forceinline__ void operator()(const f32x4 (&acc)[2][2][4][2], const Unit& u, int wr, int wc, int fr, int fq) const {
#pragma unroll
        for (int ai = 0; ai < 2; ++ai)
#pragma unroll
            for (int m = 0; m < 4; ++m) { bf16_t* rowp = O + (size_t)EPI_ROW(u, ai, m) * ldc;
#pragma unroll
                for (int bj = 0; bj < 2; ++bj) { f32x4 v0 = acc[ai][bj][m][0], v1 = acc[ai][bj][m][1];
                    if (ACT == 1) {
#pragma unroll
                        for (int j = 0; j < 4; ++j) { v0[j] = gelu_tanh(v0[j]); v1[j] = gelu_tanh(v1[j]); } }
                    *(u32x4*)(rowp + EPI_COL8(u, bj)) = pack8(v0, v1); } }
    }
};
struct EpiPool {
    static constexpr bool PERM = true;
    bf16_t* gb;
    __device__ __forceinline__ void operator()(const f32x4 (&acc)[2][2][4][2], const Unit& u, int wr, int wc, int fr, int fq) const {
#pragma unroll
        for (int ai = 0; ai < 2; ++ai)
#pragma unroll
            for (int m = 0; m < 4; ++m) { bf16_t* rowp = gb + (size_t)EPI_ROW(u, ai, m) * 1024;
#pragma unroll
                for (int bj = 0; bj < 2; ++bj) { u32x4* p = (u32x4*)(rowp + EPI_COL8(u, bj)); f32x4 g0, g1; unpack8(*p, g0, g1);
                    *p = pack8(g0 * acc[ai][bj][m][0], g1 * acc[ai][bj][m][1]); } }
    }
};
struct EpiGlu {
    static constexpr bool PERM = true;
    bf16_t* ga; const bf16_t* gb;
    __device__ __forceinline__ void operator()(const f32x4 (&acc)[2][2][4][2], const Unit& u, int wr, int wc, int fr, int fq) const {
#pragma unroll
        for (int ai = 0; ai < 2; ++ai)
#pragma unroll
            for (int m = 0; m < 4; ++m) { const size_t off = (size_t)EPI_ROW(u, ai, m) * 1024 + (size_t)(u.pn * HALF + wc * 32 + 8 * fq);
                u32x4* pa = (u32x4*)(ga + off); f32x4 a0, a1, t0, t1; unpack8(*pa, a0, a1); unpack8(*(const u32x4*)(gb + off), t0, t1);
                const f32x4 y0 = acc[ai][0][m][0] * sig4(acc[ai][1][m][0]), y1 = acc[ai][0][m][1] * sig4(acc[ai][1][m][1]);
                *pa = pack8(a0 * y0 + t0, a1 * y1 + t1); }
    }
};
struct EpiWout {
    static constexpr bool PERM = true;
    bf16_t* s;
    __device__ __forceinline__ void operator()(const f32x4 (&acc)[2][2][4][2], const Unit& u, int wr, int wc, int fr, int fq) const {
        u32x4 xv[2][4][2];
#pragma unroll
        for (int ai = 0; ai < 2; ++ai) {
#pragma unroll
            for (int m = 0; m < 4; ++m)
#pragma unroll
                for (int bj = 0; bj < 2; ++bj) xv[ai & 1][m][bj] = *(const u32x4*)(s + (size_t)EPI_ROW(u, ai, m) * 1024 + EPI_COL8(u, bj));
#pragma unroll
            for (int m = 0; m < 4; ++m)
#pragma unroll
                for (int bj = 0; bj < 2; ++bj) { f32x4 x0, x1; unpack8(xv[ai & 1][m][bj], x0, x1);
                    *(u32x4*)(s + (size_t)EPI_ROW(u, ai, m) * 1024 + EPI_COL8(u, bj)) = pack8(x0 * 1.189207115002721f + acc[ai][bj][m][0], x1 * 1.189207115002721f + acc[ai][bj][m][1]); }
            asm volatile("" ::: "memory"); }
    }
};
struct EpiPle {
    static constexpr bool PERM = true;
    const bf16_t* h1; const bf16_t* pp; bf16_t* base; const float* brouter; int* tope; float* topw;
    __device__ __forceinline__ void operator()(const f32x4 (&acc)[2][2][4][2], const Unit& u, int wr, int wc, int fr, int fq) const {
        if (u.pn < 4) {
#pragma unroll
            for (int ai = 0; ai < 2; ++ai) { u32x4 hv[4][2], pv[4][2];
#pragma unroll
                for (int m = 0; m < 4; ++m)
#pragma unroll
                    for (int bj = 0; bj < 2; ++bj) { const size_t o = (size_t)EPI_ROW(u, ai, m) * 1024 + EPI_COL8(u, bj); hv[m][bj] = *(const u32x4*)(h1 + o); pv[m][bj] = *(const u32x4*)(pp + o); }
#pragma unroll
                for (int m = 0; m < 4; ++m)
#pragma unroll
                    for (int bj = 0; bj < 2; ++bj) { const size_t o = (size_t)EPI_ROW(u, ai, m) * 1024 + EPI_COL8(u, bj); f32x4 h0, h1v, p0, p1; unpack8(hv[m][bj], h0, h1v); unpack8(pv[m][bj], p0, p1);
                        *(u32x4*)(base + o) = pack8(h0 * 1.189207115002721f + sig4(acc[ai][bj][m][0]) * p0, h1v * 1.189207115002721f + sig4(acc[ai][bj][m][1]) * p1); }
                asm volatile("" ::: "memory"); }
        } else if (wc == 0) {
            const f32x4 b0 = *(const f32x4*)(brouter + 8 * fq), b1 = *(const f32x4*)(brouter + 8 * fq + 4);
#pragma unroll
            for (int ai = 0; ai < 2; ++ai)
#pragma unroll
                for (int m = 0; m < 4; ++m) {
                    float v[8]; const f32x4 l0 = acc[ai][0][m][0] + acc[ai][1][m][0] + b0, l1 = acc[ai][0][m][1] + acc[ai][1][m][1] + b1;
#pragma unroll
                    for (int i = 0; i < 4; ++i) { v[i] = l0[i]; v[4 + i] = l1[i]; }
                    float tv[4]; int te[4];
#pragma unroll
                    for (int r = 0; r < 4; ++r) {
                        float bv = -3.0e38f; int bi = 0;
#pragma unroll
                        for (int i = 0; i < 8; ++i) { if (v[i] > bv) { bv = v[i]; bi = i; } }
                        const int be = 8 * fq + bi;
                        float gv = bv; int ge = be;
#pragma unroll
                        for (int o = 16; o <= 32; o <<= 1) { const float ov = __shfl_xor(gv, o); const int oe = __shfl_xor(ge, o); if (ov > gv || (ov == gv && oe < ge)) { gv = ov; ge = oe; } }
                        tv[r] = gv; te[r] = ge;
                        if (ge == be) {
#pragma unroll
                            for (int i = 0; i < 8; ++i) if (i == bi) v[i] = -3.0e38f; }
                    }
                    if (fq == 0) { const float e1 = __expf(tv[1] - tv[0]), e2 = __expf(tv[2] - tv[0]), e3 = __expf(tv[3] - tv[0]); const float inv = 1.0f / (1.0f + e1 + e2 + e3);
                        const int t = EPI_ROW(u, ai, m);
                        *(int4*)(tope + (size_t)t * 4) = make_int4(te[0], te[1], te[2], te[3]);
                        *(float4*)(topw + (size_t)t * 4) = make_float4(inv, e1 * inv, e2 * inv, e3 * inv); }
                }
        }
    }
};
struct EpiM1 {
    static constexpr bool PERM = true;
    bf16_t* act; const float* bgate; const float* bup;
    __device__ __forceinline__ void operator()(const f32x4 (&acc)[2][2][4][2], const Unit& u, int wr, int wc, int fr, int fq) const {
        const int col = u.pn * HALF + wc * 32 + 8 * fq; const float* bg = bgate + (size_t)u.aux * 1024 + col; const float* bu = bup + (size_t)u.aux * 1024 + col;
        const f32x4 g0 = *(const f32x4*)bg, g1 = *(const f32x4*)(bg + 4), u0 = *(const f32x4*)bu, u1 = *(const f32x4*)(bu + 4);
#pragma unroll
        for (int ai = 0; ai < 2; ++ai)
#pragma unroll
            for (int m = 0; m < 4; ++m) { f32x4 o[2];
#pragma unroll
                for (int n = 0; n < 2; ++n) { const f32x4 gg = acc[ai][0][m][n] + (n ? g1 : g0), uu = acc[ai][1][m][n] + (n ? u1 : u0);
#pragma unroll
                    for (int j = 0; j < 4; ++j) { const float g = fminf(gg[j], 7.0f), up = fminf(fmaxf(uu[j], -7.0f), 7.0f); o[n][j] = (up + 1.0f) * (g * sigmoid_f(1.702f * g)); } }
                *(u32x4*)(act + (size_t)EPI_ROW(u, ai, m) * 1024 + col) = pack8(o[0], o[1]); }
    }
};
__device__ __forceinline__ u32x2 pack8_fp8(const f32x4 a, const f32x4 b) { int w0 = 0, w1 = 0;
    w0 = __builtin_amdgcn_cvt_pk_fp8_f32(a[0], a[1], w0, false); w0 = __builtin_amdgcn_cvt_pk_fp8_f32(a[2], a[3], w0, true);
    w1 = __builtin_amdgcn_cvt_pk_fp8_f32(b[0], b[1], w1, false); w1 = __builtin_amdgcn_cvt_pk_fp8_f32(b[2], b[3], w1, true); return (u32x2){(unsigned)w0, (unsigned)w1}; }
struct EpiM1F8 {
    static constexpr bool PERM = true;
    unsigned char* act; const float* bgate; const float* bup;
    __device__ __forceinline__ void operator()(const f32x4 (&acc)[2][2][4][2], const Unit& u, int wr, int wc, int fr, int fq) const {
        const int col = u.pn * HALF + wc * 32 + 8 * fq; const float* bg = bgate + (size_t)u.aux * 1024 + col; const float* bu = bup + (size_t)u.aux * 1024 + col;
        const f32x4 g0 = *(const f32x4*)bg, g1 = *(const f32x4*)(bg + 4), u0 = *(const f32x4*)bu, u1 = *(const f32x4*)(bu + 4);
#pragma unroll
        for (int ai = 0; ai < 2; ++ai)
#pragma unroll
            for (int m = 0; m < 4; ++m) { f32x4 o[2];
#pragma unroll
                for (int n = 0; n < 2; ++n) { const f32x4 gg = acc[ai][0][m][n] * 0.03125f + (n ? g1 : g0), uu = acc[ai][1][m][n] * 0.03125f + (n ? u1 : u0);
#pragma unroll
                    for (int j = 0; j < 4; ++j) { const float g = fminf(gg[j], 7.0f), up = fminf(fmaxf(uu[j], -7.0f), 7.0f); o[n][j] = (up + 1.0f) * (g * sigmoid_f(1.702f * g)); } }
                *(u32x2*)(act + (size_t)(u.pm * BM + ai * HALF + wr * 64 + m * 16 + fr) * 1024 + col) = pack8_fp8(o[0], o[1]); }
    }
};
struct EpiM2 {
    static constexpr bool PERM = true;
    unsigned char* y; const float* bdown; float sc;
    __device__ __forceinline__ void operator()(const f32x4 (&acc)[2][2][4][2], const Unit& u, int wr, int wc, int fr, int fq) const {
        f32x4 b[2][2];
#pragma unroll
        for (int bj = 0; bj < 2; ++bj) { const float* bp = bdown + (size_t)u.aux * 1024 + EPI_COL8(u, bj); b[bj][0] = *(const f32x4*)bp; b[bj][1] = *(const f32x4*)(bp + 4); }
#pragma unroll
        for (int ai = 0; ai < 2; ++ai)
#pragma unroll
            for (int m = 0; m < 4; ++m) { const size_t ro = (size_t)EPI_ROW(u, ai, m) * 1024;
#pragma unroll
                for (int bj = 0; bj < 2; ++bj) { const f32x4 v0 = acc[ai][bj][m][0] * sc + b[bj][0], v1 = acc[ai][bj][m][1] * sc + b[bj][1];
                    if (Y_FP8) *(u32x2*)(y + ro + EPI_COL8(u, bj)) = pack8_fp8(v0, v1);
                    else *(u32x4*)((bf16_t*)y + ro + EPI_COL8(u, bj)) = pack8(v0, v1); } }
    }
};
#undef EPI_ROW
#undef EPI_COL8
#undef EPI_COL4
}

struct Args { const float* in[31]; float* out; unsigned char* ws; int ph_lo, ph_hi, li, pad; };
struct Ctx { LAS unsigned char* lds; int tid, lane, wave, vcu, G, gw, ngw; };
__device__ __forceinline__ int lane_id() { return (int)__builtin_amdgcn_mbcnt_hi(~0u, __builtin_amdgcn_mbcnt_lo(~0u, 0u)); }
struct PT { const LAS unsigned long long* t;
    __device__ __forceinline__ unsigned long long get(int k) const { const unsigned long long v = t[k]; const unsigned lo = __builtin_amdgcn_readfirstlane((unsigned)v), hi = __builtin_amdgcn_readfirstlane((unsigned)(v >> 32)); return ((unsigned long long)hi << 32) | lo; }
    __device__ __forceinline__ const float* in(int k) const { return (const float*)get(k); }
    __device__ __forceinline__ float* out() const { return (float*)get(31); }
    __device__ __forceinline__ unsigned char* ws() const { return (unsigned char*)get(32); } };

__device__ __forceinline__ float wave_sum(float v) {
#pragma unroll
    for (int o = 1; o < 64; o <<= 1) v += __shfl_xor(v, o);
    return v;
}
__device__ __forceinline__ void p0_transpose_item(const float* W, int K, int N, bf16* WT, int dst_row0, LAS unsigned char* scr, int kb, int nb, int lane) {
    const int k0 = 64 * kb, n0 = 64 * nb, kr = lane >> 4, nq = lane & 15;
    f32x4 v[16];
#pragma unroll
    for (int i = 0; i < 16; ++i) v[i] = *(const f32x4*)(W + (size_t)(k0 + 4 * i + kr) * N + n0 + 4 * nq);
#pragma unroll
    for (int i = 0; i < 16; ++i) { const int k = 4 * i + kr;
#pragma unroll
        for (int j = 0; j < 4; ++j) *(LAS unsigned short*)(scr + (4 * nq + j) * 144 + 2 * k) = (unsigned short)f2bf(v[i][j]); }
    LDS_WAIT(); asm volatile("" ::: "memory");
    const int c = lane & 7;
#pragma unroll
    for (int j = 0; j < 8; ++j) { const int n = (lane >> 3) + 8 * j; const v4u o = *(const LAS v4u*)(scr + n * 144 + 16 * c);
        *(v4u*)(WT + (size_t)(dst_row0 + n) * K + k0 + 8 * c) = o; }
    LDS_WAIT(); asm volatile("" ::: "memory");
}
__device__ __forceinline__ unsigned char f2fp8(float x) { return (unsigned char)(__builtin_amdgcn_cvt_pk_fp8_f32(x, x, 0, false) & 0xff); }
struct T8Item { const float* W; unsigned char* WT; int dst_row0, k0, n0; float sc; };
__device__ __forceinline__ void t8_load(const T8Item& it, f32x4 (&v)[16], int lane) { const int kr = lane >> 3, nq = lane & 7;
#pragma unroll
    for (int i = 0; i < 16; ++i) v[i] = *(const f32x4*)(it.W + (size_t)(it.k0 + 8 * i + kr) * 1024 + it.n0 + 4 * nq); }
__device__ __forceinline__ void t8_store(const T8Item& it, const f32x4 (&v)[16], LAS unsigned char* scr, int lane) { const int kr = lane >> 3, nq = lane & 7;
#pragma unroll
    for (int i = 0; i < 16; ++i) { const int k = 8 * i + kr;
#pragma unroll
        for (int j = 0; j < 4; ++j) *(LAS unsigned char*)(scr + (4 * nq + j) * 144 + k) = f2fp8(v[i][j] * it.sc); }
    LDS_WAIT(); asm volatile("" ::: "memory");
#pragma unroll
    for (int j = 0; j < 4; ++j) { const int q = lane + 64 * j, n = q >> 3, c = q & 7; const v4u o = *(const LAS v4u*)(scr + n * 144 + 16 * c);
        *(v4u*)(it.WT + (size_t)(it.dst_row0 + n) * 1024 + it.k0 + 16 * c) = o; }
    LDS_WAIT(); asm volatile("" ::: "memory");
}
__device__ __forceinline__ void cv_load(const float* src, f32x4 (&v)[16], int lane) { const f32x4* s = (const f32x4*)src + lane;
#pragma unroll
    for (int j = 0; j < 16; ++j) v[j] = s[64 * j]; }
__device__ __forceinline__ void cv_store(bf16* dst, const f32x4 (&v)[16], int lane) { v2u* o = (v2u*)dst + lane;
#pragma unroll
    for (int j = 0; j < 16; ++j) { v2u w; w.x = pk2(v[j].x, v[j].y); w.y = pk2(v[j].z, v[j].w); o[64 * j] = w; } }
struct cplx { float re, im; };
__device__ __forceinline__ cplx cmul(cplx a, cplx b) { return cplx{a.re * b.re - a.im * b.im, a.re * b.im + a.im * b.re}; }
__device__ __forceinline__ cplx lam_pow(float lre, float lim, float step, float tau) { const float m = __expf(lre * step * tau); float s, c; sincosf(lim * step * tau, &s, &c); return cplx{m * c, m * s}; }
__device__ __forceinline__ cplx bbar_fac(float lre, float lim, float step) { const cplx lb = lam_pow(lre, lim, step, 1.0f); const float nr = lb.re - 1.0f, ni = lb.im, d = 1.0f / (lre * lre + lim * lim);
    return cplx{(nr * lre + ni * lim) * d, (ni * lre - nr * lim) * d}; }

__device__ __forceinline__ void phase_prologue(const PT a, const Ctx& c0) {
    Ctx c = c0; c.lane = lane_id(); c.tid = c.wave * 64 + c.lane;
    unsigned char* ws = a.ws();
    LAS float* scr = (LAS float*)(c.lds + c.wave * 16384);
    const float *w_in = a.in(2), *lre = a.in(3), *lim = a.in(4), *lstep = a.in(5), *bre = a.in(6), *bim = a.in(7), *cre = a.in(8), *cim = a.in(9), *dsk = a.in(10);
    const float *wval = a.in(11), *wgt = a.in(12), *wgrp = a.in(13), *pscale = a.in(14), *wpp = a.in(15), *wout = a.in(16), *wrt = a.in(19);
    const float *wgate = a.in(21), *wup = a.in(23), *wdown = a.in(25), *wpleg = a.in(27), *wplep = a.in(28);
    constexpr int I_IN = 16 * 48, I_GL = 8 * 16, I_SQ = 16 * 16, I_PP = 4 * 16, I_E = 32 * I_SQ;
    constexpr int NITEMS = I_IN + 2 * I_GL + 2 * I_SQ + I_PP + (MOE_FP8 ? 0 : 3 * I_E);
    LAS unsigned char* scrb = (LAS unsigned char*)scr;
    for (int it = c.gw; it < NITEMS; it += c.ngw) {
        int r = it;
        if (r < I_IN) { p0_transpose_item(w_in, 1024, 3072, (bf16*)(ws + WS_WIN), 64 * (r % 48), scrb, r / 48, r % 48, c.lane); continue; } r -= I_IN;
        if (r < 2 * I_GL) { const int which = r / I_GL, q = r % I_GL, nb = q % 16, n0 = 64 * nb;
            p0_transpose_item(which ? wgt : wval, 512, 1024, (bf16*)(ws + WS_WGLU), (n0 >> 7) * 256 + (n0 & 127) + which * 128, scrb, q / 16, nb, c.lane); continue; } r -= 2 * I_GL;
        if (r < I_SQ) { p0_transpose_item(wout, 1024, 1024, (bf16*)(ws + WS_WOUT), 64 * (r % 16), scrb, r / 16, r % 16, c.lane); continue; } r -= I_SQ;
        if (r < I_SQ) { p0_transpose_item(wpleg, 1024, 1024, (bf16*)(ws + WS_WPLE), 64 * (r % 16), scrb, r / 16, r % 16, c.lane); continue; } r -= I_SQ;
        if (r < I_PP) { p0_transpose_item(wplep, 256, 1024, (bf16*)(ws + WS_WPP), 64 * (r % 16), scrb, r / 16, r % 16, c.lane); continue; } r -= I_PP;
#if !MOE_FP8
        if (r < 2 * I_E) { const int which = r / I_E, q = r % I_E, e = q / I_SQ, qq = q % I_SQ, nb = qq % 16, n0 = 64 * nb;
            p0_transpose_item((which ? wup : wgate) + (size_t)e * 1048576, 1024, 1024, (bf16*)(ws + WS_WGU) + (size_t)e * 2048 * 1024, (n0 >> 7) * 256 + (n0 & 127) + which * 128, scrb, qq / 16, nb, c.lane); continue; } r -= 2 * I_E;
        { const int e = r / I_SQ, qq = r % I_SQ; p0_transpose_item(wdown + (size_t)e * 1048576, 1024, 1024, (bf16*)(ws + WS_WDN) + (size_t)e * 1048576, 64 * (qq % 16), scrb, qq / 16, qq % 16, c.lane); }
#endif
    }
    { constexpr int NCX = T / 4, NCV = NCX + T / 16; const float* xs = a.in(0); const float* ps = a.in(1);
#define CV_SRC(m_) ((m_) < NCX ? xs + (size_t)(m_) * 4096 : ps + (size_t)((m_) - NCX) * 4096)
#define CV_DST(m_) ((m_) < NCX ? (bf16*)(ws + WS_XB) + (size_t)(m_) * 4096 : (bf16*)(ws + WS_PB) + (size_t)((m_) - NCX) * 4096)
      int m = c.gw; f32x4 va[16], vb[16];
      if (m < NCV) { cv_load(CV_SRC(m), va, c.lane);
        for (;;) {
            const int m2 = m + c.ngw; const bool h2 = m2 < NCV; if (h2) cv_load(CV_SRC(m2), vb, c.lane);
            cv_store(CV_DST(m), va, c.lane);
            if (!h2) break;
            const int m3 = m2 + c.ngw; const bool h3 = m3 < NCV; if (h3) cv_load(CV_SRC(m3), va, c.lane);
            cv_store(CV_DST(m2), vb, c.lane);
            if (!h3) break;
            m = m3; } }
#undef CV_SRC
#undef CV_DST
    }
    { bf16* W = (bf16*)(ws + WS_WPLE) + (size_t)1024 * 1024;
      for (int ch = c.gw * 64 + c.lane; ch < 256 * 128; ch += c.ngw * 64) { const int r = ch >> 7, k0 = (ch & 127) * 8; unsigned o[4] = {0u, 0u, 0u, 0u};
          if (r < 32 || (r >= 128 && r < 160)) { const int e = r & 31; float f[8];
#pragma unroll
              for (int j = 0; j < 8; ++j) { const float w = wrt[(size_t)(k0 + j) * 32 + e]; const float hi = bf2f((unsigned short)f2bf(w)); f[j] = (r < 32) ? hi : (w - hi); }
#pragma unroll
              for (int j = 0; j < 4; ++j) o[j] = pk2(f[2 * j], f[2 * j + 1]); }
          *(v4u*)(W + (size_t)r * 1024 + k0) = (v4u){o[0], o[1], o[2], o[3]}; } }
    for (int it = c.gw; it < 64 * 16; it += c.ngw) { const int c0 = (it >> 4) * 8, d = (it & 15) * 64 + c.lane, g = c0 >> 7; float s[8];
#pragma unroll
        for (int i = 0; i < 8; ++i) s[i] = 0.f;
        for (int j = 0; j < 128; ++j) { const float pw = pscale[g * 128 + j] * wpp[(size_t)(g * 128 + j) * 1024 + d];
#pragma unroll
            for (int i = 0; i < 8; ++i) s[i] += wgrp[(size_t)(g * 128 + (c0 & 127) + i) * 128 + j] * pw; }
        *(v4u*)((bf16*)(ws + WS_WPOOL) + (size_t)d * 512 + c0) = (v4u){pk2(s[0], s[1]), pk2(s[2], s[3]), pk2(s[4], s[5]), pk2(s[6], s[7])}; }
    { bf16* TV = (bf16*)(ws + WS_TV);
      if ((c.gw & 3) == 0 && (c.gw >> 2) < 512) { const int it = c.gw >> 2, g = it >> 4, h = it & 15, hp = c.lane & 15, pq = c.lane >> 4; const float step = __expf(lstep[g]);
          float Kt[32];
#pragma unroll
          for (int tt = 0; tt < 32; ++tt) Kt[tt] = 0.f;
          for (int pi = 0; pi < 16; ++pi) { const int p = pq * 16 + pi; const float lr = lre[g * 64 + p], li = lim[g * 64 + p]; const cplx lb = lam_pow(lr, li, step, 1.0f), bf = bbar_fac(lr, li, step);
              const cplx bb = cmul(bf, cplx{bre[(size_t)(g * 64 + p) * 16 + hp], bim[(size_t)(g * 64 + p) * 16 + hp]});
              cplx w = cmul(cplx{cre[(size_t)(g * 16 + h) * 64 + p], cim[(size_t)(g * 16 + h) * 64 + p]}, bb);
#pragma unroll
              for (int tt = 0; tt < 32; ++tt) { Kt[tt] += w.re; w = cmul(w, lb); } }
#pragma unroll
          for (int tt = 0; tt < 32; ++tt) { Kt[tt] += __shfl_xor(Kt[tt], 16); Kt[tt] += __shfl_xor(Kt[tt], 32); }
          if (h == hp) Kt[0] += dsk[g * 16 + h];
#pragma unroll
          for (int tt = 0; tt < 32; ++tt) { if ((tt >> 3) == pq) { const bf16 v = (bf16)f2bf(Kt[tt]);
              for (int s = 0; s + tt < 32; ++s) TV[((size_t)g * 512 + (size_t)(s + tt) * 16 + h) * 640 + s * 16 + hp] = v; } } }
      for (int it = c.gw; it < 32 * 512; it += c.ngw) { const int g = it >> 9, n = it & 511, j = n >> 4, h = n & 15; bf16* row = TV + (size_t)it * 640;
          if (c.lane * 8 >= (j + 1) * 16) *(v4u*)(row + c.lane * 8) = (v4u){0u, 0u, 0u, 0u};
          const int p = c.lane; const float step = __expf(lstep[g]); const cplx lp = lam_pow(lre[g * 64 + p], lim[g * 64 + p], step, (float)(j + 1));
          const cplx mv = cmul(cplx{cre[(size_t)(g * 16 + h) * 64 + p], cim[(size_t)(g * 16 + h) * 64 + p]}, lp);
          row[512 + p] = (bf16)f2bf(mv.re); row[576 + p] = (bf16)f2bf(-mv.im); }
      bf16* WS = (bf16*)(ws + WS_WS);
      for (int it = c.gw; it < 32 * 256; it += c.ngw) { const int g = it >> 8, n = it & 255; v4u o = (v4u){0u, 0u, 0u, 0u};
          if (n < 128) { const int p = n & 63, s = c.lane >> 1, h0 = (c.lane & 1) * 8; const float step = __expf(lstep[g]), lr = lre[g * 64 + p], li = lim[g * 64 + p];
              const cplx f = cmul(lam_pow(lr, li, step, (float)(31 - s)), bbar_fac(lr, li, step)); float v[8];
#pragma unroll
              for (int i = 0; i < 8; ++i) { const cplx r = cmul(f, cplx{bre[(size_t)(g * 64 + p) * 16 + h0 + i], bim[(size_t)(g * 64 + p) * 16 + h0 + i]}); v[i] = (n < 64) ? r.re : r.im; }
              o = (v4u){pk2(v[0], v[1]), pk2(v[2], v[3]), pk2(v[4], v[5]), pk2(v[6], v[7])}; }
          *(v4u*)(WS + (size_t)it * 512 + c.lane * 8) = o; } }
}

__device__ __forceinline__ void phase_moe_convert(const PT a, const Ctx& c0) {
    Ctx c = c0; c.lane = lane_id(); c.tid = c.wave * 64 + c.lane;
    unsigned char* ws = a.ws(); LAS unsigned char* scrb = c.lds + c.wave * 16384;
    const float *wgate = a.in(21), *wup = a.in(23), *wdown = a.in(25);
    { constexpr int NT8 = 3 * 32 * 256;
#define T8_DECODE(r_, it_) do { const int which_ = (r_) / 8192, q_ = (r_) % 8192, e_ = q_ >> 8, qq_ = q_ & 255, nb_ = qq_ & 31, n0_ = 32 * nb_; \
        it_.k0 = 128 * (qq_ >> 5); it_.n0 = n0_; \
        if (which_ < 2) { it_.W = (which_ ? wup : wgate) + (size_t)e_ * 1048576; it_.WT = (unsigned char*)(ws + WS_WGU) + (size_t)e_ * 2048 * 1024; it_.dst_row0 = (n0_ >> 7) * 256 + (n0_ & 127) + which_ * 128; it_.sc = 32.0f; } \
        else { it_.W = wdown + (size_t)e_ * 1048576; it_.WT = (unsigned char*)(ws + WS_WDN) + (size_t)e_ * 1048576; it_.dst_row0 = n0_; it_.sc = 64.0f; } } while (0)
      int r = c.gw; T8Item ia, ib; f32x4 va[16], vb[16];
      if (r < NT8) { T8_DECODE(r, ia); t8_load(ia, va, c.lane);
        for (;;) {
            const int r2 = r + c.ngw; const bool h2 = r2 < NT8; if (h2) { T8_DECODE(r2, ib); t8_load(ib, vb, c.lane); }
            t8_store(ia, va, scrb, c.lane);
            if (!h2) break;
            const int r3 = r2 + c.ngw; const bool h3 = r3 < NT8; if (h3) { T8_DECODE(r3, ia); t8_load(ia, va, c.lane); }
            t8_store(ib, vb, scrb, c.lane);
            if (!h3) break;
            r = r3; } }
#undef T8_DECODE
    }
}

__device__ __forceinline__ void unpack8f(const v4u v, float (&f)[8]) { f[0] = pg8::bf_lo(v.x); f[1] = pg8::bf_hi(v.x); f[2] = pg8::bf_lo(v.y); f[3] = pg8::bf_hi(v.y); f[4] = pg8::bf_lo(v.z); f[5] = pg8::bf_hi(v.z); f[6] = pg8::bf_lo(v.w); f[7] = pg8::bf_hi(v.w); }
__device__ __forceinline__ void phase_pooling(const PT a, const Ctx& c0) {
    Ctx c = c0; c.lane = lane_id(); c.tid = c.wave * 64 + c.lane;
    const bf16* up = (const bf16*)(a.ws() + WS_UPOOL) + c.lane * 8; bf16* po = (bf16*)(a.ws() + WS_POOLED) + c.lane * 8;
    const int w = 2 << (c.lane >> 4);
    for (int run = c.gw; run < T / 32; run += c.ngw) { const int t0 = run * 32, pos0 = t0 & (SEQ - 1);
        float s[8];
#pragma unroll
        for (int i = 0; i < 8; ++i) s[i] = 0.f;
        for (int j = 1; j < w; ++j) { if (pos0 - j >= 0) { float f[8]; unpack8f(*(const v4u*)(up + (size_t)(t0 - j) * 512), f);
#pragma unroll
                for (int i = 0; i < 8; ++i) s[i] += f[i]; } }
#pragma unroll 4
        for (int q = 0; q < 32; ++q) { const int t = t0 + q, pos = pos0 + q; float f[8], o[8]; unpack8f(*(const v4u*)(up + (size_t)t * 512), f);
            const int cnt = (pos + 1 < w) ? pos + 1 : w; const float inv = 1.0f / (float)cnt;
#pragma unroll
            for (int i = 0; i < 8; ++i) { s[i] += f[i]; o[i] = s[i] * inv - f[i]; }
            *(v4u*)(po + (size_t)t * 512) = (v4u){pk2(o[0], o[1]), pk2(o[2], o[3]), pk2(o[4], o[5]), pk2(o[6], o[7])};
            if (pos - w + 1 >= 0) { float g[8]; unpack8f(*(const v4u*)(up + (size_t)(t - w + 1) * 512), g);
#pragma unroll
                for (int i = 0; i < 8; ++i) s[i] -= g[i]; } } }
}

__device__ __forceinline__ void phase_scan(const PT a, const Ctx& c0) {
    Ctx c = c0; c.lane = lane_id(); c.tid = c.wave * 64 + c.lane;
    const float* S = (const float*)(a.ws() + WS_S); bf16* ue = (bf16*)(a.ws() + WS_UEXT);
    const float *lre = a.in(3), *lim = a.in(4), *lstep = a.in(5);
    for (int it = c.gw; it < NG * BATCH; it += c.ngw) { const int g = it >> 4, b = it & 15, p = c.lane;
        const cplx l32 = lam_pow(lre[g * 64 + p], lim[g * 64 + p], __expf(lstep[g]), 32.0f);
        const float* sp = S + ((size_t)g * 2048 + (size_t)b * 128) * 128 + p; bf16* up = ue + ((size_t)g * 2048 + (size_t)b * 128) * 640 + 512 + p;
        cplx X{0.f, 0.f};
        for (int c0 = 0; c0 < NCH; c0 += 16) { float sr[16], si[16];
#pragma unroll
            for (int j = 0; j < 16; ++j) { sr[j] = sp[(size_t)(c0 + j) * 128]; si[j] = sp[(size_t)(c0 + j) * 128 + 64]; }
#pragma unroll
            for (int j = 0; j < 16; ++j) { up[(size_t)(c0 + j) * 640] = (bf16)f2bf(X.re); up[(size_t)(c0 + j) * 640 + 64] = (bf16)f2bf(X.im);
                const cplx n = cmul(l32, X); X.re = n.re + sr[j]; X.im = n.im + si[j]; } } }
}

__device__ __forceinline__ void phase_ln1(const PT a, const Ctx& c0) {
    Ctx c = c0; c.lane = lane_id(); c.tid = c.wave * 64 + c.lane;
    bf16* h1 = (bf16*)(a.ws() + WS_H1); const float *g1 = a.in(17), *b1 = a.in(18);
    f32x4 gv[4], bv[4];
#pragma unroll
    for (int j = 0; j < 4; ++j) { gv[j] = ((const f32x4*)g1)[c.lane + 64 * j]; bv[j] = ((const f32x4*)b1)[c.lane + 64 * j]; }
    for (int m0 = c.gw * 4; m0 < T; m0 += c.ngw * 4) {
        v2u q[4][4];
#pragma unroll
        for (int r = 0; r < 4; ++r) { const v2u* xr = (const v2u*)(h1 + (size_t)(m0 + r) * 1024) + c.lane;
#pragma unroll
            for (int j = 0; j < 4; ++j) q[r][j] = xr[64 * j]; }
#pragma unroll
        for (int r = 0; r < 4; ++r) { const int m = m0 + r; f32x4 v[4]; float sm = 0.f;
#pragma unroll
            for (int j = 0; j < 4; ++j) { v[j] = (f32x4){pg8::bf_lo(q[r][j].x), pg8::bf_hi(q[r][j].x), pg8::bf_lo(q[r][j].y), pg8::bf_hi(q[r][j].y)}; sm += (v[j].x + v[j].y) + (v[j].z + v[j].w); }
            const float mean = wave_sum(sm) * (1.f / 1024.f); float s2 = 0.f;
#pragma unroll
            for (int j = 0; j < 4; ++j) { v[j] = v[j] - mean; s2 += (v[j].x * v[j].x + v[j].y * v[j].y) + (v[j].z * v[j].z + v[j].w * v[j].w); }
            const float rstd = 1.f / sqrtf(wave_sum(s2) * (1.f / 1024.f) + LN_EPS);
            v2u* o = (v2u*)(h1 + (size_t)m * 1024) + c.lane; unsigned* oq = (unsigned*)(a.ws() + WS_H1Q + (size_t)m * 1024) + c.lane;
#pragma unroll
            for (int j = 0; j < 4; ++j) { const f32x4 y = v[j] * rstd * gv[j] + bv[j]; v2u w; w.x = pk2(y.x, y.y); w.y = pk2(y.z, y.w); o[64 * j] = w;
                if (MOE_FP8) { int qq = 0; qq = __builtin_amdgcn_cvt_pk_fp8_f32(y.x, y.y, qq, false); qq = __builtin_amdgcn_cvt_pk_fp8_f32(y.z, y.w, qq, true); oq[64 * j] = (unsigned)qq; } } } }
}

__device__ __forceinline__ void phase_route_count(const PT a, const Ctx& c0) {
    Ctx c = c0; c.lane = lane_id(); c.tid = c.wave * 64 + c.lane;
    LAS int* hist = (LAS int*)c.lds; const int* tope = (const int*)(a.ws() + WS_TOPE); int* cnt = (int*)(a.ws() + WS_CNT);
    for (int w = blockIdx.x; w < 256; w += c.G) {
        if (c.tid < 32) hist[c.tid] = 0;
        __syncthreads();
        { const int slot = c.tid * 2; const int2 e2 = *(const int2*)(tope + (size_t)w * 1024 + slot); atomicAdd((int*)&hist[e2.x], 1); atomicAdd((int*)&hist[e2.y], 1); }
        __syncthreads();
        if (c.tid < 32) cnt[w * 32 + c.tid] = hist[c.tid];
        __syncthreads();
    }
}
__device__ __forceinline__ void phase_route_place(const PT a, const Ctx& c0) {
    Ctx c = c0; c.lane = lane_id(); c.tid = c.wave * 64 + c.lane;
    LAS int* L = (LAS int*)c.lds;
    const int* tope = (const int*)(a.ws() + WS_TOPE); const int* cnt = (const int*)(a.ws() + WS_CNT); int* tpg = (int*)(a.ws() + WS_CNT + 65536);
    for (int w = blockIdx.x; w < 256; w += c.G) { const int s = w / WPS, wl = w % WPS;
        int* rowtok = (int*)(a.ws() + WS_ROWTOK) + (size_t)s * SLAB_ROWS; int* slotpos = (int*)(a.ws() + WS_SLOTPOS);
        if (c.tid < 32) { int tot = 0, pre = 0; for (int q = 0; q < WPS; ++q) { const int v = cnt[(s * WPS + q) * 32 + c.tid]; tot += v; pre += (q < wl) ? v : 0; } L[c.tid] = tot; L[32 + c.tid] = pre; L[96 + c.tid] = 0; }
        __syncthreads();
        if (c.tid == 0) { int acc = 0; for (int e = 0; e < 32; ++e) { L[128 + e] = acc; L[64 + e] = acc * 256; acc += (L[e] + 255) >> 8; } L[160] = acc;
            if (wl == 0) for (int e = 0; e <= 32; ++e) tpg[s * 64 + e] = L[128 + e]; }
        __syncthreads();
        { const int slot = c.tid * 2, tok = w * 256 + (slot >> 2); const int2 e2 = *(const int2*)(tope + (size_t)w * 1024 + slot);
#pragma unroll
          for (int q = 0; q < 2; ++q) { const int e = q ? e2.y : e2.x; const int r = atomicAdd((int*)&L[96 + e], 1); const int pos = L[64 + e] + L[32 + e] + r;
              rowtok[pos] = tok; slotpos[(size_t)tok * 4 + ((slot + q) & 3)] = pos; } }
        if (wl < 32) { const int e = wl, tot = L[e], end = ((tot + 255) >> 8) << 8; for (int r = tot + c.tid; r < end; r += 512) rowtok[L[64 + e] + r] = s * SLAB_T; }
        __syncthreads();
    }
}
__device__ __forceinline__ void phase_combine(const PT a, const Ctx& c0, int s) {
    Ctx c = c0; c.lane = lane_id(); c.tid = c.wave * 64 + c.lane;
    const bf16* y = (const bf16*)(a.ws() + WS_Y); const float* topw = (const float*)(a.ws() + WS_TOPW); float* out = a.out(); const float *g2 = a.in(29), *b2 = a.in(30);
    f32x4 gv[4], bv[4];
#pragma unroll
    for (int j = 0; j < 4; ++j) { gv[j] = ((const f32x4*)g2)[c.lane + 64 * j]; bv[j] = ((const f32x4*)b2)[c.lane + 64 * j]; }
    const bf16* base = (const bf16*)(a.ws() + WS_BASE);
    for (int tl = c.gw; tl < SLAB_T; tl += c.ngw) { const int t = s * SLAB_T + tl; f32x4* xr = (f32x4*)(out + (size_t)t * 1024) + c.lane; f32x4 v[4]; const v2u* br = (const v2u*)(base + (size_t)t * 1024) + c.lane;
        const float4 wk = *(const float4*)(topw + (size_t)t * 4); const float wv[4] = {wk.x, wk.y, wk.z, wk.w};
        const int4 pk = *(const int4*)((const int*)(a.ws() + WS_SLOTPOS) + (size_t)t * 4); const int pv[4] = {pk.x, pk.y, pk.z, pk.w};
#pragma unroll
        for (int j = 0; j < 4; ++j) { const v2u q = br[64 * j]; v[j] = (f32x4){pg8::bf_lo(q.x), pg8::bf_hi(q.x), pg8::bf_lo(q.y), pg8::bf_hi(q.y)}; }
#pragma unroll
        for (int k = 0; k < 4; ++k) {
            if (Y_FP8) { const unsigned* yr = (const unsigned*)((const unsigned char*)y + (size_t)pv[k] * 1024) + c.lane;
#pragma unroll
                for (int j = 0; j < 4; ++j) { const unsigned q = yr[64 * j]; const auto lo = __builtin_amdgcn_cvt_pk_f32_fp8((int)q, false), hi = __builtin_amdgcn_cvt_pk_f32_fp8((int)q, true);
                    v[j] = v[j] + (f32x4){lo[0], lo[1], hi[0], hi[1]} * wv[k]; } }
            else { const v2u* yr = (const v2u*)(y + (size_t)pv[k] * 1024) + c.lane;
#pragma unroll
                for (int j = 0; j < 4; ++j) { const v2u q = yr[64 * j]; v[j] = v[j] + (f32x4){pg8::bf_lo(q.x), pg8::bf_hi(q.x), pg8::bf_lo(q.y), pg8::bf_hi(q.y)} * wv[k]; } } }
        float sm = 0.f;
#pragma unroll
        for (int j = 0; j < 4; ++j) sm += (v[j].x + v[j].y) + (v[j].z + v[j].w);
        const float mean = wave_sum(sm) * (1.f / 1024.f); float s2 = 0.f;
#pragma unroll
        for (int j = 0; j < 4; ++j) { v[j] = v[j] - mean; s2 += (v[j].x * v[j].x + v[j].y * v[j].y) + (v[j].z * v[j].z + v[j].w * v[j].w); }
        const float rstd = 1.f / sqrtf(wave_sum(s2) * (1.f / 1024.f) + LN_EPS);
#pragma unroll
        for (int j = 0; j < 4; ++j) xr[64 * j] = v[j] * rstd * gv[j] + bv[j]; }
}

__global__ void __launch_bounds__(NWAVES * 64, 2) mega_fwd(Args args) {
    extern __shared__ __attribute__((aligned(16))) unsigned char lds_raw[];
    Ctx c;
    c.lds = (LAS unsigned char*)lds_raw;
    c.tid = threadIdx.x; c.lane = c.tid & 63; c.wave = __builtin_amdgcn_readfirstlane(c.tid >> 6);
    c.G = gridDim.x; { const int bx = blockIdx.x; c.vcu = (c.G % 8 == 0) ? (bx % 8) * (c.G / 8) + bx / 8 : bx; }
    c.gw = c.vcu * NWAVES + c.wave; c.ngw = c.G * NWAVES;
    volatile LAS unsigned* MISC = (volatile LAS unsigned*)(c.lds + MISC_OFF);
    for (int u = c.tid; u < (LDS_BYTES - LDSCTL_OFF) / 4; u += NWAVES * 64) ((LAS unsigned*)(c.lds + LDSCTL_OFF))[u] = 0u;
    __syncthreads();
    { LAS unsigned long long* ptw = (LAS unsigned long long*)(c.lds + PTAB_OFF);
      if (c.tid < 31) ptw[c.tid] = (unsigned long long)args.in[c.tid]; else if (c.tid == 31) ptw[31] = (unsigned long long)args.out; else if (c.tid == 32) ptw[32] = (unsigned long long)args.ws; }
    __syncthreads();
    const PT pt{(const LAS unsigned long long*)(c.lds + PTAB_OFF)};
    unsigned char* ws = pt.ws();
    XcdBarrier bar; bar.bar = (unsigned*)(ws + WS_CTL) + CW_BAR + args.li * XCD_BAR_WORDS; bar.x = 0; bar.st = nullptr;
    if (!MK_PER_PHASE) bar = xcd_barrier_post((unsigned*)(ws + WS_CTL) + CW_BAR + args.li * XCD_BAR_WORDS, MISC + 8);
    const int lo = args.ph_lo, hi = args.ph_hi;
#ifndef PH_MASK
#define PH_MASK 0xFFFFFFFFu
#endif
#define IN(k) (((PH_MASK >> (k)) & 1u) && lo <= (k) && (k) < hi)
#define SEAM(k) do { if (IN(k) && IN((k) + 1)) xcd_barrier(bar); } while (0)
    LAS unsigned char* ring = c.lds;
    const int bid = (int)blockIdx.x;
    using namespace pg8;

    if (IN(0)) { phase_prologue(pt, c); }
    SEAM(0);
    if (IN(1)) {
        Prob P{(const char*)(ws + WS_XB), (const char*)(ws + WS_WIN), nullptr, 2048u, 2048u, 128u, 16, 0, 0, c.wave};
        GridOrder S; S.init(T / 256, NIN / 256, c.G, bid, -1);
        EpiInProj E{(bf16_t*)(ws + WS_UEXT), (bf16_t*)(ws + WS_UPOOL), (bf16_t*)(ws + WS_GA), (bf16_t*)(ws + WS_GB)};
        const bool conv_first = ((bid >> 3) & 1) == 0;
        if (MOE_FP8 && conv_first) { phase_moe_convert(pt, c); __syncthreads(); }
        gemm_phase<0, false, EpiInProj, GridOrder, true>(ring, P, S, E);
        if (MOE_FP8 && !conv_first) phase_moe_convert(pt, c);
    }
    SEAM(1);
    if (IN(2)) {
        Prob P{(const char*)(ws + WS_UEXT), (const char*)(ws + WS_WS), nullptr, (unsigned)(UEXT_LD * 2), 1024u, 128u, 8, 256, 0, c.wave};
        GridOrder S; S.init(NG * CHROWS / 256, 1, c.G, bid, 3);
        EpiS E{(float*)(ws + WS_S)};
        gemm_phase<0, false, EpiS, GridOrder, true>(ring, P, S, E);
        phase_pooling(pt, c);
    }
    SEAM(2);
    if (IN(3)) {
        phase_scan(pt, c);
        Prob P{(const char*)(ws + WS_POOLED), (const char*)(ws + WS_WPOOL), nullptr, 1024u, 1024u, 128u, 8, 0, 0, c.wave};
        GridOrder S; S.init(T / 256, 4, c.G, bid, -1);
        EpiPool E{(bf16_t*)(ws + WS_GB)};
        gemm_phase<0, false, EpiPool, GridOrder, true>(ring, P, S, E);
    }
    SEAM(3);
    if (IN(4)) {
        Prob P{(const char*)(ws + WS_UEXT), (const char*)(ws + WS_TV), nullptr, (unsigned)(UEXT_LD * 2), (unsigned)(UEXT_LD * 2), 128u, 10, 512, 0, c.wave};
        GridOrder S; S.init(NG * CHROWS / 256, 2, c.G, bid, 3);
        EpiBf16<1> E{(bf16_t*)(ws + WS_Z), 512};
        gemm_phase<0, false, EpiBf16<1>, GridOrder, true>(ring, P, S, E);
    }
    SEAM(4);
    if (IN(5)) {
        Prob P{(const char*)(ws + WS_Z), (const char*)(ws + WS_WGLU), nullptr, (unsigned)(2 * MiB), 1024u, (unsigned)(8 * MiB), 8, 0, 0, c.wave};
        GridOrder S; S.init(T / 256, 8, c.G, bid, -1);
        EpiGlu E{(bf16_t*)(ws + WS_GA), (const bf16_t*)(ws + WS_GB)};
        gemm_phase<1, false, EpiGlu, GridOrder, true>(ring, P, S, E);
    }
    SEAM(5);
    if (IN(6)) {
        Prob P{(const char*)(ws + WS_GA), (const char*)(ws + WS_WOUT), nullptr, 2048u, 2048u, 128u, 16, 0, 0, c.wave};
        GridOrder S; S.init(T / 256, 4, c.G, bid, -1);
        EpiWout E{(bf16_t*)(ws + WS_H1)};
        gemm_phase<0, false, EpiWout, GridOrder, true>(ring, P, S, E);
    }
    SEAM(6);
    if (IN(7)) {
        const bool rows_first = ((bid >> 3) & 1) == 0;
        if (rows_first) phase_ln1(pt, c);
        Prob P{(const char*)(ws + WS_PB), (const char*)(ws + WS_WPP), nullptr, 512u, 512u, 128u, 4, 0, 0, c.wave};
        GridOrder S; S.init(T / 256, 4, c.G, bid, -1);
        EpiBf16<0> E{(bf16_t*)(ws + WS_PP), 1024};
        gemm_phase<0, false, EpiBf16<0>, GridOrder, true>(ring, P, S, E);
        if (!rows_first) phase_ln1(pt, c);
    }
    SEAM(7);
    if (IN(8)) {
        Prob P{(const char*)(ws + WS_H1), (const char*)(ws + WS_WPLE), nullptr, 2048u, 2048u, 128u, 16, 0, 0, c.wave};
        GridOrder S; S.init(T / 256, 5, c.G, bid, -1);
        EpiPle E{(const bf16_t*)(ws + WS_H1), (const bf16_t*)(ws + WS_PP), (bf16_t*)(ws + WS_BASE), pt.in(20), (int*)(ws + WS_TOPE), (float*)(ws + WS_TOPW)};
        gemm_phase<0, false, EpiPle, GridOrder, true>(ring, P, S, E);
    }
    SEAM(8);
    if (IN(9)) phase_route_count(pt, c);
    SEAM(9);
    if (IN(10)) phase_route_place(pt, c);
    SEAM(10);
#define MOE_SLAB(s) do { constexpr int pa = 11 + 2 * (s), pb = 12 + 2 * (s); \
        LAS int* tp = (LAS int*)(c.lds + TP_OFF); \
        if (IN(pa) || IN(pb)) { const int tid_ = c.wave * 64 + lane_id(); __syncthreads(); if (tid_ < 33) tp[tid_] = ((const int*)(ws + WS_CNT + 65536))[(s) * 64 + tid_]; __syncthreads(); } \
        if (IN(pa)) { \
            const bool rows_first = ((bid >> 3) & 1) == 0; \
            if ((s) > 0 && rows_first) phase_combine(pt, c, (s) - 1); \
            MoeOrder S; S.init((const PG8_LAS int*)tp, 8, c.G, bid); \
            if (STAGGER_US > 0 && ((bid >> 3) & 1)) { const unsigned long long t0_ = __builtin_amdgcn_s_memrealtime(); while (__builtin_amdgcn_s_memrealtime() - t0_ < (unsigned long long)(STAGGER_US * 100)) __builtin_amdgcn_s_sleep(8); } \
            if (MOE_FP8) { \
                Prob P{(const char*)(ws + WS_H1Q), (const char*)(ws + WS_WGU), (const int*)(ws + WS_ROWTOK) + (size_t)(s) * SLAB_ROWS, 1024u, 1024u, 128u, 8, 2048, IB_OFF, c.wave}; \
                EpiM1F8 E{(unsigned char*)(ws + WS_ACT), pt.in(22), pt.in(24)}; \
                if (SHADOW == 11 && (s) == 0) { EpiNull<true> E0; gemm_phase<2, true, EpiNull<true>, MoeOrder, true>(ring, P, S, E0); } \
                gemm_phase<2, true, EpiM1F8, MoeOrder, true>(ring, P, S, E); \
            } else { \
                Prob P{(const char*)(ws + WS_H1), (const char*)(ws + WS_WGU), (const int*)(ws + WS_ROWTOK) + (size_t)(s) * SLAB_ROWS, 2048u, 2048u, 128u, 16, 2048, IB_OFF, c.wave}; \
                EpiM1 E{(bf16_t*)(ws + WS_ACT), pt.in(22), pt.in(24)}; \
                gemm_phase<2, false, EpiM1, MoeOrder, true>(ring, P, S, E); \
            } \
            if ((s) > 0 && !rows_first) phase_combine(pt, c, (s) - 1); \
        } \
        SEAM(pa); \
        if (IN(pb)) { \
            MoeOrder S; S.init((const PG8_LAS int*)tp, 4, c.G, bid); \
            if (MOE_FP8) { \
                Prob P{(const char*)(ws + WS_ACT), (const char*)(ws + WS_WDN), nullptr, 1024u, 1024u, 128u, 8, 1024, 0, c.wave}; \
                EpiM2 E{(unsigned char*)(ws + WS_Y), pt.in(26), 0.015625f}; \
                gemm_phase<0, true, EpiM2, MoeOrder, true>(ring, P, S, E); \
            } else { \
                Prob P{(const char*)(ws + WS_ACT), (const char*)(ws + WS_WDN), nullptr, 2048u, 2048u, 128u, 16, 1024, 0, c.wave}; \
                EpiM2 E{(unsigned char*)(ws + WS_Y), pt.in(26), 1.0f}; \
                gemm_phase<0, false, EpiM2, MoeOrder, true>(ring, P, S, E); \
            } \
        } \
        SEAM(pb); } while (0)
    MOE_SLAB(0);
#if MOE_NSLAB == 2
    MOE_SLAB(1);
#endif
#undef MOE_SLAB
    if (IN(NPHASE - 1)) phase_combine(pt, c, NSLAB - 1);
#undef IN
#undef SEAM
}

extern "C" void kernel_launch(void* const* d_in, const int* in_sizes, int n_in, void* d_out, int out_size, void* d_ws, size_t ws_size, hipStream_t stream) {
    static int grid = 0;
    if (grid == 0) {
        if (n_in != 31 || in_sizes[0] != T * D || out_size != T * D || ws_size < WS_END) { fprintf(stderr, "kernel_launch: unexpected problem (n_in %d, in0 %d, out %d, ws %zu); nothing launched\n", n_in, n_in > 0 ? in_sizes[0] : -1, out_size, ws_size); grid = -1; return; }
        int dev = 0, cus = 0, per_cu = 0;
        if (hipGetDevice(&dev) != hipSuccess || hipDeviceGetAttribute(&cus, hipDeviceAttributeMultiprocessorCount, dev) != hipSuccess) { grid = -1; return; }
        if (hipFuncSetAttribute((const void*)mega_fwd, hipFuncAttributeMaxDynamicSharedMemorySize, LDS_BYTES) != hipSuccess) { fprintf(stderr, "kernel_launch: hipFuncSetAttribute failed\n"); grid = -1; return; }
        if (hipOccupancyMaxActiveBlocksPerMultiprocessor(&per_cu, (const void*)mega_fwd, NWAVES * 64, LDS_BYTES) != hipSuccess || per_cu < 1) { fprintf(stderr, "kernel_launch: occupancy query reports %d workgroups per CU\n", per_cu); }
        (void)hipGetLastError();
        grid = cus;
    }
    if (grid < 0) return;
    if (hipMemsetAsync((char*)d_ws + WS_CTL, 0, CTL_ZERO_BYTES, stream) != hipSuccess) return;
    Args a{};
    for (int i = 0; i < 31; ++i) a.in[i] = (const float*)d_in[i];
    a.out = (float*)d_out; a.ws = (unsigned char*)d_ws; a.pad = 0;
#if MK_PER_PHASE
    for (int ph = 0; ph < NPHASE; ++ph) { a.ph_lo = ph; a.ph_hi = ph + 1; a.li = 0; hipLaunchKernelGGL(mega_fwd, dim3(grid), dim3(NWAVES * 64), LDS_BYTES, stream, a); }
#elif defined(PROBE_REPEAT)
    a.ph_lo = 0; a.ph_hi = PROBE_REPEAT + 1; a.li = 0; hipLaunchKernelGGL(mega_fwd, dim3(grid), dim3(NWAVES * 64), LDS_BYTES, stream, a);
    a.ph_lo = PROBE_REPEAT; a.ph_hi = NPHASE; a.li = 1; hipLaunchKernelGGL(mega_fwd, dim3(grid), dim3(NWAVES * 64), LDS_BYTES, stream, a);
#else
    a.ph_lo = 0; a.ph_hi = NPHASE; a.li = 0;
    hipLaunchKernelGGL(mega_fwd, dim3(grid), dim3(NWAVES * 64), LDS_BYTES, stream, a);
#endif
}
```

```cpp
#include <hip/hip_runtime.h>
#include <cstdio>
#include <cstdint>

#ifndef SHADOW
#define SHADOW 0
#endif
#ifndef MOE_FP8
#define MOE_FP8 1
#endif
#ifndef Y_FP8
#define Y_FP8 1
#endif
#ifndef STAGGER_US
#define STAGGER_US 0
#endif
#ifndef MK_PER_PHASE
#define MK_PER_PHASE 0
#endif

namespace pg8 {
#define PG8_LAS __attribute__((address_space(3)))
typedef unsigned short bf16_t;
typedef short bf16x8 __attribute__((ext_vector_type(8)));
typedef float f32x4 __attribute__((ext_vector_type(4)));
typedef float f32x2 __attribute__((ext_vector_type(2)));
typedef unsigned u32x4 __attribute__((ext_vector_type(4)));
typedef unsigned u32x2 __attribute__((ext_vector_type(2)));
constexpr int BM = 256, BK = 64, HALF = 128, HTB = HALF * BK * 2  , STAGE_BYTES = 8 * HTB, NXCD = 8, WGM = 8;

__host__ __device__ __forceinline__ int lds_byte(int r, int c) { const int st = (r >> 4) * 2 + (c >> 5), rr = r & 15, cc = c & 31, ob = rr * 64 + cc * 2; return st * 1024 + (ob ^ (((ob >> 9) & 1) << 5)); }
__host__ __device__ __forceinline__ void stage_rc(int b, int& R, int& C) { const int st = b / 1024, sb = b % 1024, swz = sb ^ (((sb >> 9) & 1) << 5); R = (st >> 1) * 16 + swz / 64; C = (st & 1) * 32 + (swz % 64) / 2; }
__host__ __device__ __forceinline__ int perm32(int rho) { const int n = rho >> 4, i = rho & 15; return 8 * (i >> 2) + 4 * n + (i & 3); }

struct Unit { int pm, pn, aux; };

struct Prob {
    const char* A; const char* B; const int* gidx;
    unsigned lda;
    unsigned ldb;
    unsigned kstepA;
    int nt;
    int bgn;
    int ib_off;
    int wid;
};

struct GridOrder {
    int nM, nN, nwg, G, c, gshift;
    __device__ void init(int nM_, int nN_, int G_, int c_, int gshift_) { nM = nM_; nN = nN_; nwg = nM * nN; G = G_; c = c_; gshift = gshift_; }
    __device__ bool next(int i, Unit& u) const {
        const long L = (long)i * G + c; if (L >= nwg) return false;
        int wgid = (int)L; { const int q = nwg / NXCD, r = nwg % NXCD, xcd = wgid % NXCD, off = wgid / NXCD; wgid = (xcd < r ? xcd * (q + 1) : r * (q + 1) + (xcd - r) * q) + off; }
        const int nig = WGM * nN, gid = wgid / nig, fm = gid * WGM, gsz = (nM - fm) < WGM ? (nM - fm) : WGM;
        u.pm = fm + ((wgid % nig) % gsz); u.pn = (wgid % nig) / gsz; u.aux = gshift >= 0 ? (u.pm >> gshift) : 0; return true;
    }
};
struct MoeOrder {
    const PG8_LAS int* tp; int nct, total, G, c;
    __device__ void init(const PG8_LAS int* tp_, int nct_, int G_, int c_) { tp = tp_; nct = nct_; G = G_; c = c_; total = __builtin_amdgcn_readfirstlane(tp_[32]) * nct_; }
    __device__ bool next(int i, Unit& u) const {
        const long L = (long)i * G + c; if (L >= total) return false;
        int wgid = (int)L; { const int q = total / NXCD, r = total % NXCD, xcd = wgid % NXCD, off = wgid / NXCD; wgid = (xcd < r ? xcd * (q + 1) : r * (q + 1) + (xcd - r) * q) + off; }
        int ln = (int)__builtin_amdgcn_mbcnt_hi(~0u, __builtin_amdgcn_mbcnt_lo(~0u, 0u)); asm volatile("" : "+v"(ln));
        int e = __builtin_popcountll(__ballot(ln < 31 && wgid >= tp[(ln < 31 ? ln : 30) + 1] * nct)); e = __builtin_amdgcn_readfirstlane(e);
        const int t0 = __builtin_amdgcn_readfirstlane(tp[e]), nte = __builtin_amdgcn_readfirstlane(tp[e + 1]) - t0, local = wgid - t0 * nct;
        (void)nte; u.pn = __builtin_amdgcn_readfirstlane(local % nct); u.pm = __builtin_amdgcn_readfirstlane(t0 + local / nct); u.aux = e; return true;
    }
};

__device__ __forceinline__ unsigned cvt_pk_bf16(float lo, float hi) { unsigned r; asm volatile("v_cvt_pk_bf16_f32 %0, %1, %2" : "=v"(r) : "v"(lo), "v"(hi)); return r; }
__device__ __forceinline__ float bf_lo(unsigned w) { return __uint_as_float(w << 16); }
__device__ __forceinline__ float bf_hi(unsigned w) { return __uint_as_float(w & 0xffff0000u); }
__device__ __forceinline__ float sigmoid_f(float x) { return __builtin_amdgcn_rcpf(1.0f + __builtin_amdgcn_exp2f(-1.4426950409f * x)); }

typedef int v4i __attribute__((ext_vector_type(4)));
typedef int v8i __attribute__((ext_vector_type(8)));
template <bool FP8> __device__ __forceinline__ void stage_map(int p, int& R, int& Cb) {
    if (FP8) { R = (p >> 11) * 16 + ((p & 255) >> 4); Cb = ((p & 2047) >> 8) * 16; }
    else { int C; stage_rc(p, R, C); Cb = 2 * C; }
}
template <int AMODE, bool FP8, class Epi, class Sched, bool ALIGN_EPI>
__device__ __forceinline__ void gemm_phase(PG8_LAS unsigned char* lds, const Prob P, const Sched& S, const Epi& E) {
    const int wid = P.wid, lane = (int)__builtin_amdgcn_mbcnt_hi(~0u, __builtin_amdgcn_mbcnt_lo(~0u, 0u)), tid = wid * 64 + lane, wr = wid >> 2, wc = wid & 3, fr = lane & 15, fq = lane >> 4;
    const int nt = P.nt;
    unsigned vo[2][2], voffB[2];
#pragma unroll
    for (int i = 0; i < 2; ++i) { int R, Cb; stage_map<FP8>(tid * 16 + i * 8192, R, Cb); const int Rb = Epi::PERM ? ((R & ~31) + perm32(R & 31)) : R;
        voffB[i] = (unsigned)Rb * P.ldb + (unsigned)Cb;
#pragma unroll
        for (int h = 0; h < 2; ++h) {
            if (AMODE == 0) vo[h][i] = (unsigned)(h * HALF + R) * P.lda + (unsigned)Cb;
            else if (AMODE == 1) vo[h][i] = (unsigned)(Cb >> 5) * P.lda + (unsigned)(h * HALF + R) * 32u + (unsigned)(Cb & 31);
            else vo[h][i] = 0u; } }
    const unsigned kstepA = P.kstepA, kstepB = (unsigned)(BK * 2);
    const unsigned hstepB = (unsigned)HALF * P.ldb;
    const unsigned ldsw = (unsigned)wid * 1024u;
    const int aoff = FP8 ? (wr * 4 * 2048 + 2 * fq * 256 + fr * 16) : lds_byte(wr * 64 + fr, fq * 8), boff = FP8 ? (wc * 2 * 2048 + 2 * fq * 256 + fr * 16) : lds_byte(wc * 32 + fr, fq * 8);
    constexpr int KOFF = FP8 ? 256 : 1024;
    const int sc1 = 0x7F7F7F7F;
#define PG8_AOFF(u) ((unsigned)(AMODE == 0 ? (unsigned)(u).pm * BM * P.lda : (AMODE == 1 ? (unsigned)(u).pm * BM * 32u : 0u)))
#define PG8_BOFF(u) ((unsigned)(((unsigned)(u).aux * P.bgn + (unsigned)(u).pn * BM) * P.ldb))
#define PG8_GIDX(src, dst) do { _Pragma("unroll") for (int _i = 0; _i < 2; ++_i) { int _R, _C; stage_map<FP8>(tid * 16 + _i * 8192, _R, _C); _Pragma("unroll") for (int _h = 0; _h < 2; ++_h) \
        dst[_h][_i] = (unsigned)(src)[_h * HALF + _R] * P.lda + (unsigned)_C; } } while (0)
#define PG8_SA(b, h) (((b) * 2 + (h)) * HTB)
#define PG8_SB(b, h) ((4 + (b) * 2 + (h)) * HTB)
    const __amdgpu_buffer_rsrc_t rsA = __builtin_amdgcn_make_buffer_rsrc((void*)P.A, 0, 0xFFFFFFFF, 0x00020000);
    const __amdgpu_buffer_rsrc_t rsB = __builtin_amdgcn_make_buffer_rsrc((void*)P.B, 0, 0xFFFFFFFF, 0x00020000);
#define PG8_STAGE2(bufoff, rs, so, v0, v1) do { \
        __builtin_amdgcn_raw_ptr_buffer_load_lds(rs, (PG8_LAS void*)(lds + (bufoff) + ldsw), 16, (int)(v0), (int)(so), 0, 0); \
        __builtin_amdgcn_raw_ptr_buffer_load_lds(rs, (PG8_LAS void*)(lds + (bufoff) + ldsw + 8192), 16, (int)(v1), (int)(so), 0, 0); } while (0)
#define PG8_STAGE_A(bufoff, so, h) PG8_STAGE2(bufoff, rsA, so, vo[h][0], vo[h][1])
#define PG8_STAGE_B(bufoff, so) PG8_STAGE2(bufoff, rsB, so, voffB[0], voffB[1])
#define PG8_LDA(dst, b, h) do { _Pragma("unroll") for (int m = 0; m < 4; ++m) _Pragma("unroll") for (int k = 0; k < 2; ++k) dst[m][k] = *(const PG8_LAS bf16x8*)(lds + PG8_SA(b, h) + aoff + m * 2048 + k * KOFF); } while (0)
#define PG8_LDB(dst, b, h) do { _Pragma("unroll") for (int n = 0; n < 2; ++n) _Pragma("unroll") for (int k = 0; k < 2; ++k) dst[n][k] = *(const PG8_LAS bf16x8*)(lds + PG8_SB(b, h) + boff + n * 2048 + k * KOFF); } while (0)
#define PG8_MMA(ai, bj, At, Bt) do { __builtin_amdgcn_s_setprio(1); _Pragma("unroll") for (int m = 0; m < 4; ++m) _Pragma("unroll") for (int n = 0; n < 2; ++n) { \
        if constexpr (FP8) { acc[ai][bj][m][n] = __builtin_amdgcn_mfma_scale_f32_16x16x128_f8f6f4( \
                __builtin_shufflevector(__builtin_bit_cast(v4i, Bt[n][0]), __builtin_bit_cast(v4i, Bt[n][1]), 0, 1, 2, 3, 4, 5, 6, 7), \
                __builtin_shufflevector(__builtin_bit_cast(v4i, At[m][0]), __builtin_bit_cast(v4i, At[m][1]), 0, 1, 2, 3, 4, 5, 6, 7), acc[ai][bj][m][n], 0, 0, 0, 0, 0, 0); } \
        else { _Pragma("unroll") for (int k = 0; k < 2; ++k) acc[ai][bj][m][n] = __builtin_amdgcn_mfma_f32_16x16x32_bf16(Bt[n][k], At[m][k], acc[ai][bj][m][n], 0, 0, 0); } } \
        __builtin_amdgcn_s_setprio(0); } while (0)
#define PG8_WAIT_V(n) asm volatile("s_waitcnt vmcnt(" #n ")" ::: "memory")
#define PG8_WAIT_L(n) asm volatile("s_waitcnt lgkmcnt(" #n ")" ::: "memory")
#define PG8_BAR __builtin_amdgcn_s_barrier()
#define PG8_SCHED __builtin_amdgcn_sched_barrier(0)
    Unit cur, nxt; int ui = 0;
    if (!S.next(0, cur)) return;
    f32x4 acc[2][2][4][2];
#pragma unroll
    for (int a = 0; a < 2; ++a)
#pragma unroll
        for (int b = 0; b < 2; ++b)
#pragma unroll
            for (int m = 0; m < 4; ++m)
#pragma unroll
                for (int n = 0; n < 2; ++n) acc[a][b][m][n] = (f32x4){0.f, 0.f, 0.f, 0.f};
    bf16x8 At[4][2], B0[2][2], B1[2][2];
    unsigned cA = PG8_AOFF(cur), cB = PG8_BOFF(cur);
    if (AMODE == 2) { const int* gi = P.gidx + cur.pm * BM; PG8_GIDX(gi, vo); }
    PG8_STAGE_B(PG8_SB(0, 0), cB); PG8_STAGE_B(PG8_SB(0, 1), cB + hstepB); PG8_STAGE_A(PG8_SA(0, 0), cA, 0); PG8_STAGE_A(PG8_SA(0, 1), cA, 1);
    if (wr == 1) PG8_BAR;
    PG8_WAIT_V(2); PG8_BAR;
    PG8_STAGE_B(PG8_SB(1, 0), cB + kstepB); PG8_STAGE_A(PG8_SA(1, 0), cA + kstepA, 0); PG8_STAGE_B(PG8_SB(1, 1), cB + hstepB + kstepB);
    PG8_WAIT_V(6); PG8_BAR;
    for (;;) {
        const bool has_next = S.next(ui + 1, nxt);
        const unsigned nA = has_next ? PG8_AOFF(nxt) : cA, nB = has_next ? PG8_BOFF(nxt) : cB;
#pragma nounroll
        for (int t = 0; t < nt; t += 2) {
            const bool last = (t == nt - 2);
            const unsigned a1 = cA + (unsigned)(t + 1) * kstepA;
            const unsigned a2 = last ? nA : cA + (unsigned)(t + 2) * kstepA, b2 = last ? nB : cB + (unsigned)(t + 2) * kstepB;
            const unsigned a3 = a2 + kstepA, b3 = b2 + kstepB;
            if (AMODE == 2) { if (t == 0 && has_next && wid < 4)
                    __builtin_amdgcn_global_load_lds((const unsigned*)(P.gidx + nxt.pm * BM + wid * 64 + lane), (PG8_LAS unsigned*)(lds + P.ib_off + (((ui + 1) & 1) * 256 + wid * 64) * 4), 4, 0, 0); }
            PG8_LDB(B0, 0, 0); PG8_LDB(B1, 0, 1); PG8_SCHED; PG8_LDA(At, 0, 0); PG8_STAGE_A(PG8_SA(1, 1), a1, 1);
            if (AMODE == 2) { if (last && has_next) { const PG8_LAS int* ib = (const PG8_LAS int*)(lds + P.ib_off) + ((ui + 1) & 1) * 256; PG8_GIDX(ib, vo); } }
            PG8_WAIT_V(8); PG8_WAIT_L(0); PG8_BAR; PG8_MMA(0, 0, At, B0); PG8_MMA(0, 1, At, B1); PG8_BAR; PG8_SCHED;
            PG8_LDA(At, 0, 1); PG8_STAGE_B(PG8_SB(0, 0), b2); PG8_STAGE_B(PG8_SB(0, 1), b2 + hstepB); PG8_STAGE_A(PG8_SA(0, 0), a2, 0);
            PG8_WAIT_V(8); PG8_WAIT_L(0); PG8_BAR; PG8_MMA(1, 0, At, B0); PG8_MMA(1, 1, At, B1); PG8_BAR; PG8_SCHED;
            PG8_LDB(B0, 1, 0); PG8_LDB(B1, 1, 1); PG8_SCHED; PG8_LDA(At, 1, 0); PG8_STAGE_A(PG8_SA(0, 1), a2, 1);
            PG8_WAIT_V(8); PG8_WAIT_L(0); PG8_BAR; PG8_MMA(0, 0, At, B0); PG8_MMA(0, 1, At, B1); PG8_BAR; PG8_SCHED;
            PG8_LDA(At, 1, 1); PG8_STAGE_B(PG8_SB(1, 0), b3); PG8_STAGE_B(PG8_SB(1, 1), b3 + hstepB); PG8_STAGE_A(PG8_SA(1, 0), a3, 0);
            PG8_WAIT_V(8); PG8_WAIT_L(0); PG8_BAR; PG8_MMA(1, 0, At, B0); PG8_MMA(1, 1, At, B1); PG8_BAR; PG8_SCHED;
        }
        if constexpr (ALIGN_EPI) { if (wr == 0) PG8_BAR; }
        { int fr2 = fr, fq2 = fq; asm volatile("" : "+v"(fr2), "+v"(fq2));
          E(acc, cur, wr, wc, fr2, fq2); }
        if (!has_next) break;
#pragma unroll
        for (int a = 0; a < 2; ++a)
#pragma unroll
            for (int b = 0; b < 2; ++b)
#pragma unroll
                for (int m = 0; m < 4; ++m)
#pragma unroll
                    for (int n = 0; n < 2; ++n) acc[a][b][m][n] = (f32x4){0.f, 0.f, 0.f, 0.f};
        cur = nxt; cA = nA; cB = nB; ++ui;
        if constexpr (ALIGN_EPI) { if (wr == 1) PG8_BAR; }
    }
    PG8_WAIT_V(0);
    if constexpr (!ALIGN_EPI) { if (wr == 0) PG8_BAR; }
    PG8_BAR;
#undef PG8_AOFF
#undef PG8_BOFF
#undef PG8_GIDX
#undef PG8_SA
#undef PG8_SB
#undef PG8_STAGE2
#undef PG8_STAGE_B
#undef PG8_STAGE_A
#undef PG8_LDA
#undef PG8_LDB
#undef PG8_MMA
#undef PG8_WAIT_V
#undef PG8_WAIT_L
#undef PG8_BAR
#undef PG8_SCHED
}
}

constexpr int NWAVES = 8;
constexpr int BATCH = 16, SEQ = 4096, D = 1024, T = BATCH * SEQ;
constexpr int PLE = 256, SSMW = 512, POOLW = 512, NG = 32, GH = 16, NP = 64;
constexpr int LC = 32, NCH = SEQ / LC, CHROWS = BATCH * NCH;
constexpr int UEXT_LD = 640;
constexpr int NEXP = 32, TOPK = 4, NIN = 3072;
#ifndef MOE_NSLAB
#define MOE_NSLAB 1
#endif
constexpr int NSLAB = MOE_NSLAB, WPS = 256 / NSLAB  , SLAB_T = T / NSLAB, SLAB_ROWS = (SLAB_T * TOPK / 256 + NEXP) * 256;
constexpr float LN_EPS = 1e-5f, DN_ALPHA = 1.189207115002721f, SW_LIMIT = 7.0f, SW_ALPHA = 1.702f;
constexpr int NPHASE = 12 + 2 * NSLAB;

constexpr size_t MiB = 1u << 20;
constexpr size_t WS_WGU = 0 * MiB;
constexpr size_t WS_WDN = 128 * MiB;
constexpr size_t WS_WIN = 192 * MiB;
constexpr size_t WS_WGLU = 198 * MiB;
constexpr size_t WS_WPOOL = 200 * MiB;
constexpr size_t WS_WOUT = 201 * MiB;
constexpr size_t WS_WPLE = 203 * MiB;
constexpr size_t WS_WPP = 206 * MiB;
constexpr size_t WS_WS = 207 * MiB;
constexpr size_t WS_TV = 215 * MiB;
constexpr size_t WS_CTL = 235 * MiB;
constexpr size_t WS_TOPE = 236 * MiB;
constexpr size_t WS_TOPW = 237 * MiB;
constexpr size_t WS_ROWTOK = 238 * MiB;
constexpr size_t WS_SLOTPOS = 240 * MiB;
constexpr size_t WS_CNT = 242 * MiB;
constexpr size_t WS_XB = 244 * MiB;
constexpr size_t WS_H1 = 244 * MiB;
constexpr size_t WS_UEXT = 372 * MiB;
constexpr size_t WS_UPOOL = 452 * MiB;
constexpr size_t WS_PP = 372 * MiB;
constexpr size_t WS_GA = 516 * MiB;
constexpr size_t WS_GB = 644 * MiB;
constexpr size_t WS_POOLED = 772 * MiB;
constexpr size_t WS_S = 836 * MiB;
constexpr size_t WS_Z = 868 * MiB;
constexpr size_t WS_PB = 932 * MiB;
constexpr size_t WS_ACT = (NSLAB == 1 ? 244 : 372) * MiB;
constexpr size_t WS_BASE = 580 * MiB;
constexpr size_t WS_Y = (NSLAB == 1 ? 708 : 752) * MiB;
constexpr size_t WS_H1Q = 516 * MiB;
constexpr size_t WS_END = 1024 * MiB;
static_assert(MOE_FP8 && Y_FP8, "the workspace map below assumes e4m3 act and y");
static_assert(WS_BASE + (size_t)T * 2048 <= WS_Y && WS_H1Q + (size_t)T * 1024 <= WS_BASE && WS_ACT + (size_t)SLAB_ROWS * 1024 <= WS_H1Q && WS_Y + (size_t)SLAB_ROWS * 1024 <= WS_END && (size_t)NSLAB * SLAB_ROWS * 4 <= 2 * MiB && WS_PB + (size_t)T * PLE * 2 <= WS_END, "ws map");
constexpr size_t CTL_ZERO_BYTES = 1 * MiB;
constexpr int CW_BAR = 4096;

constexpr int RING_BYTES = 131072;
constexpr int LDSCTL_OFF = RING_BYTES, MISC_OFF = LDSCTL_OFF + 320;
constexpr int TP_OFF = LDSCTL_OFF + 1024, IB_OFF = TP_OFF + 512, PTAB_OFF = IB_OFF + 2048;
constexpr int LDS_BYTES = 147456;

#define GAS __attribute__((address_space(1)))
#define LAS __attribute__((address_space(3)))
typedef unsigned short bf16;
typedef unsigned v4u __attribute__((ext_vector_type(4)));
typedef unsigned v2u __attribute__((ext_vector_type(2)));
typedef float f32x4 __attribute__((ext_vector_type(4)));
typedef GAS unsigned gu32;
#define RLX_AGENT __ATOMIC_RELAXED, __HIP_MEMORY_SCOPE_AGENT
#define LDS_WAIT() asm volatile("s_waitcnt lgkmcnt(0)" ::: "memory")
#define VM_WAIT() asm volatile("s_waitcnt vmcnt(0)" ::: "memory")
__device__ __forceinline__ unsigned f2bf(float f) { unsigned u = __builtin_bit_cast(unsigned, f); return (u + 0x7fffu + ((u >> 16) & 1u)) >> 16; }
__device__ __forceinline__ unsigned pk2(float lo, float hi) { return f2bf(lo) | (f2bf(hi) << 16); }
__device__ __forceinline__ float bf2f(unsigned short b) { return __uint_as_float(((unsigned)b) << 16); }

#define XB_TMO      128
#define XB_XCNT(j)  (256  + 64 * (j))
#define XB_XSUB(j)  (1280 + 64 * (j))
#define XB_XGEN(j)  (2304 + 64 * (j))
#define XB_TOP      3328
#define XB_TOPGEN   3392
#define XCD_BAR_WORDS 3456
#define XB_SPIN_CAP (1u << 18)

__device__ __forceinline__ unsigned xb_ld(unsigned* p)              { return __hip_atomic_load(p, __ATOMIC_RELAXED, __HIP_MEMORY_SCOPE_AGENT); }
__device__ __forceinline__ unsigned xb_add(unsigned* p, unsigned v) { return __hip_atomic_fetch_add(p, v, __ATOMIC_RELAXED, __HIP_MEMORY_SCOPE_AGENT); }
__device__ __forceinline__ unsigned xb_xcc_id() { return (unsigned)__builtin_amdgcn_s_getreg((3 << 11) | 20) & 0xFu; }
#define XB_SPIN(cond, bar) do { unsigned _sp = 0; while (cond) { __builtin_amdgcn_s_sleep(1); \
    if ((++_sp & 255u) == 0u) { if (xb_ld(&(bar)[XB_TMO])) break; if (_sp > XB_SPIN_CAP) { atomicAdd(&(bar)[XB_TMO], 1u); break; } } } } while (0)

struct XcdBarrier {
    unsigned* bar; unsigned x;
    volatile LAS unsigned* st;
};

__device__ __forceinline__ XcdBarrier xcd_barrier_post(unsigned* bar, volatile LAS unsigned* st) {
    XcdBarrier b; b.bar = bar; b.x = xb_xcc_id(); b.st = st;
    if (threadIdx.x == 0) (void)xb_add(&bar[XB_XCNT(b.x)], 1u);
    return b;
}
__device__ __forceinline__ void xcd_barrier_complete(unsigned* bar, unsigned x, unsigned& nloc, unsigned& nx) {
    const unsigned G = gridDim.x * gridDim.y * gridDim.z;
    unsigned sum, cnt, mine, sp = 0u;
    for (;;) {
        sum = 0u; cnt = 0u; mine = 0u;
#pragma unroll
        for (unsigned j = 0; j < 16; ++j) { const unsigned c = xb_ld(&bar[XB_XCNT(j)]); sum += c; cnt += (c > 0u) ? 1u : 0u; mine = (j == x) ? c : mine; }
        if (sum == G) break;
        __builtin_amdgcn_s_sleep(1);
        if ((++sp & 255u) == 0u) { if (xb_ld(&bar[XB_TMO])) break; if (sp > XB_SPIN_CAP) { atomicAdd(&bar[XB_TMO], 1u); break; } }
    }
    nloc = mine > 0u ? mine : 1u; nx = cnt > 0u ? cnt : 1u;
}

__device__ __forceinline__ void xcd_barrier(const XcdBarrier& b) {
    asm volatile("s_waitcnt vmcnt(0)" ::: "memory");
    __syncthreads();
    if (threadIdx.x == 0) {
        unsigned* bar = b.bar;
        __builtin_amdgcn_s_waitcnt(0);
        unsigned nloc = b.st[0], nx = b.st[1];
        if (nloc == 0u) { xcd_barrier_complete(bar, b.x, nloc, nx); b.st[0] = nloc; b.st[1] = nx; }
        const unsigned old = xb_add(&bar[XB_XSUB(b.x)], 1u);
        const unsigned gen = old / nloc;
        if (old + 1u == (gen + 1u) * nloc) {
            __builtin_amdgcn_fence(__ATOMIC_RELEASE, "agent");
            asm volatile("s_waitcnt vmcnt(0)" ::: "memory");
            const unsigned og = xb_add(&bar[XB_TOP], 1u);
            const unsigned tg = og / nx;
            if (og + 1u == (tg + 1u) * nx) xb_add(&bar[XB_TOPGEN], 1u);
            else XB_SPIN(xb_ld(&bar[XB_TOPGEN]) == tg, bar);
            __builtin_amdgcn_fence(__ATOMIC_ACQUIRE, "agent");
            xb_add(&bar[XB_XGEN(b.x)], 1u);
            asm volatile("s_waitcnt vmcnt(0)" ::: "memory");
        } else {
            XB_SPIN(xb_ld(&bar[XB_XGEN(b.x)]) == gen, bar);
            __builtin_amdgcn_fence(__ATOMIC_ACQUIRE, "agent");
            asm volatile("s_waitcnt vmcnt(0)" ::: "memory");
        }
    }
    __syncthreads();
}

namespace pg8 {
#define EPI_ROW(u, ai, m) ((u).pm * BM + (ai) * HALF + wr * 64 + (m) * 16 + fr)
#define EPI_COL8(u, bj) ((u).pn * BM + (bj) * HALF + wc * 32 + 8 * fq)
#define EPI_COL4(u, bj, n) ((u).pn * BM + (bj) * HALF + wc * 32 + 16 * (n) + 4 * fq)
__device__ __forceinline__ u32x4 pack8(const f32x4 a, const f32x4 b) { u32x4 w; w.x = cvt_pk_bf16(a[0], a[1]); w.y = cvt_pk_bf16(a[2], a[3]); w.z = cvt_pk_bf16(b[0], b[1]); w.w = cvt_pk_bf16(b[2], b[3]); return w; }
__device__ __forceinline__ void unpack8(const u32x4 w, f32x4& a, f32x4& b) { a = (f32x4){bf_lo(w.x), bf_hi(w.x), bf_lo(w.y), bf_hi(w.y)}; b = (f32x4){bf_lo(w.z), bf_hi(w.z), bf_lo(w.w), bf_hi(w.w)}; }
__device__ __forceinline__ f32x4 sig4(const f32x4 v) { return (f32x4){sigmoid_f(v[0]), sigmoid_f(v[1]), sigmoid_f(v[2]), sigmoid_f(v[3])}; }
__device__ __forceinline__ float gelu_tanh(float x) { return x * sigmoid_f(1.5957691216f * (x + 0.044715f * x * x * x)); }

template <bool PERM_> struct EpiNull {
    static constexpr bool PERM = PERM_;
    __device__ __forceinline__ void operator()(const f32x4 (&acc)[2][2][4][2], const Unit& u, int wr, int wc, int fr, int fq) const {
#pragma unroll
        for (int ai = 0; ai < 2; ++ai)
#pragma unroll
            for (int bj = 0; bj < 2; ++bj)
#pragma unroll
                for (int m = 0; m < 4; ++m)
#pragma unroll
                    for (int n = 0; n < 2; ++n) asm volatile("" :: "v"(acc[ai][bj][m][n]));
    }
};
struct EpiInProj {
    static constexpr bool PERM = true;
    bf16_t* uext; bf16_t* upool; bf16_t* ga; bf16_t* gb;
    __device__ __forceinline__ void operator()(const f32x4 (&acc)[2][2][4][2], const Unit& u, int wr, int wc, int fr, int fq) const {
#pragma unroll
        for (int ai = 0; ai < 2; ++ai)
#pragma unroll
            for (int m = 0; m < 4; ++m) { const int t = EPI_ROW(u, ai, m);
#pragma unroll
                for (int bj = 0; bj < 2; ++bj) { const int c = EPI_COL8(u, bj); f32x4 v0 = acc[ai][bj][m][0], v1 = acc[ai][bj][m][1]; bf16_t* dst;
                    if (u.pn < 2) { const int g = c >> 4, h0 = c & 15; dst = uext + ((size_t)g * 2048 + (size_t)(t >> 5)) * 640 + (size_t)((t & 31) * 16 + h0); }
                    else if (u.pn < 4) dst = upool + (size_t)t * 512 + (c - 512);
                    else { v0 = sig4(v0); v1 = sig4(v1); dst = (u.pn < 8) ? ga + (size_t)t * 1024 + (c - 1024) : gb + (size_t)t * 1024 + (c - 2048); }
                    *(u32x4*)dst = pack8(v0, v1); } }
    }
};
struct EpiS {
    static constexpr bool PERM = false;
    float* S;
    __device__ __forceinline__ void operator()(const f32x4 (&acc)[2][2][4][2], const Unit& u, int wr, int wc, int fr, int fq) const {
#pragma unroll
        for (int ai = 0; ai < 2; ++ai)
#pragma unroll
            for (int m = 0; m < 4; ++m) { float* rowp = S + (size_t)EPI_ROW(u, ai, m) * 128 + wc * 32 + 4 * fq;
#pragma unroll
                for (int n = 0; n < 2; ++n) *(f32x4*)(rowp + 16 * n) = acc[ai][0][m][n]; }
    }
};
template <int ACT> struct EpiBf16 {
    static constexpr bool PERM = true;
    bf16_t* O; int ldc;
    __device__ __forceinline__ void operator()(const f32x4 (&acc)[2][2][4][2], const Unit& u, int wr, int wc, int fr, int fq) const {
#pragma unroll
        for (int ai = 0; ai < 2; ++ai)
#pragma unroll
            for (int m = 0; m < 4; ++m) { bf16_t* rowp = O + (size_t)EPI_ROW(u, ai, m) * ldc;
#pragma unroll
                for (int bj = 0; bj < 2; ++bj) { f32x4 v0 = acc[ai][bj][m][0], v1 = acc[ai][bj][m][1];
                    if (ACT == 1) {
#pragma unroll
                        for (int j = 0; j < 4; ++j) { v0[j] = gelu_tanh(v0[j]); v1[j] = gelu_tanh(v1[j]); } }
                    *(u32x4*)(rowp + EPI_COL8(u, bj)) = pack8(v0, v1); } }
    }
};
struct EpiPool {
    static constexpr bool PERM = true;
    bf16_t* gb;
    __device__ __forceinline__ void operator()(const f32x4 (&acc)[2][2][4][2], const Unit& u, int wr, int wc, int fr, int fq) const {
#pragma unroll
        for (int ai = 0; ai < 2; ++ai)
#pragma unroll
            for (int m = 0; m < 4; ++m) { bf16_t* rowp = gb + (size_t)EPI_ROW(u, ai, m) * 1024;
#pragma unroll
                for (int bj = 0; bj < 2; ++bj) { u32x4* p = (u32x4*)(rowp + EPI_COL8(u, bj)); f32x4 g0, g1; unpack8(*p, g0, g1);
                    *p = pack8(g0 * acc[ai][bj][m][0], g1 * acc[ai][bj][m][1]); } }
    }
};
struct EpiGlu {
    static constexpr bool PERM = true;
    bf16_t* ga; const bf16_t* gb;
    __device__ __forceinline__ void operator()(const f32x4 (&acc)[2][2][4][2], const Unit& u, int wr, int wc, int fr, int fq) const {
#pragma unroll
        for (int ai = 0; ai < 2; ++ai)
#pragma unroll
            for (int m = 0; m < 4; ++m) { const size_t off = (size_t)EPI_ROW(u, ai, m) * 1024 + (size_t)(u.pn * HALF + wc * 32 + 8 * fq);
                u32x4* pa = (u32x4*)(ga + off); f32x4 a0, a1, t0, t1; unpack8(*pa, a0, a1); unpack8(*(const u32x4*)(gb + off), t0, t1);
                const f32x4 y0 = acc[ai][0][m][0] * sig4(acc[ai][1][m][0]), y1 = acc[ai][0][m][1] * sig4(acc[ai][1][m][1]);
                *pa = pack8(a0 * y0 + t0, a1 * y1 + t1); }
    }
};
struct EpiWout {
    static constexpr bool PERM = true;
    bf16_t* s;
    __device__ __forceinline__ void operator()(const f32x4 (&acc)[2][2][4][2], const Unit& u, int wr, int wc, int fr, int fq) const {
        u32x4 xv[2][4][2];
#pragma unroll
        for (int ai = 0; ai < 2; ++ai) {
#pragma unroll
            for (int m = 0; m < 4; ++m)
#pragma unroll
                for (int bj = 0; bj < 2; ++bj) xv[ai & 1][m][bj] = *(const u32x4*)(s + (size_t)EPI_ROW(u, ai, m) * 1024 + EPI_COL8(u, bj));
#pragma unroll
            for (int m = 0; m < 4; ++m)
#pragma unroll
                for (int bj = 0; bj < 2; ++bj) { f32x4 x0, x1; unpack8(xv[ai & 1][m][bj], x0, x1);
                    *(u32x4*)(s + (size_t)EPI_ROW(u, ai, m) * 1024 + EPI_COL8(u, bj)) = pack8(x0 * 1.189207115002721f + acc[ai][bj][m][0], x1 * 1.189207115002721f + acc[ai][bj][m][1]); }
            asm volatile("" ::: "memory"); }
    }
};
struct EpiPle {
    static constexpr bool PERM = true;
    const bf16_t* h1; const bf16_t* pp; bf16_t* base; const float* brouter; int* tope; float* topw;
    __device__ __forceinline__ void operator()(const f32x4 (&acc)[2][2][4][2], const Unit& u, int wr, int wc, int fr, int fq) const {
        if (u.pn < 4) {
#pragma unroll
            for (int ai = 0; ai < 2; ++ai) { u32x4 hv[4][2], pv[4][2];
#pragma unroll
                for (int m = 0; m < 4; ++m)
#pragma unroll
                    for (int bj = 0; bj < 2; ++bj) { const size_t o = (size_t)EPI_ROW(u, ai, m) * 1024 + EPI_COL8(u, bj); hv[m][bj] = *(const u32x4*)(h1 + o); pv[m][bj] = *(const u32x4*)(pp + o); }
#pragma unroll
                for (int m = 0; m < 4; ++m)
#pragma unroll
                    for (int bj = 0; bj < 2; ++bj) { const size_t o = (size_t)EPI_ROW(u, ai, m) * 1024 + EPI_COL8(u, bj); f32x4 h0, h1v, p0, p1; unpack8(hv[m][bj], h0, h1v); unpack8(pv[m][bj], p0, p1);
                        *(u32x4*)(base + o) = pack8(h0 * 1.189207115002721f + sig4(acc[ai][bj][m][0]) * p0, h1v * 1.189207115002721f + sig4(acc[ai][bj][m][1]) * p1); }
                asm volatile("" ::: "memory"); }
        } else if (wc == 0) {
            const f32x4 b0 = *(const f32x4*)(brouter + 8 * fq), b1 = *(const f32x4*)(brouter + 8 * fq + 4);
#pragma unroll
            for (int ai = 0; ai < 2; ++ai)
#pragma unroll
                for (int m = 0; m < 4; ++m) {
                    float v[8]; const f32x4 l0 = acc[ai][0][m][0] + acc[ai][1][m][0] + b0, l1 = acc[ai][0][m][1] + acc[ai][1][m][1] + b1;
#pragma unroll
                    for (int i = 0; i < 4; ++i) { v[i] = l0[i]; v[4 + i] = l1[i]; }
                    float tv[4]; int te[4];
#pragma unroll
                    for (int r = 0; r < 4; ++r) {
                        float bv = -3.0e38f; int bi = 0;
#pragma unroll
                        for (int i = 0; i < 8; ++i) { if (v[i] > bv) { bv = v[i]; bi = i; } }
                        const int be = 8 * fq + bi;
                        float gv = bv; int ge = be;
#pragma unroll
                        for (int o = 16; o <= 32; o <<= 1) { const float ov = __shfl_xor(gv, o); const int oe = __shfl_xor(ge, o); if (ov > gv || (ov == gv && oe < ge)) { gv = ov; ge = oe; } }
                        tv[r] = gv; te[r] = ge;
                        if (ge == be) {
#pragma unroll
                            for (int i = 0; i < 8; ++i) if (i == bi) v[i] = -3.0e38f; }
                    }
                    if (fq == 0) { const float e1 = __expf(tv[1] - tv[0]), e2 = __expf(tv[2] - tv[0]), e3 = __expf(tv[3] - tv[0]); const float inv = 1.0f / (1.0f + e1 + e2 + e3);
                        const int t = EPI_ROW(u, ai, m);
                        *(int4*)(tope + (size_t)t * 4) = make_int4(te[0], te[1], te[2], te[3]);
                        *(float4*)(topw + (size_t)t * 4) = make_float4(inv, e1 * inv, e2 * inv, e3 * inv); }
                }
        }
    }
};
struct EpiM1 {
    static constexpr bool PERM = true;
    bf16_t* act; const float* bgate; const float* bup;
    __device__ __forceinline__ void operator()(const f32x4 (&acc)[2][2][4][2], const Unit& u, int wr, int wc, int fr, int fq) const {
        const int col = u.pn * HALF + wc * 32 + 8 * fq; const float* bg = bgate + (size_t)u.aux * 1024 + col; const float* bu = bup + (size_t)u.aux * 1024 + col;
        const f32x4 g0 = *(const f32x4*)bg, g1 = *(const f32x4*)(bg + 4), u0 = *(const f32x4*)bu, u1 = *(const f32x4*)(bu + 4);
#pragma unroll
        for (int ai = 0; ai < 2; ++ai)
#pragma unroll
            for (int m = 0; m < 4; ++m) { f32x4 o[2];
#pragma unroll
                for (int n = 0; n < 2; ++n) { const f32x4 gg = acc[ai][0][m][n] + (n ? g1 : g0), uu = acc[ai][1][m][n] + (n ? u1 : u0);
#pragma unroll
                    for (int j = 0; j < 4; ++j) { const float g = fminf(gg[j], 7.0f), up = fminf(fmaxf(uu[j], -7.0f), 7.0f); o[n][j] = (up + 1.0f) * (g * sigmoid_f(1.702f * g)); } }
                *(u32x4*)(act + (size_t)EPI_ROW(u, ai, m) * 1024 + col) = pack8(o[0], o[1]); }
    }
};
__device__ __forceinline__ u32x2 pack8_fp8(const f32x4 a, const f32x4 b) { int w0 = 0, w1 = 0;
    w0 = __builtin_amdgcn_cvt_pk_fp8_f32(a[0], a[1], w0, false); w0 = __builtin_amdgcn_cvt_pk_fp8_f32(a[2], a[3], w0, true);
    w1 = __builtin_amdgcn_cvt_pk_fp8_f32(b[0], b[1], w1, false); w1 = __builtin_amdgcn_cvt_pk_fp8_f32(b[2], b[3], w1, true); return (u32x2){(unsigned)w0, (unsigned)w1}; }
struct EpiM1F8 {
    static constexpr bool PERM = true;
    unsigned char* act; const float* bgate; const float* bup;
    __device__ __forceinline__ void operator()(const f32x4 (&acc)[2][2][4][2], const Unit& u, int wr, int wc, int fr, int fq) const {
        const int col = u.pn * HALF + wc * 32 + 8 * fq; const float* bg = bgate + (size_t)u.aux * 1024 + col; const float* bu = bup + (size_t)u.aux * 1024 + col;
        const f32x4 g0 = *(const f32x4*)bg, g1 = *(const f32x4*)(bg + 4), u0 = *(const f32x4*)bu, u1 = *(const f32x4*)(bu + 4);
#pragma unroll
        for (int ai = 0; ai < 2; ++ai)
#pragma unroll
            for (int m = 0; m < 4; ++m) { f32x4 o[2];
#pragma unroll
                for (int n = 0; n < 2; ++n) { const f32x4 gg = acc[ai][0][m][n] * 0.03125f + (n ? g1 : g0), uu = acc[ai][1][m][n] * 0.03125f + (n ? u1 : u0);
#pragma unroll
                    for (int j = 0; j < 4; ++j) { const float g = fminf(gg[j], 7.0f), up = fminf(fmaxf(uu[j], -7.0f), 7.0f); o[n][j] = (up + 1.0f) * (g * sigmoid_f(1.702f * g)); } }
                *(u32x2*)(act + (size_t)(u.pm * BM + ai * HALF + wr * 64 + m * 16 + fr) * 1024 + col) = pack8_fp8(o[0], o[1]); }
    }
};
struct EpiM2 {
    static constexpr bool PERM = true;
    unsigned char* y; const float* bdown; float sc;
    __device__ __forceinline__ void operator()(const f32x4 (&acc)[2][2][4][2], const Unit& u, int wr, int wc, int fr, int fq) const {
        f32x4 b[2][2];
#pragma unroll
        for (int bj = 0; bj < 2; ++bj) { const float* bp = bdown + (size_t)u.aux * 1024 + EPI_COL8(u, bj); b[bj][0] = *(const f32x4*)bp; b[bj][1] = *(const f32x4*)(bp + 4); }
#pragma unroll
        for (int ai = 0; ai < 2; ++ai)
#pragma unroll
            for (int m = 0; m < 4; ++m) { const size_t ro = (size_t)EPI_ROW(u, ai, m) * 1024;
#pragma unroll
                for (int bj = 0; bj < 2; ++bj) { const f32x4 v0 = acc[ai][bj][m][0] * sc + b[bj][0], v1 = acc[ai][bj][m][1] * sc + b[bj][1];
                    if (Y_FP8) *(u32x2*)(y + ro + EPI_COL8(u, bj)) = pack8_fp8(v0, v1);
                    else *(u32x4*)((bf16_t*)y + ro + EPI_COL8(u, bj)) = pack8(v0, v1); } }
    }
};
#undef EPI_ROW
#undef EPI_COL8
#undef EPI_COL4
}

struct Args { const float* in[31]; float* out; unsigned char* ws; int ph_lo, ph_hi, li, pad; };
struct Ctx { LAS unsigned char* lds; int tid, lane, wave, vcu, G, gw, ngw; };
__device__ __forceinline__ int lane_id() { return (int)__builtin_amdgcn_mbcnt_hi(~0u, __builtin_amdgcn_mbcnt_lo(~0u, 0u)); }
struct PT { const LAS unsigned long long* t;
    __device__ __forceinline__ unsigned long long get(int k) const { const unsigned long long v = t[k]; const unsigned lo = __builtin_amdgcn_readfirstlane((unsigned)v), hi = __builtin_amdgcn_readfirstlane((unsigned)(v >> 32)); return ((unsigned long long)hi << 32) | lo; }
    __device__ __forceinline__ const float* in(int k) const { return (const float*)get(k); }
    __device__ __forceinline__ float* out() const { return (float*)get(31); }
    __device__ __forceinline__ unsigned char* ws() const { return (unsigned char*)get(32); } };

__device__ __forceinline__ float wave_sum(float v) {
#pragma unroll
    for (int o = 1; o < 64; o <<= 1) v += __shfl_xor(v, o);
    return v;
}
__device__ __forceinline__ void p0_transpose_item(const float* W, int K, int N, bf16* WT, int dst_row0, LAS unsigned char* scr, int kb, int nb, int lane) {
    const int k0 = 64 * kb, n0 = 64 * nb, kr = lane >> 4, nq = lane & 15;
    f32x4 v[16];
#pragma unroll
    for (int i = 0; i < 16; ++i) v[i] = *(const f32x4*)(W + (size_t)(k0 + 4 * i + kr) * N + n0 + 4 * nq);
#pragma unroll
    for (int i = 0; i < 16; ++i) { const int k = 4 * i + kr;
#pragma unroll
        for (int j = 0; j < 4; ++j) *(LAS unsigned short*)(scr + (4 * nq + j) * 144 + 2 * k) = (unsigned short)f2bf(v[i][j]); }
    LDS_WAIT(); asm volatile("" ::: "memory");
    const int c = lane & 7;
#pragma unroll
    for (int j = 0; j < 8; ++j) { const int n = (lane >> 3) + 8 * j; const v4u o = *(const LAS v4u*)(scr + n * 144 + 16 * c);
        *(v4u*)(WT + (size_t)(dst_row0 + n) * K + k0 + 8 * c) = o; }
    LDS_WAIT(); asm volatile("" ::: "memory");
}
__device__ __forceinline__ unsigned char f2fp8(float x) { return (unsigned char)(__builtin_amdgcn_cvt_pk_fp8_f32(x, x, 0, false) & 0xff); }
struct T8Item { const float* W; unsigned char* WT; int dst_row0, k0, n0; float sc; };
__device__ __forceinline__ void t8_load(const T8Item& it, f32x4 (&v)[16], int lane) { const int kr = lane >> 3, nq = lane & 7;
#pragma unroll
    for (int i = 0; i < 16; ++i) v[i] = *(const f32x4*)(it.W + (size_t)(it.k0 + 8 * i + kr) * 1024 + it.n0 + 4 * nq); }
__device__ __forceinline__ void t8_store(const T8Item& it, const f32x4 (&v)[16], LAS unsigned char* scr, int lane) { const int kr = lane >> 3, nq = lane & 7;
#pragma unroll
    for (int i = 0; i < 16; ++i) { const int k = 8 * i + kr;
#pragma unroll
        for (int j = 0; j < 4; ++j) *(LAS unsigned char*)(scr + (4 * nq + j) * 144 + k) = f2fp8(v[i][j] * it.sc); }
    LDS_WAIT(); asm volatile("" ::: "memory");
#pragma unroll
    for (int j = 0; j < 4; ++j) { const int q = lane + 64 * j, n = q >> 3, c = q & 7; const v4u o = *(const LAS v4u*)(scr + n * 144 + 16 * c);
        *(v4u*)(it.WT + (size_t)(it.dst_row0 + n) * 1024 + it.k0 + 16 * c) = o; }
    LDS_WAIT(); asm volatile("" ::: "memory");
}
__device__ __forceinline__ void cv_load(const float* src, f32x4 (&v)[16], int lane) { const f32x4* s = (const f32x4*)src + lane;
#pragma unroll
    for (int j = 0; j < 16; ++j) v[j] = s[64 * j]; }
__device__ __forceinline__ void cv_store(bf16* dst, const f32x4 (&v)[16], int lane) { v2u* o = (v2u*)dst + lane;
#pragma unroll
    for (int j = 0; j < 16; ++j) { v2u w; w.x = pk2(v[j].x, v[j].y); w.y = pk2(v[j].z, v[j].w); o[64 * j] = w; } }
struct cplx { float re, im; };
__device__ __forceinline__ cplx cmul(cplx a, cplx b) { return cplx{a.re * b.re - a.im * b.im, a.re * b.im + a.im * b.re}; }
__device__ __forceinline__ cplx lam_pow(float lre, float lim, float step, float tau) { const float m = __expf(lre * step * tau); float s, c; sincosf(lim * step * tau, &s, &c); return cplx{m * c, m * s}; }
__device__ __forceinline__ cplx bbar_fac(float lre, float lim, float step) { const cplx lb = lam_pow(lre, lim, step, 1.0f); const float nr = lb.re - 1.0f, ni = lb.im, d = 1.0f / (lre * lre + lim * lim);
    return cplx{(nr * lre + ni * lim) * d, (ni * lre - nr * lim) * d}; }

__device__ __forceinline__ void prologue_stream(const PT a, const Ctx& c0) {
    Ctx c = c0; c.lane = lane_id(); c.tid = c.wave * 64 + c.lane;
    unsigned char* ws = a.ws();
    LAS float* scr = (LAS float*)(c.lds + c.wave * 16384);
    const float *w_in = a.in(2), *lre = a.in(3), *lim = a.in(4), *lstep = a.in(5), *bre = a.in(6), *bim = a.in(7), *cre = a.in(8), *cim = a.in(9), *dsk = a.in(10);
    const float *wval = a.in(11), *wgt = a.in(12), *wgrp = a.in(13), *pscale = a.in(14), *wpp = a.in(15), *wout = a.in(16), *wrt = a.in(19);
    const float *wgate = a.in(21), *wup = a.in(23), *wdown = a.in(25), *wpleg = a.in(27), *wplep = a.in(28);
    constexpr int I_IN = 16 * 48, I_GL = 8 * 16, I_SQ = 16 * 16, I_PP = 4 * 16, I_E = 32 * I_SQ;
    constexpr int NITEMS = I_IN + 2 * I_GL + 2 * I_SQ + I_PP + (MOE_FP8 ? 0 : 3 * I_E);
    LAS unsigned char* scrb = (LAS unsigned char*)scr;
    for (int it = c.gw; it < NITEMS; it += c.ngw) {
        int r = it;
        if (r < I_IN) { p0_transpose_item(w_in, 1024, 3072, (bf16*)(ws + WS_WIN), 64 * (r % 48), scrb, r / 48, r % 48, c.lane); continue; } r -= I_IN;
        if (r < 2 * I_GL) { const int which = r / I_GL, q = r % I_GL, nb = q % 16, n0 = 64 * nb;
            p0_transpose_item(which ? wgt : wval, 512, 1024, (bf16*)(ws + WS_WGLU), (n0 >> 7) * 256 + (n0 & 127) + which * 128, scrb, q / 16, nb, c.lane); continue; } r -= 2 * I_GL;
        if (r < I_SQ) { p0_transpose_item(wout, 1024, 1024, (bf16*)(ws + WS_WOUT), 64 * (r % 16), scrb, r / 16, r % 16, c.lane); continue; } r -= I_SQ;
        if (r < I_SQ) { p0_transpose_item(wpleg, 1024, 1024, (bf16*)(ws + WS_WPLE), 64 * (r % 16), scrb, r / 16, r % 16, c.lane); continue; } r -= I_SQ;
        if (r < I_PP) { p0_transpose_item(wplep, 256, 1024, (bf16*)(ws + WS_WPP), 64 * (r % 16), scrb, r / 16, r % 16, c.lane); continue; } r -= I_PP;
#if !MOE_FP8
        if (r < 2 * I_E) { const int which = r / I_E, q = r % I_E, e = q / I_SQ, qq = q % I_SQ, nb = qq % 16, n0 = 64 * nb;
            p0_transpose_item((which ? wup : wgate) + (size_t)e * 1048576, 1024, 1024, (bf16*)(ws + WS_WGU) + (size_t)e * 2048 * 1024, (n0 >> 7) * 256 + (n0 & 127) + which * 128, scrb, qq / 16, nb, c.lane); continue; } r -= 2 * I_E;
        { const int e = r / I_SQ, qq = r % I_SQ; p0_transpose_item(wdown + (size_t)e * 1048576, 1024, 1024, (bf16*)(ws + WS_WDN) + (size_t)e * 1048576, 64 * (qq % 16), scrb, qq / 16, qq % 16, c.lane); }
#endif
    }
    { constexpr int NCX = T / 4, NCV = NCX + T / 16; const float* xs = a.in(0); const float* ps = a.in(1);
#define CV_SRC(m_) ((m_) < NCX ? xs + (size_t)(m_) * 4096 : ps + (size_t)((m_) - NCX) * 4096)
#define CV_DST(m_) ((m_) < NCX ? (bf16*)(ws + WS_XB) + (size_t)(m_) * 4096 : (bf16*)(ws + WS_PB) + (size_t)((m_) - NCX) * 4096)
      int m = c.gw; f32x4 va[16], vb[16];
      if (m < NCV) { cv_load(CV_SRC(m), va, c.lane);
        for (;;) {
            const int m2 = m + c.ngw; const bool h2 = m2 < NCV; if (h2) cv_load(CV_SRC(m2), vb, c.lane);
            cv_store(CV_DST(m), va, c.lane);
            if (!h2) break;
            const int m3 = m2 + c.ngw; const bool h3 = m3 < NCV; if (h3) cv_load(CV_SRC(m3), va, c.lane);
            cv_store(CV_DST(m2), vb, c.lane);
            if (!h3) break;
            m = m3; } }
#undef CV_SRC
#undef CV_DST
    }
}
__device__ __forceinline__ void prologue_tables(const PT a, const Ctx& c0) {
    Ctx c = c0; c.lane = lane_id(); c.tid = c.wave * 64 + c.lane;
    unsigned char* ws = a.ws();
    LAS float* scr = (LAS float*)(c.lds + c.wave * 16384);
    const float *w_in = a.in(2), *lre = a.in(3), *lim = a.in(4), *lstep = a.in(5), *bre = a.in(6), *bim = a.in(7), *cre = a.in(8), *cim = a.in(9), *dsk = a.in(10);
    const float *wval = a.in(11), *wgt = a.in(12), *wgrp = a.in(13), *pscale = a.in(14), *wpp = a.in(15), *wout = a.in(16), *wrt = a.in(19);
    const float *wgate = a.in(21), *wup = a.in(23), *wdown = a.in(25), *wpleg = a.in(27), *wplep = a.in(28);
    { bf16* W = (bf16*)(ws + WS_WPLE) + (size_t)1024 * 1024;
      for (int ch = c.gw * 64 + c.lane; ch < 256 * 128; ch += c.ngw * 64) { const int r = ch >> 7, k0 = (ch & 127) * 8; unsigned o[4] = {0u, 0u, 0u, 0u};
          if (r < 32 || (r >= 128 && r < 160)) { const int e = r & 31; float f[8];
#pragma unroll
              for (int j = 0; j < 8; ++j) { const float w = wrt[(size_t)(k0 + j) * 32 + e]; const float hi = bf2f((unsigned short)f2bf(w)); f[j] = (r < 32) ? hi : (w - hi); }
#pragma unroll
              for (int j = 0; j < 4; ++j) o[j] = pk2(f[2 * j], f[2 * j + 1]); }
          *(v4u*)(W + (size_t)r * 1024 + k0) = (v4u){o[0], o[1], o[2], o[3]}; } }
    for (int it = c.gw; it < 64 * 16; it += c.ngw) { const int c0 = (it >> 4) * 8, d = (it & 15) * 64 + c.lane, g = c0 >> 7; float s[8];
#pragma unroll
        for (int i = 0; i < 8; ++i) s[i] = 0.f;
        for (int j = 0; j < 128; ++j) { const float pw = pscale[g * 128 + j] * wpp[(size_t)(g * 128 + j) * 1024 + d];
#pragma unroll
            for (int i = 0; i < 8; ++i) s[i] += wgrp[(size_t)(g * 128 + (c0 & 127) + i) * 128 + j] * pw; }
        *(v4u*)((bf16*)(ws + WS_WPOOL) + (size_t)d * 512 + c0) = (v4u){pk2(s[0], s[1]), pk2(s[2], s[3]), pk2(s[4], s[5]), pk2(s[6], s[7])}; }
    { bf16* TV = (bf16*)(ws + WS_TV);
      if ((c.gw & 3) == 0 && (c.gw >> 2) < 512) { const int it = c.gw >> 2, g = it >> 4, h = it & 15, hp = c.lane & 15, pq = c.lane >> 4; const float step = __expf(lstep[g]);
          float Kt[32];
#pragma unroll
          for (int tt = 0; tt < 32; ++tt) Kt[tt] = 0.f;
          for (int pi = 0; pi < 16; ++pi) { const int p = pq * 16 + pi; const float lr = lre[g * 64 + p], li = lim[g * 64 + p]; const cplx lb = lam_pow(lr, li, step, 1.0f), bf = bbar_fac(lr, li, step);
              const cplx bb = cmul(bf, cplx{bre[(size_t)(g * 64 + p) * 16 + hp], bim[(size_t)(g * 64 + p) * 16 + hp]});
              cplx w = cmul(cplx{cre[(size_t)(g * 16 + h) * 64 + p], cim[(size_t)(g * 16 + h) * 64 + p]}, bb);
#pragma unroll
              for (int tt = 0; tt < 32; ++tt) { Kt[tt] += w.re; w = cmul(w, lb); } }
#pragma unroll
          for (int tt = 0; tt < 32; ++tt) { Kt[tt] += __shfl_xor(Kt[tt], 16); Kt[tt] += __shfl_xor(Kt[tt], 32); }
          if (h == hp) Kt[0] += dsk[g * 16 + h];
#pragma unroll
          for (int tt = 0; tt < 32; ++tt) { if ((tt >> 3) == pq) { const bf16 v = (bf16)f2bf(Kt[tt]);
              for (int s = 0; s + tt < 32; ++s) TV[((size_t)g * 512 + (size_t)(s + tt) * 16 + h) * 640 + s * 16 + hp] = v; } } }
      for (int it = c.gw; it < 32 * 512; it += c.ngw) { const int g = it >> 9, n = it & 511, j = n >> 4, h = n & 15; bf16* row = TV + (size_t)it * 640;
          if (c.lane * 8 >= (j + 1) * 16) *(v4u*)(row + c.lane * 8) = (v4u){0u, 0u, 0u, 0u};
          const int p = c.lane; const float step = __expf(lstep[g]); const cplx lp = lam_pow(lre[g * 64 + p], lim[g * 64 + p], step, (float)(j + 1));
          const cplx mv = cmul(cplx{cre[(size_t)(g * 16 + h) * 64 + p], cim[(size_t)(g * 16 + h) * 64 + p]}, lp);
          row[512 + p] = (bf16)f2bf(mv.re); row[576 + p] = (bf16)f2bf(-mv.im); }
      bf16* WS = (bf16*)(ws + WS_WS);
      for (int it = c.gw; it < 32 * 256; it += c.ngw) { const int g = it >> 8, n = it & 255; v4u o = (v4u){0u, 0u, 0u, 0u};
          if (n < 128) { const int p = n & 63, s = c.lane >> 1, h0 = (c.lane & 1) * 8; const float step = __expf(lstep[g]), lr = lre[g * 64 + p], li = lim[g * 64 + p];
              const cplx f = cmul(lam_pow(lr, li, step, (float)(31 - s)), bbar_fac(lr, li, step)); float v[8];
#pragma unroll
              for (int i = 0; i < 8; ++i) { const cplx r = cmul(f, cplx{bre[(size_t)(g * 64 + p) * 16 + h0 + i], bim[(size_t)(g * 64 + p) * 16 + h0 + i]}); v[i] = (n < 64) ? r.re : r.im; }
              o = (v4u){pk2(v[0], v[1]), pk2(v[2], v[3]), pk2(v[4], v[5]), pk2(v[6], v[7])}; }
          *(v4u*)(WS + (size_t)it * 512 + c.lane * 8) = o; } }
}
__device__ __forceinline__ void phase_prologue(const PT a, const Ctx& c0) {
    if (c0.wave >= 4) { prologue_stream(a, c0); prologue_tables(a, c0); } else { prologue_tables(a, c0); prologue_stream(a, c0); }
}

__device__ __forceinline__ void phase_moe_convert(const PT a, const Ctx& c0) {
    Ctx c = c0; c.lane = lane_id(); c.tid = c.wave * 64 + c.lane;
    unsigned char* ws = a.ws(); LAS unsigned char* scrb = c.lds + c.wave * 16384;
    const float *wgate = a.in(21), *wup = a.in(23), *wdown = a.in(25);
    { constexpr int NT8 = 3 * 32 * 256;
#define T8_DECODE(r_, it_) do { const int which_ = (r_) / 8192, q_ = (r_) % 8192, e_ = q_ >> 8, qq_ = q_ & 255, nb_ = qq_ & 31, n0_ = 32 * nb_; \
        it_.k0 = 128 * (qq_ >> 5); it_.n0 = n0_; \
        if (which_ < 2) { it_.W = (which_ ? wup : wgate) + (size_t)e_ * 1048576; it_.WT = (unsigned char*)(ws + WS_WGU) + (size_t)e_ * 2048 * 1024; it_.dst_row0 = (n0_ >> 7) * 256 + (n0_ & 127) + which_ * 128; it_.sc = 32.0f; } \
        else { it_.W = wdown + (size_t)e_ * 1048576; it_.WT = (unsigned char*)(ws + WS_WDN) + (size_t)e_ * 1048576; it_.dst_row0 = n0_; it_.sc = 64.0f; } } while (0)
      int r = c.gw; T8Item ia, ib; f32x4 va[16], vb[16];
      if (r < NT8) { T8_DECODE(r, ia); t8_load(ia, va, c.lane);
        for (;;) {
            const int r2 = r + c.ngw; const bool h2 = r2 < NT8; if (h2) { T8_DECODE(r2, ib); t8_load(ib, vb, c.lane); }
            t8_store(ia, va, scrb, c.lane);
            if (!h2) break;
            const int r3 = r2 + c.ngw; const bool h3 = r3 < NT8; if (h3) { T8_DECODE(r3, ia); t8_load(ia, va, c.lane); }
            t8_store(ib, vb, scrb, c.lane);
            if (!h3) break;
            r = r3; } }
#undef T8_DECODE
    }
}

__device__ __forceinline__ void unpack8f(const v4u v, float (&f)[8]) { f[0] = pg8::bf_lo(v.x); f[1] = pg8::bf_hi(v.x); f[2] = pg8::bf_lo(v.y); f[3] = pg8::bf_hi(v.y); f[4] = pg8::bf_lo(v.z); f[5] = pg8::bf_hi(v.z); f[6] = pg8::bf_lo(v.w); f[7] = pg8::bf_hi(v.w); }
__device__ __forceinline__ void phase_pooling(const PT a, const Ctx& c0) {
    Ctx c = c0; c.lane = lane_id(); c.tid = c.wave * 64 + c.lane;
    const bf16* up = (const bf16*)(a.ws() + WS_UPOOL) + c.lane * 8; bf16* po = (bf16*)(a.ws() + WS_POOLED) + c.lane * 8;
    const int w = 2 << (c.lane >> 4);
    for (int run = c.gw; run < T / 32; run += c.ngw) { const int t0 = run * 32, pos0 = t0 & (SEQ - 1);
        float s[8];
#pragma unroll
        for (int i = 0; i < 8; ++i) s[i] = 0.f;
        for (int j = 1; j < w; ++j) { if (pos0 - j >= 0) { float f[8]; unpack8f(*(const v4u*)(up + (size_t)(t0 - j) * 512), f);
#pragma unroll
                for (int i = 0; i < 8; ++i) s[i] += f[i]; } }
#pragma unroll 4
        for (int q = 0; q < 32; ++q) { const int t = t0 + q, pos = pos0 + q; float f[8], o[8]; unpack8f(*(const v4u*)(up + (size_t)t * 512), f);
            const int cnt = (pos + 1 < w) ? pos + 1 : w; const float inv = 1.0f / (float)cnt;
#pragma unroll
            for (int i = 0; i < 8; ++i) { s[i] += f[i]; o[i] = s[i] * inv - f[i]; }
            *(v4u*)(po + (size_t)t * 512) = (v4u){pk2(o[0], o[1]), pk2(o[2], o[3]), pk2(o[4], o[5]), pk2(o[6], o[7])};
            if (pos - w + 1 >= 0) { float g[8]; unpack8f(*(const v4u*)(up + (size_t)(t - w + 1) * 512), g);
#pragma unroll
                for (int i = 0; i < 8; ++i) s[i] -= g[i]; } } }
}

__device__ __forceinline__ void phase_scan(const PT a, const Ctx& c0) {
    Ctx c = c0; c.lane = lane_id(); c.tid = c.wave * 64 + c.lane;
    const float* S = (const float*)(a.ws() + WS_S); bf16* ue = (bf16*)(a.ws() + WS_UEXT);
    const float *lre = a.in(3), *lim = a.in(4), *lstep = a.in(5);
    for (int it = c.gw; it < NG * BATCH; it += c.ngw) { const int g = it >> 4, b = it & 15, p = c.lane;
        const cplx l32 = lam_pow(lre[g * 64 + p], lim[g * 64 + p], __expf(lstep[g]), 32.0f);
        const float* sp = S + ((size_t)g * 2048 + (size_t)b * 128) * 128 + p; bf16* up = ue + ((size_t)g * 2048 + (size_t)b * 128) * 640 + 512 + p;
        cplx X{0.f, 0.f};
        for (int c0 = 0; c0 < NCH; c0 += 16) { float sr[16], si[16];
#pragma unroll
            for (int j = 0; j < 16; ++j) { sr[j] = sp[(size_t)(c0 + j) * 128]; si[j] = sp[(size_t)(c0 + j) * 128 + 64]; }
#pragma unroll
            for (int j = 0; j < 16; ++j) { up[(size_t)(c0 + j) * 640] = (bf16)f2bf(X.re); up[(size_t)(c0 + j) * 640 + 64] = (bf16)f2bf(X.im);
                const cplx n = cmul(l32, X); X.re = n.re + sr[j]; X.im = n.im + si[j]; } } }
}

__device__ __forceinline__ void phase_ln1(const PT a, const Ctx& c0) {
    Ctx c = c0; c.lane = lane_id(); c.tid = c.wave * 64 + c.lane;
    bf16* h1 = (bf16*)(a.ws() + WS_H1); const float *g1 = a.in(17), *b1 = a.in(18);
    f32x4 gv[4], bv[4];
#pragma unroll
    for (int j = 0; j < 4; ++j) { gv[j] = ((const f32x4*)g1)[c.lane + 64 * j]; bv[j] = ((const f32x4*)b1)[c.lane + 64 * j]; }
    for (int m0 = c.gw * 4; m0 < T; m0 += c.ngw * 4) {
        v2u q[4][4];
#pragma unroll
        for (int r = 0; r < 4; ++r) { const v2u* xr = (const v2u*)(h1 + (size_t)(m0 + r) * 1024) + c.lane;
#pragma unroll
            for (int j = 0; j < 4; ++j) q[r][j] = xr[64 * j]; }
#pragma unroll
        for (int r = 0; r < 4; ++r) { const int m = m0 + r; f32x4 v[4]; float sm = 0.f;
#pragma unroll
            for (int j = 0; j < 4; ++j) { v[j] = (f32x4){pg8::bf_lo(q[r][j].x), pg8::bf_hi(q[r][j].x), pg8::bf_lo(q[r][j].y), pg8::bf_hi(q[r][j].y)}; sm += (v[j].x + v[j].y) + (v[j].z + v[j].w); }
            const float mean = wave_sum(sm) * (1.f / 1024.f); float s2 = 0.f;
#pragma unroll
            for (int j = 0; j < 4; ++j) { v[j] = v[j] - mean; s2 += (v[j].x * v[j].x + v[j].y * v[j].y) + (v[j].z * v[j].z + v[j].w * v[j].w); }
            const float rstd = 1.f / sqrtf(wave_sum(s2) * (1.f / 1024.f) + LN_EPS);
            v2u* o = (v2u*)(h1 + (size_t)m * 1024) + c.lane; unsigned* oq = (unsigned*)(a.ws() + WS_H1Q + (size_t)m * 1024) + c.lane;
#pragma unroll
            for (int j = 0; j < 4; ++j) { const f32x4 y = v[j] * rstd * gv[j] + bv[j]; v2u w; w.x = pk2(y.x, y.y); w.y = pk2(y.z, y.w); o[64 * j] = w;
                if (MOE_FP8) { int qq = 0; qq = __builtin_amdgcn_cvt_pk_fp8_f32(y.x, y.y, qq, false); qq = __builtin_amdgcn_cvt_pk_fp8_f32(y.z, y.w, qq, true); oq[64 * j] = (unsigned)qq; } } } }
}

__device__ __forceinline__ void phase_route_count(const PT a, const Ctx& c0) {
    Ctx c = c0; c.lane = lane_id(); c.tid = c.wave * 64 + c.lane;
    LAS int* hist = (LAS int*)c.lds; const int* tope = (const int*)(a.ws() + WS_TOPE); int* cnt = (int*)(a.ws() + WS_CNT);
    for (int w = blockIdx.x; w < 256; w += c.G) {
        if (c.tid < 32) hist[c.tid] = 0;
        __syncthreads();
        { const int slot = c.tid * 2; const int2 e2 = *(const int2*)(tope + (size_t)w * 1024 + slot); atomicAdd((int*)&hist[e2.x], 1); atomicAdd((int*)&hist[e2.y], 1); }
        __syncthreads();
        if (c.tid < 32) cnt[w * 32 + c.tid] = hist[c.tid];
        __syncthreads();
    }
}
__device__ __forceinline__ void phase_route_place(const PT a, const Ctx& c0) {
    Ctx c = c0; c.lane = lane_id(); c.tid = c.wave * 64 + c.lane;
    LAS int* L = (LAS int*)c.lds;
    const int* tope = (const int*)(a.ws() + WS_TOPE); const int* cnt = (const int*)(a.ws() + WS_CNT); int* tpg = (int*)(a.ws() + WS_CNT + 65536);
    for (int w = blockIdx.x; w < 256; w += c.G) { const int s = w / WPS, wl = w % WPS;
        int* rowtok = (int*)(a.ws() + WS_ROWTOK) + (size_t)s * SLAB_ROWS; int* slotpos = (int*)(a.ws() + WS_SLOTPOS);
        if (c.tid < 32) { int tot = 0, pre = 0; for (int q = 0; q < WPS; ++q) { const int v = cnt[(s * WPS + q) * 32 + c.tid]; tot += v; pre += (q < wl) ? v : 0; } L[c.tid] = tot; L[32 + c.tid] = pre; L[96 + c.tid] = 0; }
        __syncthreads();
        if (c.tid == 0) { int acc = 0; for (int e = 0; e < 32; ++e) { L[128 + e] = acc; L[64 + e] = acc * 256; acc += (L[e] + 255) >> 8; } L[160] = acc;
            if (wl == 0) for (int e = 0; e <= 32; ++e) tpg[s * 64 + e] = L[128 + e]; }
        __syncthreads();
        { const int slot = c.tid * 2, tok = w * 256 + (slot >> 2); const int2 e2 = *(const int2*)(tope + (size_t)w * 1024 + slot);
#pragma unroll
          for (int q = 0; q < 2; ++q) { const int e = q ? e2.y : e2.x; const int r = atomicAdd((int*)&L[96 + e], 1); const int pos = L[64 + e] + L[32 + e] + r;
              rowtok[pos] = tok; slotpos[(size_t)tok * 4 + ((slot + q) & 3)] = pos; } }
        if (wl < 32) { const int e = wl, tot = L[e], end = ((tot + 255) >> 8) << 8; for (int r = tot + c.tid; r < end; r += 512) rowtok[L[64 + e] + r] = s * SLAB_T; }
        __syncthreads();
    }
}
__device__ __forceinline__ void phase_combine(const PT a, const Ctx& c0, int s) {
    Ctx c = c0; c.lane = lane_id(); c.tid = c.wave * 64 + c.lane;
    const bf16* y = (const bf16*)(a.ws() + WS_Y); const float* topw = (const float*)(a.ws() + WS_TOPW); float* out = a.out(); const float *g2 = a.in(29), *b2 = a.in(30);
    f32x4 gv[4], bv[4];
#pragma unroll
    for (int j = 0; j < 4; ++j) { gv[j] = ((const f32x4*)g2)[c.lane + 64 * j]; bv[j] = ((const f32x4*)b2)[c.lane + 64 * j]; }
    const bf16* base = (const bf16*)(a.ws() + WS_BASE);
    for (int tl = c.gw; tl < SLAB_T; tl += c.ngw) { const int t = s * SLAB_T + tl; f32x4* xr = (f32x4*)(out + (size_t)t * 1024) + c.lane; f32x4 v[4]; const v2u* br = (const v2u*)(base + (size_t)t * 1024) + c.lane;
        const float4 wk = *(const float4*)(topw + (size_t)t * 4); const float wv[4] = {wk.x, wk.y, wk.z, wk.w};
        const int4 pk = *(const int4*)((const int*)(a.ws() + WS_SLOTPOS) + (size_t)t * 4); const int pv[4] = {pk.x, pk.y, pk.z, pk.w};
#pragma unroll
        for (int j = 0; j < 4; ++j) { const v2u q = br[64 * j]; v[j] = (f32x4){pg8::bf_lo(q.x), pg8::bf_hi(q.x), pg8::bf_lo(q.y), pg8::bf_hi(q.y)}; }
#pragma unroll
        for (int k = 0; k < 4; ++k) {
            if (Y_FP8) { const unsigned* yr = (const unsigned*)((const unsigned char*)y + (size_t)pv[k] * 1024) + c.lane;
#pragma unroll
                for (int j = 0; j < 4; ++j) { const unsigned q = yr[64 * j]; const auto lo = __builtin_amdgcn_cvt_pk_f32_fp8((int)q, false), hi = __builtin_amdgcn_cvt_pk_f32_fp8((int)q, true);
                    v[j] = v[j] + (f32x4){lo[0], lo[1], hi[0], hi[1]} * wv[k]; } }
            else { const v2u* yr = (const v2u*)(y + (size_t)pv[k] * 1024) + c.lane;
#pragma unroll
                for (int j = 0; j < 4; ++j) { const v2u q = yr[64 * j]; v[j] = v[j] + (f32x4){pg8::bf_lo(q.x), pg8::bf_hi(q.x), pg8::bf_lo(q.y), pg8::bf_hi(q.y)} * wv[k]; } } }
        float sm = 0.f;
#pragma unroll
        for (int j = 0; j < 4; ++j) sm += (v[j].x + v[j].y) + (v[j].z + v[j].w);
        const float mean = wave_sum(sm) * (1.f / 1024.f); float s2 = 0.f;
#pragma unroll
        for (int j = 0; j < 4; ++j) { v[j] = v[j] - mean; s2 += (v[j].x * v[j].x + v[j].y * v[j].y) + (v[j].z * v[j].z + v[j].w * v[j].w); }
        const float rstd = 1.f / sqrtf(wave_sum(s2) * (1.f / 1024.f) + LN_EPS);
#pragma unroll
        for (int j = 0; j < 4; ++j) xr[64 * j] = v[j] * rstd * gv[j] + bv[j]; }
}

__global__ void __launch_bounds__(NWAVES * 64, 2) mega_fwd(Args args) {
    extern __shared__ __attribute__((aligned(16))) unsigned char lds_raw[];
    Ctx c;
    c.lds = (LAS unsigned char*)lds_raw;
    c.tid = threadIdx.x; c.lane = c.tid & 63; c.wave = __builtin_amdgcn_readfirstlane(c.tid >> 6);
    c.G = gridDim.x; { const int bx = blockIdx.x; c.vcu = (c.G % 8 == 0) ? (bx % 8) * (c.G / 8) + bx / 8 : bx; }
    c.gw = c.vcu * NWAVES + c.wave; c.ngw = c.G * NWAVES;
    volatile LAS unsigned* MISC = (volatile LAS unsigned*)(c.lds + MISC_OFF);
    for (int u = c.tid; u < (LDS_BYTES - LDSCTL_OFF) / 4; u += NWAVES * 64) ((LAS unsigned*)(c.lds + LDSCTL_OFF))[u] = 0u;
    __syncthreads();
    { LAS unsigned long long* ptw = (LAS unsigned long long*)(c.lds + PTAB_OFF);
      if (c.tid < 31) ptw[c.tid] = (unsigned long long)args.in[c.tid]; else if (c.tid == 31) ptw[31] = (unsigned long long)args.out; else if (c.tid == 32) ptw[32] = (unsigned long long)args.ws; }
    __syncthreads();
    const PT pt{(const LAS unsigned long long*)(c.lds + PTAB_OFF)};
    unsigned char* ws = pt.ws();
    XcdBarrier bar; bar.bar = (unsigned*)(ws + WS_CTL) + CW_BAR + args.li * XCD_BAR_WORDS; bar.x = 0; bar.st = nullptr;
    if (!MK_PER_PHASE) bar = xcd_barrier_post((unsigned*)(ws + WS_CTL) + CW_BAR + args.li * XCD_BAR_WORDS, MISC + 8);
    const int lo = args.ph_lo, hi = args.ph_hi;
#ifndef PH_MASK
#define PH_MASK 0xFFFFFFFFu
#endif
#define IN(k) (((PH_MASK >> (k)) & 1u) && lo <= (k) && (k) < hi)
#define SEAM(k) do { if (IN(k) && IN((k) + 1)) xcd_barrier(bar); } while (0)
    LAS unsigned char* ring = c.lds;
    const int bid = (int)blockIdx.x;
    using namespace pg8;

    if (IN(0)) { phase_prologue(pt, c); }
    SEAM(0);
    if (IN(1)) {
        Prob P{(const char*)(ws + WS_XB), (const char*)(ws + WS_WIN), nullptr, 2048u, 2048u, 128u, 16, 0, 0, c.wave};
        GridOrder S; S.init(T / 256, NIN / 256, c.G, bid, -1);
        EpiInProj E{(bf16_t*)(ws + WS_UEXT), (bf16_t*)(ws + WS_UPOOL), (bf16_t*)(ws + WS_GA), (bf16_t*)(ws + WS_GB)};
        const bool conv_first = ((bid >> 3) & 1) == 0;
        if (MOE_FP8 && conv_first) { phase_moe_convert(pt, c); __syncthreads(); }
        gemm_phase<0, false, EpiInProj, GridOrder, true>(ring, P, S, E);
        if (MOE_FP8 && !conv_first) phase_moe_convert(pt, c);
    }
    SEAM(1);
    if (IN(2)) {
        Prob P{(const char*)(ws + WS_UEXT), (const char*)(ws + WS_WS), nullptr, (unsigned)(UEXT_LD * 2), 1024u, 128u, 8, 256, 0, c.wave};
        GridOrder S; S.init(NG * CHROWS / 256, 1, c.G, bid, 3);
        EpiS E{(float*)(ws + WS_S)};
        gemm_phase<0, false, EpiS, GridOrder, true>(ring, P, S, E);
        phase_pooling(pt, c);
    }
    SEAM(2);
    if (IN(3)) {
        phase_scan(pt, c);
        Prob P{(const char*)(ws + WS_POOLED), (const char*)(ws + WS_WPOOL), nullptr, 1024u, 1024u, 128u, 8, 0, 0, c.wave};
        GridOrder S; S.init(T / 256, 4, c.G, bid, -1);
        EpiPool E{(bf16_t*)(ws + WS_GB)};
        gemm_phase<0, false, EpiPool, GridOrder, true>(ring, P, S, E);
    }
    SEAM(3);
    if (IN(4)) {
        Prob P{(const char*)(ws + WS_UEXT), (const char*)(ws + WS_TV), nullptr, (unsigned)(UEXT_LD * 2), (unsigned)(UEXT_LD * 2), 128u, 10, 512, 0, c.wave};
        GridOrder S; S.init(NG * CHROWS / 256, 2, c.G, bid, 3);
        EpiBf16<1> E{(bf16_t*)(ws + WS_Z), 512};
        gemm_phase<0, false, EpiBf16<1>, GridOrder, true>(ring, P, S, E);
    }
    SEAM(4);
    if (IN(5)) {
        Prob P{(const char*)(ws + WS_Z), (const char*)(ws + WS_WGLU), nullptr, (unsigned)(2 * MiB), 1024u, (unsigned)(8 * MiB), 8, 0, 0, c.wave};
        GridOrder S; S.init(T / 256, 8, c.G, bid, -1);
        EpiGlu E{(bf16_t*)(ws + WS_GA), (const bf16_t*)(ws + WS_GB)};
        gemm_phase<1, false, EpiGlu, GridOrder, true>(ring, P, S, E);
    }
    SEAM(5);
    if (IN(6)) {
        Prob P{(const char*)(ws + WS_GA), (const char*)(ws + WS_WOUT), nullptr, 2048u, 2048u, 128u, 16, 0, 0, c.wave};
        GridOrder S; S.init(T / 256, 4, c.G, bid, -1);
        EpiWout E{(bf16_t*)(ws + WS_H1)};
        gemm_phase<0, false, EpiWout, GridOrder, true>(ring, P, S, E);
    }
    SEAM(6);
    if (IN(7)) {
        const bool rows_first = ((bid >> 3) & 1) == 0;
        if (rows_first) phase_ln1(pt, c);
        Prob P{(const char*)(ws + WS_PB), (const char*)(ws + WS_WPP), nullptr, 512u, 512u, 128u, 4, 0, 0, c.wave};
        GridOrder S; S.init(T / 256, 4, c.G, bid, -1);
        EpiBf16<0> E{(bf16_t*)(ws + WS_PP), 1024};
        gemm_phase<0, false, EpiBf16<0>, GridOrder, true>(ring, P, S, E);
        if (!rows_first) phase_ln1(pt, c);
    }
    SEAM(7);
    if (IN(8)) {
        Prob P{(const char*)(ws + WS_H1), (const char*)(ws + WS_WPLE), nullptr, 2048u, 2048u, 128u, 16, 0, 0, c.wave};
        GridOrder S; S.init(T / 256, 5, c.G, bid, -1);
        EpiPle E{(const bf16_t*)(ws + WS_H1), (const bf16_t*)(ws + WS_PP), (bf16_t*)(ws + WS_BASE), pt.in(20), (int*)(ws + WS_TOPE), (float*)(ws + WS_TOPW)};
        gemm_phase<0, false, EpiPle, GridOrder, true>(ring, P, S, E);
    }
    SEAM(8);
    if (IN(9)) phase_route_count(pt, c);
    SEAM(9);
    if (IN(10)) phase_route_place(pt, c);
    SEAM(10);
#define MOE_SLAB(s) do { constexpr int pa = 11 + 2 * (s), pb = 12 + 2 * (s); \
        LAS int* tp = (LAS int*)(c.lds + TP_OFF); \
        if (IN(pa) || IN(pb)) { const int tid_ = c.wave * 64 + lane_id(); __syncthreads(); if (tid_ < 33) tp[tid_] = ((const int*)(ws + WS_CNT + 65536))[(s) * 64 + tid_]; __syncthreads(); } \
        if (IN(pa)) { \
            const bool rows_first = ((bid >> 3) & 1) == 0; \
            if ((s) > 0 && rows_first) phase_combine(pt, c, (s) - 1); \
            MoeOrder S; S.init((const PG8_LAS int*)tp, 8, c.G, bid); \
            if (STAGGER_US > 0 && ((bid >> 3) & 1)) { const unsigned long long t0_ = __builtin_amdgcn_s_memrealtime(); while (__builtin_amdgcn_s_memrealtime() - t0_ < (unsigned long long)(STAGGER_US * 100)) __builtin_amdgcn_s_sleep(8); } \
            if (MOE_FP8) { \
                Prob P{(const char*)(ws + WS_H1Q), (const char*)(ws + WS_WGU), (const int*)(ws + WS_ROWTOK) + (size_t)(s) * SLAB_ROWS, 1024u, 1024u, 128u, 8, 2048, IB_OFF, c.wave}; \
                EpiM1F8 E{(unsigned char*)(ws + WS_ACT), pt.in(22), pt.in(24)}; \
                if (SHADOW == 11 && (s) == 0) { EpiNull<true> E0; gemm_phase<2, true, EpiNull<true>, MoeOrder, true>(ring, P, S, E0); } \
                gemm_phase<2, true, EpiM1F8, MoeOrder, true>(ring, P, S, E); \
            } else { \
                Prob P{(const char*)(ws + WS_H1), (const char*)(ws + WS_WGU), (const int*)(ws + WS_ROWTOK) + (size_t)(s) * SLAB_ROWS, 2048u, 2048u, 128u, 16, 2048, IB_OFF, c.wave}; \
                EpiM1 E{(bf16_t*)(ws + WS_ACT), pt.in(22), pt.in(24)}; \
                gemm_phase<2, false, EpiM1, MoeOrder, true>(ring, P, S, E); \
            } \
            if ((s) > 0 && !rows_first) phase_combine(pt, c, (s) - 1); \
        } \
        SEAM(pa); \
        if (IN(pb)) { \
            MoeOrder S; S.init((const PG8_LAS int*)tp, 4, c.G, bid); \
            if (MOE_FP8) { \
                Prob P{(const char*)(ws + WS_ACT), (const char*)(ws + WS_WDN), nullptr, 1024u, 1024u, 128u, 8, 1024, 0, c.wave}; \
                EpiM2 E{(unsigned char*)(ws + WS_Y), pt.in(26), 0.015625f}; \
                gemm_phase<0, true, EpiM2, MoeOrder, true>(ring, P, S, E); \
            } else { \
                Prob P{(const char*)(ws + WS_ACT), (const char*)(ws + WS_WDN), nullptr, 2048u, 2048u, 128u, 16, 1024, 0, c.wave}; \
                EpiM2 E{(unsigned char*)(ws + WS_Y), pt.in(26), 1.0f}; \
                gemm_phase<0, false, EpiM2, MoeOrder, true>(ring, P, S, E); \
            } \
        } \
        SEAM(pb); } while (0)
    MOE_SLAB(0);
#if MOE_NSLAB == 2
    MOE_SLAB(1);
#endif
#undef MOE_SLAB
    if (IN(NPHASE - 1)) phase_combine(pt, c, NSLAB - 1);
#undef IN
#undef SEAM
}

extern "C" void kernel_launch(void* const* d_in, const int* in_sizes, int n_in, void* d_out, int out_size, void* d_ws, size_t ws_size, hipStream_t stream) {
    static int grid = 0;
    if (grid == 0) {
        if (n_in != 31 || in_sizes[0] != T * D || out_size != T * D || ws_size < WS_END) { fprintf(stderr, "kernel_launch: unexpected problem (n_in %d, in0 %d, out %d, ws %zu); nothing launched\n", n_in, n_in > 0 ? in_sizes[0] : -1, out_size, ws_size); grid = -1; return; }
        int dev = 0, cus = 0, per_cu = 0;
        if (hipGetDevice(&dev) != hipSuccess || hipDeviceGetAttribute(&cus, hipDeviceAttributeMultiprocessorCount, dev) != hipSuccess) { grid = -1; return; }
        if (hipFuncSetAttribute((const void*)mega_fwd, hipFuncAttributeMaxDynamicSharedMemorySize, LDS_BYTES) != hipSuccess) { fprintf(stderr, "kernel_launch: hipFuncSetAttribute failed\n"); grid = -1; return; }
        if (hipOccupancyMaxActiveBlocksPerMultiprocessor(&per_cu, (const void*)mega_fwd, NWAVES * 64, LDS_BYTES) != hipSuccess || per_cu < 1) { fprintf(stderr, "kernel_launch: occupancy query reports %d workgroups per CU\n", per_cu); }
        (void)hipGetLastError();
        grid = cus;
    }
    if (grid < 0) return;
    if (hipMemsetAsync((char*)d_ws + WS_CTL, 0, CTL_ZERO_BYTES, stream) != hipSuccess) return;
    Args a{};
    for (int i = 0; i < 31; ++i) a.in[i] = (const float*)d_in[i];
    a.out = (float*)d_out; a.ws = (unsigned char*)d_ws; a.pad = 0;
#if MK_PER_PHASE
    for (int ph = 0; ph < NPHASE; ++ph) { a.ph_lo = ph; a.ph_hi = ph + 1; a.li = 0; hipLaunchKernelGGL(mega_fwd, dim3(grid), dim3(NWAVES * 64), LDS_BYTES, stream, a); }
#elif defined(PROBE_REPEAT)
    a.ph_lo = 0; a.ph_hi = PROBE_REPEAT + 1; a.li = 0; hipLaunchKernelGGL(mega_fwd, dim3(grid), dim3(NWAVES * 64), LDS_BYTES, stream, a);
    a.ph_lo = PROBE_REPEAT; a.ph_hi = NPHASE; a.li = 1; hipLaunchKernelGGL(mega_fwd, dim3(grid), dim3(NWAVES * 64), LDS_BYTES, stream, a);
#else
    a.ph_lo = 0; a.ph_hi = NPHASE; a.li = 0;
    hipLaunchKernelGGL(mega_fwd, dim3(grid), dim3(NWAVES * 64), LDS_BYTES, stream, a);
#endif
}
```

```cpp
#include <hip/hip_runtime.h>
#include <cstdio>
#include <cstdint>

#ifndef SHADOW
#define SHADOW 0
#endif
#ifndef MOE_FP8
#define MOE_FP8 1
#endif
#ifndef Y_FP8
#define Y_FP8 1
#endif
#ifndef STAGGER_US
#define STAGGER_US 0
#endif
#ifndef MK_PER_PHASE
#define MK_PER_PHASE 0
#endif

namespace pg8 {
#define PG8_LAS __attribute__((address_space(3)))
typedef unsigned short bf16_t;
typedef short bf16x8 __attribute__((ext_vector_type(8)));
typedef float f32x4 __attribute__((ext_vector_type(4)));
typedef float f32x2 __attribute__((ext_vector_type(2)));
typedef unsigned u32x4 __attribute__((ext_vector_type(4)));
typedef unsigned u32x2 __attribute__((ext_vector_type(2)));
constexpr int BM = 256, BK = 64, HALF = 128, HTB = HALF * BK * 2  , STAGE_BYTES = 8 * HTB, NXCD = 8, WGM = 8;

__host__ __device__ __forceinline__ int lds_byte(int r, int c) { const int st = (r >> 4) * 2 + (c >> 5), rr = r & 15, cc = c & 31, ob = rr * 64 + cc * 2; return st * 1024 + (ob ^ (((ob >> 9) & 1) << 5)); }
__host__ __device__ __forceinline__ void stage_rc(int b, int& R, int& C) { const int st = b / 1024, sb = b % 1024, swz = sb ^ (((sb >> 9) & 1) << 5); R = (st >> 1) * 16 + swz / 64; C = (st & 1) * 32 + (swz % 64) / 2; }
__host__ __device__ __forceinline__ int perm32(int rho) { const int n = rho >> 4, i = rho & 15; return 8 * (i >> 2) + 4 * n + (i & 3); }

struct Unit { int pm, pn, aux; };

struct Prob {
    const char* A; const char* B; const int* gidx;
    unsigned lda;
    unsigned ldb;
    unsigned kstepA;
    int nt;
    int bgn;
    int ib_off;
    int wid;
    int wscale;
};

struct GridOrder {
    int nM, nN, nwg, G, c, gshift;
    __device__ void init(int nM_, int nN_, int G_, int c_, int gshift_) { nM = nM_; nN = nN_; nwg = nM * nN; G = G_; c = c_; gshift = gshift_; }
    __device__ bool next(int i, Unit& u) const {
        const long L = (long)i * G + c; if (L >= nwg) return false;
        int wgid = (int)L; { const int q = nwg / NXCD, r = nwg % NXCD, xcd = wgid % NXCD, off = wgid / NXCD; wgid = (xcd < r ? xcd * (q + 1) : r * (q + 1) + (xcd - r) * q) + off; }
        const int nig = WGM * nN, gid = wgid / nig, fm = gid * WGM, gsz = (nM - fm) < WGM ? (nM - fm) : WGM;
        u.pm = fm + ((wgid % nig) % gsz); u.pn = (wgid % nig) / gsz; u.aux = gshift >= 0 ? (u.pm >> gshift) : 0; return true;
    }
};
struct MoeOrder {
    const PG8_LAS int* tp; int nct, total, G, c;
    __device__ void init(const PG8_LAS int* tp_, int nct_, int G_, int c_) { tp = tp_; nct = nct_; G = G_; c = c_; total = __builtin_amdgcn_readfirstlane(tp_[32]) * nct_; }
    __device__ bool next(int i, Unit& u) const {
        const long L = (long)i * G + c; if (L >= total) return false;
        int wgid = (int)L; { const int q = total / NXCD, r = total % NXCD, xcd = wgid % NXCD, off = wgid / NXCD; wgid = (xcd < r ? xcd * (q + 1) : r * (q + 1) + (xcd - r) * q) + off; }
        int ln = (int)__builtin_amdgcn_mbcnt_hi(~0u, __builtin_amdgcn_mbcnt_lo(~0u, 0u)); asm volatile("" : "+v"(ln));
        int e = __builtin_popcountll(__ballot(ln < 31 && wgid >= tp[(ln < 31 ? ln : 30) + 1] * nct)); e = __builtin_amdgcn_readfirstlane(e);
        const int t0 = __builtin_amdgcn_readfirstlane(tp[e]), nte = __builtin_amdgcn_readfirstlane(tp[e + 1]) - t0, local = wgid - t0 * nct;
        (void)nte; u.pn = __builtin_amdgcn_readfirstlane(local % nct); u.pm = __builtin_amdgcn_readfirstlane(t0 + local / nct); u.aux = e; return true;
    }
};

__device__ __forceinline__ unsigned cvt_pk_bf16(float lo, float hi) { unsigned r; asm volatile("v_cvt_pk_bf16_f32 %0, %1, %2" : "=v"(r) : "v"(lo), "v"(hi)); return r; }
__device__ __forceinline__ float bf_lo(unsigned w) { return __uint_as_float(w << 16); }
__device__ __forceinline__ float bf_hi(unsigned w) { return __uint_as_float(w & 0xffff0000u); }
__device__ __forceinline__ float sigmoid_f(float x) { return __builtin_amdgcn_rcpf(1.0f + __builtin_amdgcn_exp2f(-1.4426950409f * x)); }

typedef int v4i __attribute__((ext_vector_type(4)));
typedef int v8i __attribute__((ext_vector_type(8)));
template <bool FP8> __device__ __forceinline__ void stage_map(int p, int& R, int& Cb) {
    if (FP8) { R = (p >> 11) * 16 + ((p & 255) >> 4); Cb = ((p & 2047) >> 8) * 16; }
    else { int C; stage_rc(p, R, C); Cb = 2 * C; }
}
template <int AMODE, bool FP8, class Epi, class Sched, bool ALIGN_EPI>
__device__ __forceinline__ void gemm_phase(PG8_LAS unsigned char* lds, const Prob P, const Sched& S, const Epi& E) {
    const int wid = P.wid, lane = (int)__builtin_amdgcn_mbcnt_hi(~0u, __builtin_amdgcn_mbcnt_lo(~0u, 0u)), tid = wid * 64 + lane, wr = wid >> 2, wc = wid & 3, fr = lane & 15, fq = lane >> 4;
    const int nt = P.nt;
    unsigned vo[2][2], voffB[2];
#pragma unroll
    for (int i = 0; i < 2; ++i) { int R, Cb; stage_map<FP8>(tid * 16 + i * 8192, R, Cb); const int Rb = Epi::PERM ? ((R & ~31) + perm32(R & 31)) : R;
        voffB[i] = (unsigned)Rb * P.ldb + (unsigned)Cb;
#pragma unroll
        for (int h = 0; h < 2; ++h) {
            if (AMODE == 0) vo[h][i] = (unsigned)(h * HALF + R) * P.lda + (unsigned)Cb;
            else if (AMODE == 1) vo[h][i] = (unsigned)(Cb >> 5) * P.lda + (unsigned)(h * HALF + R) * 32u + (unsigned)(Cb & 31);
            else vo[h][i] = 0u; } }
    const unsigned kstepA = P.kstepA, kstepB = (unsigned)(BK * 2);
    const unsigned hstepB = (unsigned)HALF * P.ldb;
    const unsigned ldsw = (unsigned)wid * 1024u;
    const int aoff = FP8 ? (wr * 4 * 2048 + 2 * fq * 256 + fr * 16) : lds_byte(wr * 64 + fr, fq * 8), boff = FP8 ? (wc * 2 * 2048 + 2 * fq * 256 + fr * 16) : lds_byte(wc * 32 + fr, fq * 8);
    constexpr int KOFF = FP8 ? 256 : 1024;
    const int sc1 = 0x7F7F7F7F;
#define PG8_AOFF(u) ((unsigned)(AMODE == 0 ? (unsigned)(u).pm * BM * P.lda : (AMODE == 1 ? (unsigned)(u).pm * BM * 32u : 0u)))
#define PG8_BOFF(u) ((unsigned)(((unsigned)(u).aux * P.bgn + (unsigned)(u).pn * BM) * P.ldb))
#define PG8_GIDX(src, dst) do { _Pragma("unroll") for (int _i = 0; _i < 2; ++_i) { int _R, _C; stage_map<FP8>(tid * 16 + _i * 8192, _R, _C); _Pragma("unroll") for (int _h = 0; _h < 2; ++_h) \
        dst[_h][_i] = (unsigned)(src)[_h * HALF + _R] * P.lda + (unsigned)_C; } } while (0)
#define PG8_SA(b, h) (((b) * 2 + (h)) * HTB)
#define PG8_SB(b, h) ((4 + (b) * 2 + (h)) * HTB)
    const __amdgpu_buffer_rsrc_t rsA = __builtin_amdgcn_make_buffer_rsrc((void*)P.A, 0, 0xFFFFFFFF, 0x00020000);
    const __amdgpu_buffer_rsrc_t rsB = __builtin_amdgcn_make_buffer_rsrc((void*)P.B, 0, 0xFFFFFFFF, 0x00020000);
#define PG8_STAGE2(bufoff, rs, so, v0, v1) do { \
        __builtin_amdgcn_raw_ptr_buffer_load_lds(rs, (PG8_LAS void*)(lds + (bufoff) + ldsw), 16, (int)(v0), (int)(so), 0, 0); \
        __builtin_amdgcn_raw_ptr_buffer_load_lds(rs, (PG8_LAS void*)(lds + (bufoff) + ldsw + 8192), 16, (int)(v1), (int)(so), 0, 0); } while (0)
#define PG8_STAGE_A(bufoff, so, h) PG8_STAGE2(bufoff, rsA, so, vo[h][0], vo[h][1])
#define PG8_STAGE_B(bufoff, so) PG8_STAGE2(bufoff, rsB, so, voffB[0], voffB[1])
#define PG8_LDA(dst, b, h) do { _Pragma("unroll") for (int m = 0; m < 4; ++m) _Pragma("unroll") for (int k = 0; k < 2; ++k) dst[m][k] = *(const PG8_LAS bf16x8*)(lds + PG8_SA(b, h) + aoff + m * 2048 + k * KOFF); } while (0)
#define PG8_LDB(dst, b, h) do { _Pragma("unroll") for (int n = 0; n < 2; ++n) _Pragma("unroll") for (int k = 0; k < 2; ++k) dst[n][k] = *(const PG8_LAS bf16x8*)(lds + PG8_SB(b, h) + boff + n * 2048 + k * KOFF); } while (0)
#define PG8_MMA(ai, bj, At, Bt) do { __builtin_amdgcn_s_setprio(1); _Pragma("unroll") for (int m = 0; m < 4; ++m) _Pragma("unroll") for (int n = 0; n < 2; ++n) { \
        if constexpr (FP8) { acc[ai][bj][m][n] = __builtin_amdgcn_mfma_scale_f32_16x16x128_f8f6f4( \
                __builtin_shufflevector(__builtin_bit_cast(v4i, Bt[n][0]), __builtin_bit_cast(v4i, Bt[n][1]), 0, 1, 2, 3, 4, 5, 6, 7), \
                __builtin_shufflevector(__builtin_bit_cast(v4i, At[m][0]), __builtin_bit_cast(v4i, At[m][1]), 0, 1, 2, 3, 4, 5, 6, 7), acc[ai][bj][m][n], 0, 0, 0, P.wscale, 0, sc1); } \
        else { _Pragma("unroll") for (int k = 0; k < 2; ++k) acc[ai][bj][m][n] = __builtin_amdgcn_mfma_f32_16x16x32_bf16(Bt[n][k], At[m][k], acc[ai][bj][m][n], 0, 0, 0); } } \
        __builtin_amdgcn_s_setprio(0); } while (0)
#define PG8_WAIT_V(n) asm volatile("s_waitcnt vmcnt(" #n ")" ::: "memory")
#define PG8_WAIT_L(n) asm volatile("s_waitcnt lgkmcnt(" #n ")" ::: "memory")
#define PG8_BAR __builtin_amdgcn_s_barrier()
#define PG8_SCHED __builtin_amdgcn_sched_barrier(0)
    Unit cur, nxt; int ui = 0;
    if (!S.next(0, cur)) return;
    f32x4 acc[2][2][4][2];
    { f32x4 ini[2][2];
    E.init(cur, wc, fq, ini);
#pragma unroll
    for (int a = 0; a < 2; ++a)
#pragma unroll
        for (int b = 0; b < 2; ++b)
#pragma unroll
            for (int m = 0; m < 4; ++m)
#pragma unroll
                for (int n = 0; n < 2; ++n) acc[a][b][m][n] = ini[b][n]; }
    bf16x8 At[4][2], B0[2][2], B1[2][2];
    unsigned cA = PG8_AOFF(cur), cB = PG8_BOFF(cur);
    if (AMODE == 2) { const int* gi = P.gidx + cur.pm * BM; PG8_GIDX(gi, vo); }
    PG8_STAGE_B(PG8_SB(0, 0), cB); PG8_STAGE_B(PG8_SB(0, 1), cB + hstepB); PG8_STAGE_A(PG8_SA(0, 0), cA, 0); PG8_STAGE_A(PG8_SA(0, 1), cA, 1);
    if (wr == 1) PG8_BAR;
    PG8_WAIT_V(2); PG8_BAR;
    PG8_STAGE_B(PG8_SB(1, 0), cB + kstepB); PG8_STAGE_A(PG8_SA(1, 0), cA + kstepA, 0); PG8_STAGE_B(PG8_SB(1, 1), cB + hstepB + kstepB);
    PG8_WAIT_V(6); PG8_BAR;
    for (;;) {
        const bool has_next = S.next(ui + 1, nxt);
        const unsigned nA = has_next ? PG8_AOFF(nxt) : cA, nB = has_next ? PG8_BOFF(nxt) : cB;
#pragma nounroll
        for (int t = 0; t < nt; t += 2) {
            const bool last = (t == nt - 2);
            const unsigned a1 = cA + (unsigned)(t + 1) * kstepA;
            const unsigned a2 = last ? nA : cA + (unsigned)(t + 2) * kstepA, b2 = last ? nB : cB + (unsigned)(t + 2) * kstepB;
            const unsigned a3 = a2 + kstepA, b3 = b2 + kstepB;
            if (AMODE == 2) { if (t == 0 && has_next && wid < 4)
                    __builtin_amdgcn_global_load_lds((const unsigned*)(P.gidx + nxt.pm * BM + wid * 64 + lane), (PG8_LAS unsigned*)(lds + P.ib_off + (((ui + 1) & 1) * 256 + wid * 64) * 4), 4, 0, 0); }
            PG8_LDB(B0, 0, 0); PG8_LDB(B1, 0, 1); PG8_SCHED; PG8_LDA(At, 0, 0); PG8_STAGE_A(PG8_SA(1, 1), a1, 1);
            if (AMODE == 2) { if (last && has_next) { const PG8_LAS int* ib = (const PG8_LAS int*)(lds + P.ib_off) + ((ui + 1) & 1) * 256; PG8_GIDX(ib, vo); } }
            PG8_WAIT_V(8); PG8_WAIT_L(0); PG8_BAR; PG8_MMA(0, 0, At, B0); PG8_MMA(0, 1, At, B1); PG8_BAR; PG8_SCHED;
            PG8_LDA(At, 0, 1); PG8_STAGE_B(PG8_SB(0, 0), b2); PG8_STAGE_B(PG8_SB(0, 1), b2 + hstepB); PG8_STAGE_A(PG8_SA(0, 0), a2, 0);
            PG8_WAIT_V(8); PG8_WAIT_L(0); PG8_BAR; PG8_MMA(1, 0, At, B0); PG8_MMA(1, 1, At, B1); PG8_BAR; PG8_SCHED;
            PG8_LDB(B0, 1, 0); PG8_LDB(B1, 1, 1); PG8_SCHED; PG8_LDA(At, 1, 0); PG8_STAGE_A(PG8_SA(0, 1), a2, 1);
            PG8_WAIT_V(8); PG8_WAIT_L(0); PG8_BAR; PG8_MMA(0, 0, At, B0); PG8_MMA(0, 1, At, B1); PG8_BAR; PG8_SCHED;
            PG8_LDA(At, 1, 1); PG8_STAGE_B(PG8_SB(1, 0), b3); PG8_STAGE_B(PG8_SB(1, 1), b3 + hstepB); PG8_STAGE_A(PG8_SA(1, 0), a3, 0);
            PG8_WAIT_V(8); PG8_WAIT_L(0); PG8_BAR; PG8_MMA(1, 0, At, B0); PG8_MMA(1, 1, At, B1); PG8_BAR; PG8_SCHED;
        }
        if constexpr (ALIGN_EPI) { if (wr == 0) PG8_BAR; }
        { int fr2 = fr, fq2 = fq; asm volatile("" : "+v"(fr2), "+v"(fq2));
          f32x4 nini[2][2];
          if (has_next) E.init(nxt, wc, fq2, nini); else nini[0][0] = nini[0][1] = nini[1][0] = nini[1][1] = (f32x4){0.f, 0.f, 0.f, 0.f};
          E(acc, cur, wr, wc, fr2, fq2);
#pragma unroll
          for (int a = 0; a < 2; ++a)
#pragma unroll
            for (int b = 0; b < 2; ++b)
#pragma unroll
                for (int m = 0; m < 4; ++m)
#pragma unroll
                    for (int n = 0; n < 2; ++n) acc[a][b][m][n] = nini[b][n]; }
        if (!has_next) break;
        cur = nxt; cA = nA; cB = nB; ++ui;
        if constexpr (ALIGN_EPI) { if (wr == 1) PG8_BAR; }
    }
    PG8_WAIT_V(0);
    if constexpr (!ALIGN_EPI) { if (wr == 0) PG8_BAR; }
    PG8_BAR;
#undef PG8_AOFF
#undef PG8_BOFF
#undef PG8_GIDX
#undef PG8_SA
#undef PG8_SB
#undef PG8_STAGE2
#undef PG8_STAGE_B
#undef PG8_STAGE_A
#undef PG8_LDA
#undef PG8_LDB
#undef PG8_MMA
#undef PG8_WAIT_V
#undef PG8_WAIT_L
#undef PG8_BAR
#undef PG8_SCHED
}
}

constexpr int NWAVES = 8;
constexpr int BATCH = 16, SEQ = 4096, D = 1024, T = BATCH * SEQ;
constexpr int PLE = 256, SSMW = 512, POOLW = 512, NG = 32, GH = 16, NP = 64;
constexpr int LC = 32, NCH = SEQ / LC, CHROWS = BATCH * NCH;
constexpr int UEXT_LD = 640;
constexpr int NEXP = 32, TOPK = 4, NIN = 3072;
#ifndef MOE_NSLAB
#define MOE_NSLAB 1
#endif
constexpr int NSLAB = MOE_NSLAB, WPS = 256 / NSLAB  , SLAB_T = T / NSLAB, SLAB_ROWS = (SLAB_T * TOPK / 256 + NEXP) * 256;
constexpr float LN_EPS = 1e-5f, DN_ALPHA = 1.189207115002721f, SW_LIMIT = 7.0f, SW_ALPHA = 1.702f;
constexpr int NPHASE = 12 + 2 * NSLAB;

constexpr size_t MiB = 1u << 20;
constexpr size_t WS_WGU = 0 * MiB;
constexpr size_t WS_WDN = 128 * MiB;
constexpr size_t WS_WIN = 192 * MiB;
constexpr size_t WS_WGLU = 198 * MiB;
constexpr size_t WS_WPOOL = 200 * MiB;
constexpr size_t WS_WOUT = 201 * MiB;
constexpr size_t WS_WPLE = 203 * MiB;
constexpr size_t WS_WPP = 206 * MiB;
constexpr size_t WS_WS = 207 * MiB;
constexpr size_t WS_TV = 215 * MiB;
constexpr size_t WS_CTL = 235 * MiB;
constexpr size_t WS_TOPE = 236 * MiB;
constexpr size_t WS_TOPW = 237 * MiB;
constexpr size_t WS_ROWTOK = 238 * MiB;
constexpr size_t WS_SLOTPOS = 240 * MiB;
constexpr size_t WS_CNT = 242 * MiB;
constexpr size_t WS_XB = 244 * MiB;
constexpr size_t WS_H1 = 244 * MiB;
constexpr size_t WS_UEXT = 372 * MiB;
constexpr size_t WS_UPOOL = 452 * MiB;
constexpr size_t WS_PP = 372 * MiB;
constexpr size_t WS_GA = 516 * MiB;
constexpr size_t WS_GB = 644 * MiB;
constexpr size_t WS_POOLED = 772 * MiB;
constexpr size_t WS_S = 836 * MiB;
constexpr size_t WS_Z = 868 * MiB;
constexpr size_t WS_PB = 932 * MiB;
constexpr size_t WS_ACT = (NSLAB == 1 ? 244 : 372) * MiB;
constexpr size_t WS_BASE = 580 * MiB;
constexpr size_t WS_Y = (NSLAB == 1 ? 708 : 752) * MiB;
constexpr size_t WS_H1Q = 516 * MiB;
constexpr size_t WS_END = 1024 * MiB;
static_assert(MOE_FP8 && Y_FP8, "the workspace map below assumes e4m3 act and y");
static_assert(WS_BASE + (size_t)T * 2048 <= WS_Y && WS_H1Q + (size_t)T * 1024 <= WS_BASE && WS_ACT + (size_t)SLAB_ROWS * 1024 <= WS_H1Q && WS_Y + (size_t)SLAB_ROWS * 1024 <= WS_END && (size_t)NSLAB * SLAB_ROWS * 4 <= 2 * MiB && WS_PB + (size_t)T * PLE * 2 <= WS_END, "ws map");
constexpr size_t CTL_ZERO_BYTES = 1 * MiB;
constexpr int CW_BAR = 4096;

constexpr int RING_BYTES = 131072;
constexpr int LDSCTL_OFF = RING_BYTES, MISC_OFF = LDSCTL_OFF + 320;
constexpr int TP_OFF = LDSCTL_OFF + 1024, IB_OFF = TP_OFF + 512, PTAB_OFF = IB_OFF + 2048;
constexpr int LDS_BYTES = 147456;

#define GAS __attribute__((address_space(1)))
#define LAS __attribute__((address_space(3)))
typedef unsigned short bf16;
typedef unsigned v4u __attribute__((ext_vector_type(4)));
typedef unsigned v2u __attribute__((ext_vector_type(2)));
typedef float f32x4 __attribute__((ext_vector_type(4)));
typedef GAS unsigned gu32;
#define RLX_AGENT __ATOMIC_RELAXED, __HIP_MEMORY_SCOPE_AGENT
#define LDS_WAIT() asm volatile("s_waitcnt lgkmcnt(0)" ::: "memory")
#define VM_WAIT() asm volatile("s_waitcnt vmcnt(0)" ::: "memory")
__device__ __forceinline__ unsigned f2bf(float f) { unsigned u = __builtin_bit_cast(unsigned, f); return (u + 0x7fffu + ((u >> 16) & 1u)) >> 16; }
__device__ __forceinline__ unsigned pk2(float lo, float hi) { return f2bf(lo) | (f2bf(hi) << 16); }
__device__ __forceinline__ float bf2f(unsigned short b) { return __uint_as_float(((unsigned)b) << 16); }

#define XB_TMO      128
#define XB_XCNT(j)  (256  + 64 * (j))
#define XB_XSUB(j)  (1280 + 64 * (j))
#define XB_XGEN(j)  (2304 + 64 * (j))
#define XB_TOP      3328
#define XB_TOPGEN   3392
#define XCD_BAR_WORDS 3456
#define XB_SPIN_CAP (1u << 18)

__device__ __forceinline__ unsigned xb_ld(unsigned* p)              { return __hip_atomic_load(p, __ATOMIC_RELAXED, __HIP_MEMORY_SCOPE_AGENT); }
__device__ __forceinline__ unsigned xb_add(unsigned* p, unsigned v) { return __hip_atomic_fetch_add(p, v, __ATOMIC_RELAXED, __HIP_MEMORY_SCOPE_AGENT); }
__device__ __forceinline__ unsigned xb_xcc_id() { return (unsigned)__builtin_amdgcn_s_getreg((3 << 11) | 20) & 0xFu; }
#define XB_SPIN(cond, bar) do { unsigned _sp = 0; while (cond) { __builtin_amdgcn_s_sleep(1); \
    if ((++_sp & 255u) == 0u) { if (xb_ld(&(bar)[XB_TMO])) break; if (_sp > XB_SPIN_CAP) { atomicAdd(&(bar)[XB_TMO], 1u); break; } } } } while (0)

struct XcdBarrier {
    unsigned* bar; unsigned x;
    volatile LAS unsigned* st;
};

__device__ __forceinline__ XcdBarrier xcd_barrier_post(unsigned* bar, volatile LAS unsigned* st) {
    XcdBarrier b; b.bar = bar; b.x = xb_xcc_id(); b.st = st;
    if (threadIdx.x == 0) (void)xb_add(&bar[XB_XCNT(b.x)], 1u);
    return b;
}
__device__ __forceinline__ void xcd_barrier_complete(unsigned* bar, unsigned x, unsigned& nloc, unsigned& nx) {
    const unsigned G = gridDim.x * gridDim.y * gridDim.z;
    unsigned sum, cnt, mine, sp = 0u;
    for (;;) {
        sum = 0u; cnt = 0u; mine = 0u;
#pragma unroll
        for (unsigned j = 0; j < 16; ++j) { const unsigned c = xb_ld(&bar[XB_XCNT(j)]); sum += c; cnt += (c > 0u) ? 1u : 0u; mine = (j == x) ? c : mine; }
        if (sum == G) break;
        __builtin_amdgcn_s_sleep(1);
        if ((++sp & 255u) == 0u) { if (xb_ld(&bar[XB_TMO])) break; if (sp > XB_SPIN_CAP) { atomicAdd(&bar[XB_TMO], 1u); break; } }
    }
    nloc = mine > 0u ? mine : 1u; nx = cnt > 0u ? cnt : 1u;
}

__device__ __forceinline__ void xcd_barrier(const XcdBarrier& b) {
    asm volatile("s_waitcnt vmcnt(0)" ::: "memory");
    __syncthreads();
    if (threadIdx.x == 0) {
        unsigned* bar = b.bar;
        __builtin_amdgcn_s_waitcnt(0);
        unsigned nloc = b.st[0], nx = b.st[1];
        if (nloc == 0u) { xcd_barrier_complete(bar, b.x, nloc, nx); b.st[0] = nloc; b.st[1] = nx; }
        const unsigned old = xb_add(&bar[XB_XSUB(b.x)], 1u);
        const unsigned gen = old / nloc;
        if (old + 1u == (gen + 1u) * nloc) {
            __builtin_amdgcn_fence(__ATOMIC_RELEASE, "agent");
            asm volatile("s_waitcnt vmcnt(0)" ::: "memory");
            const unsigned og = xb_add(&bar[XB_TOP], 1u);
            const unsigned tg = og / nx;
            if (og + 1u == (tg + 1u) * nx) xb_add(&bar[XB_TOPGEN], 1u);
            else XB_SPIN(xb_ld(&bar[XB_TOPGEN]) == tg, bar);
            __builtin_amdgcn_fence(__ATOMIC_ACQUIRE, "agent");
            xb_add(&bar[XB_XGEN(b.x)], 1u);
            asm volatile("s_waitcnt vmcnt(0)" ::: "memory");
        } else {
            XB_SPIN(xb_ld(&bar[XB_XGEN(b.x)]) == gen, bar);
            __builtin_amdgcn_fence(__ATOMIC_ACQUIRE, "agent");
            asm volatile("s_waitcnt vmcnt(0)" ::: "memory");
        }
    }
    __syncthreads();
}

namespace pg8 {
#define EPI_ROW(u, ai, m) ((u).pm * BM + (ai) * HALF + wr * 64 + (m) * 16 + fr)
#define EPI_COL8(u, bj) ((u).pn * BM + (bj) * HALF + wc * 32 + 8 * fq)
#define EPI_COL4(u, bj, n) ((u).pn * BM + (bj) * HALF + wc * 32 + 16 * (n) + 4 * fq)
__device__ __forceinline__ u32x4 pack8(const f32x4 a, const f32x4 b) { u32x4 w; w.x = cvt_pk_bf16(a[0], a[1]); w.y = cvt_pk_bf16(a[2], a[3]); w.z = cvt_pk_bf16(b[0], b[1]); w.w = cvt_pk_bf16(b[2], b[3]); return w; }
__device__ __forceinline__ void unpack8(const u32x4 w, f32x4& a, f32x4& b) { a = (f32x4){bf_lo(w.x), bf_hi(w.x), bf_lo(w.y), bf_hi(w.y)}; b = (f32x4){bf_lo(w.z), bf_hi(w.z), bf_lo(w.w), bf_hi(w.w)}; }
__device__ __forceinline__ f32x4 sig4(const f32x4 v) { return (f32x4){sigmoid_f(v[0]), sigmoid_f(v[1]), sigmoid_f(v[2]), sigmoid_f(v[3])}; }
__device__ __forceinline__ float gelu_tanh(float x) { return x * sigmoid_f(1.5957691216f * (x + 0.044715f * x * x * x)); }

template <bool PERM_> struct EpiNull {
    static constexpr bool PERM = PERM_;
    __device__ __forceinline__ void init(const Unit& u, int wc, int fq, f32x4 (&ini)[2][2]) const { ini[0][0] = ini[0][1] = ini[1][0] = ini[1][1] = (f32x4){0.f, 0.f, 0.f, 0.f}; }
    __device__ __forceinline__ void operator()(const f32x4 (&acc)[2][2][4][2], const Unit& u, int wr, int wc, int fr, int fq) const {
#pragma unroll
        for (int ai = 0; ai < 2; ++ai)
#pragma unroll
            for (int bj = 0; bj < 2; ++bj)
#pragma unroll
                for (int m = 0; m < 4; ++m)
#pragma unroll
                    for (int n = 0; n < 2; ++n) asm volatile("" :: "v"(acc[ai][bj][m][n]));
    }
};
struct EpiInProj {
    static constexpr bool PERM = true;
    __device__ __forceinline__ void init(const Unit& u, int wc, int fq, f32x4 (&ini)[2][2]) const { ini[0][0] = ini[0][1] = ini[1][0] = ini[1][1] = (f32x4){0.f, 0.f, 0.f, 0.f}; }
    bf16_t* uext; bf16_t* upool; bf16_t* ga; bf16_t* gb;
    __device__ __forceinline__ void operator()(const f32x4 (&acc)[2][2][4][2], const Unit& u, int wr, int wc, int fr, int fq) const {
#pragma unroll
        for (int ai = 0; ai < 2; ++ai)
#pragma unroll
            for (int m = 0; m < 4; ++m) { const int t = EPI_ROW(u, ai, m);
#pragma unroll
                for (int bj = 0; bj < 2; ++bj) { const int c = EPI_COL8(u, bj); f32x4 v0 = acc[ai][bj][m][0], v1 = acc[ai][bj][m][1]; bf16_t* dst;
                    if (u.pn < 2) { const int g = c >> 4, h0 = c & 15; dst = uext + ((size_t)g * 2048 + (size_t)(t >> 5)) * 640 + (size_t)((t & 31) * 16 + h0); }
                    else if (u.pn < 4) dst = upool + (size_t)t * 512 + (c - 512);
                    else { v0 = sig4(v0); v1 = sig4(v1); dst = (u.pn < 8) ? ga + (size_t)t * 1024 + (c - 1024) : gb + (size_t)t * 1024 + (c - 2048); }
                    *(u32x4*)dst = pack8(v0, v1); } }
    }
};
struct EpiS {
    static constexpr bool PERM = false;
    __device__ __forceinline__ void init(const Unit& u, int wc, int fq, f32x4 (&ini)[2][2]) const { ini[0][0] = ini[0][1] = ini[1][0] = ini[1][1] = (f32x4){0.f, 0.f, 0.f, 0.f}; }
    float* S;
    __device__ __forceinline__ void operator()(const f32x4 (&acc)[2][2][4][2], const Unit& u, int wr, int wc, int fr, int fq) const {
#pragma unroll
        for (int ai = 0; ai < 2; ++ai)
#pragma unroll
            for (int m = 0; m < 4; ++m) { float* rowp = S + (size_t)EPI_ROW(u, ai, m) * 128 + wc * 32 + 4 * fq;
#pragma unroll
                for (int n = 0; n < 2; ++n) *(f32x4*)(rowp + 16 * n) = acc[ai][0][m][n]; }
    }
};
template <int ACT> struct EpiBf16 {
    static constexpr bool PERM = true;
    __device__ __forceinline__ void init(const Unit& u, int wc, int fq, f32x4 (&ini)[2][2]) const { ini[0][0] = ini[0][1] = ini[1][0] = ini[1][1] = (f32x4){0.f, 0.f, 0.f, 0.f}; }
    bf16_t* O; int ldc;
    __device__ __forceinline__ void operator()(const f32x4 (&acc)[2][2][4][2], const Unit& u, int wr, int wc, int fr, int fq) const {
#pragma unroll
        for (int ai = 0; ai < 2; ++ai)
#pragma unroll
            for (int m = 0; m < 4; ++m) { bf16_t* rowp = O + (size_t)EPI_ROW(u, ai, m) * ldc;
#pragma unroll
                for (int bj = 0; bj < 2; ++bj) { f32x4 v0 = acc[ai][bj][m][0], v1 = acc[ai][bj][m][1];
                    if (ACT == 1) {
#pragma unroll
                        for (int j = 0; j < 4; ++j) { v0[j] = gelu_tanh(v0[j]); v1[j] = gelu_tanh(v1[j]); } }
                    *(u32x4*)(rowp + EPI_COL8(u, bj)) = pack8(v0, v1); } }
    }
};
struct EpiPool {
    static constexpr bool PERM = true;
    __device__ __forceinline__ void init(const Unit& u, int wc, int fq, f32x4 (&ini)[2][2]) const { ini[0][0] = ini[0][1] = ini[1][0] = ini[1][1] = (f32x4){0.f, 0.f, 0.f, 0.f}; }
    bf16_t* gb;
    __device__ __forceinline__ void operator()(const f32x4 (&acc)[2][2][4][2], const Unit& u, int wr, int wc, int fr, int fq) const {
#pragma unroll
        for (int ai = 0; ai < 2; ++ai)
#pragma unroll
            for (int m = 0; m < 4; ++m) { bf16_t* rowp = gb + (size_t)EPI_ROW(u, ai, m) * 1024;
#pragma unroll
                for (int bj = 0; bj < 2; ++bj) { u32x4* p = (u32x4*)(rowp + EPI_COL8(u, bj)); f32x4 g0, g1; unpack8(*p, g0, g1);
                    *p = pack8(g0 * acc[ai][bj][m][0], g1 * acc[ai][bj][m][1]); } }
    }
};
struct EpiGlu {
    static constexpr bool PERM = true;
    __device__ __forceinline__ void init(const Unit& u, int wc, int fq, f32x4 (&ini)[2][2]) const { ini[0][0] = ini[0][1] = ini[1][0] = ini[1][1] = (f32x4){0.f, 0.f, 0.f, 0.f}; }
    bf16_t* ga; const bf16_t* gb;
    __device__ __forceinline__ void operator()(const f32x4 (&acc)[2][2][4][2], const Unit& u, int wr, int wc, int fr, int fq) const {
#pragma unroll
        for (int ai = 0; ai < 2; ++ai)
#pragma unroll
            for (int m = 0; m < 4; ++m) { const size_t off = (size_t)EPI_ROW(u, ai, m) * 1024 + (size_t)(u.pn * HALF + wc * 32 + 8 * fq);
                u32x4* pa = (u32x4*)(ga + off); f32x4 a0, a1, t0, t1; unpack8(*pa, a0, a1); unpack8(*(const u32x4*)(gb + off), t0, t1);
                const f32x4 y0 = acc[ai][0][m][0] * sig4(acc[ai][1][m][0]), y1 = acc[ai][0][m][1] * sig4(acc[ai][1][m][1]);
                *pa = pack8(a0 * y0 + t0, a1 * y1 + t1); }
    }
};
struct EpiWout {
    static constexpr bool PERM = true;
    __device__ __forceinline__ void init(const Unit& u, int wc, int fq, f32x4 (&ini)[2][2]) const { ini[0][0] = ini[0][1] = ini[1][0] = ini[1][1] = (f32x4){0.f, 0.f, 0.f, 0.f}; }
    bf16_t* s;
    __device__ __forceinline__ void operator()(const f32x4 (&acc)[2][2][4][2], const Unit& u, int wr, int wc, int fr, int fq) const {
        u32x4 xv[2][4][2];
#pragma unroll
        for (int ai = 0; ai < 2; ++ai) {
#pragma unroll
            for (int m = 0; m < 4; ++m)
#pragma unroll
                for (int bj = 0; bj < 2; ++bj) xv[ai & 1][m][bj] = *(const u32x4*)(s + (size_t)EPI_ROW(u, ai, m) * 1024 + EPI_COL8(u, bj));
#pragma unroll
            for (int m = 0; m < 4; ++m)
#pragma unroll
                for (int bj = 0; bj < 2; ++bj) { f32x4 x0, x1; unpack8(xv[ai & 1][m][bj], x0, x1);
                    *(u32x4*)(s + (size_t)EPI_ROW(u, ai, m) * 1024 + EPI_COL8(u, bj)) = pack8(x0 * 1.189207115002721f + acc[ai][bj][m][0], x1 * 1.189207115002721f + acc[ai][bj][m][1]); }
            asm volatile("" ::: "memory"); }
    }
};
struct EpiPle {
    static constexpr bool PERM = true;
    __device__ __forceinline__ void init(const Unit& u, int wc, int fq, f32x4 (&ini)[2][2]) const { ini[0][0] = ini[0][1] = ini[1][0] = ini[1][1] = (f32x4){0.f, 0.f, 0.f, 0.f}; }
    const bf16_t* h1; const bf16_t* pp; bf16_t* base; const float* brouter; int* tope; float* topw;
    __device__ __forceinline__ void operator()(const f32x4 (&acc)[2][2][4][2], const Unit& u, int wr, int wc, int fr, int fq) const {
        if (u.pn < 4) {
#pragma unroll
            for (int ai = 0; ai < 2; ++ai) { u32x4 hv[4][2], pv[4][2];
#pragma unroll
                for (int m = 0; m < 4; ++m)
#pragma unroll
                    for (int bj = 0; bj < 2; ++bj) { const size_t o = (size_t)EPI_ROW(u, ai, m) * 1024 + EPI_COL8(u, bj); hv[m][bj] = *(const u32x4*)(h1 + o); pv[m][bj] = *(const u32x4*)(pp + o); }
#pragma unroll
                for (int m = 0; m < 4; ++m)
#pragma unroll
                    for (int bj = 0; bj < 2; ++bj) { const size_t o = (size_t)EPI_ROW(u, ai, m) * 1024 + EPI_COL8(u, bj); f32x4 h0, h1v, p0, p1; unpack8(hv[m][bj], h0, h1v); unpack8(pv[m][bj], p0, p1);
                        *(u32x4*)(base + o) = pack8(h0 * 1.189207115002721f + sig4(acc[ai][bj][m][0]) * p0, h1v * 1.189207115002721f + sig4(acc[ai][bj][m][1]) * p1); }
                asm volatile("" ::: "memory"); }
        } else if (wc == 0) {
            const f32x4 b0 = *(const f32x4*)(brouter + 8 * fq), b1 = *(const f32x4*)(brouter + 8 * fq + 4);
#pragma unroll
            for (int ai = 0; ai < 2; ++ai)
#pragma unroll
                for (int m = 0; m < 4; ++m) {
                    float v[8]; const f32x4 l0 = acc[ai][0][m][0] + acc[ai][1][m][0] + b0, l1 = acc[ai][0][m][1] + acc[ai][1][m][1] + b1;
#pragma unroll
                    for (int i = 0; i < 4; ++i) { v[i] = l0[i]; v[4 + i] = l1[i]; }
                    float tv[4]; int te[4];
#pragma unroll
                    for (int r = 0; r < 4; ++r) {
                        float bv = -3.0e38f; int bi = 0;
#pragma unroll
                        for (int i = 0; i < 8; ++i) { if (v[i] > bv) { bv = v[i]; bi = i; } }
                        const int be = 8 * fq + bi;
                        float gv = bv; int ge = be;
#pragma unroll
                        for (int o = 16; o <= 32; o <<= 1) { const float ov = __shfl_xor(gv, o); const int oe = __shfl_xor(ge, o); if (ov > gv || (ov == gv && oe < ge)) { gv = ov; ge = oe; } }
                        tv[r] = gv; te[r] = ge;
                        if (ge == be) {
#pragma unroll
                            for (int i = 0; i < 8; ++i) if (i == bi) v[i] = -3.0e38f; }
                    }
                    if (fq == 0) { const float e1 = __expf(tv[1] - tv[0]), e2 = __expf(tv[2] - tv[0]), e3 = __expf(tv[3] - tv[0]); const float inv = 1.0f / (1.0f + e1 + e2 + e3);
                        const int t = EPI_ROW(u, ai, m);
                        *(int4*)(tope + (size_t)t * 4) = make_int4(te[0], te[1], te[2], te[3]);
                        *(float4*)(topw + (size_t)t * 4) = make_float4(inv, e1 * inv, e2 * inv, e3 * inv); }
                }
        }
    }
};
struct EpiM1 {
    static constexpr bool PERM = true;
    __device__ __forceinline__ void init(const Unit& u, int wc, int fq, f32x4 (&ini)[2][2]) const { ini[0][0] = ini[0][1] = ini[1][0] = ini[1][1] = (f32x4){0.f, 0.f, 0.f, 0.f}; }
    bf16_t* act; const float* bgate; const float* bup;
    __device__ __forceinline__ void operator()(const f32x4 (&acc)[2][2][4][2], const Unit& u, int wr, int wc, int fr, int fq) const {
        const int col = u.pn * HALF + wc * 32 + 8 * fq;
#pragma unroll
        for (int ai = 0; ai < 2; ++ai)
#pragma unroll
            for (int m = 0; m < 4; ++m) { f32x4 o[2];
#pragma unroll
                for (int n = 0; n < 2; ++n) { const f32x4 gg = acc[ai][0][m][n], uu = acc[ai][1][m][n];
#pragma unroll
                    for (int j = 0; j < 4; ++j) { const float g = fminf(gg[j], 7.0f), up = fminf(fmaxf(uu[j], -7.0f), 7.0f); o[n][j] = (up + 1.0f) * (g * sigmoid_f(1.702f * g)); } }
                *(u32x4*)(act + (size_t)EPI_ROW(u, ai, m) * 1024 + col) = pack8(o[0], o[1]); }
    }
};
__device__ __forceinline__ u32x2 pack8_fp8(const f32x4 a, const f32x4 b) { int w0 = 0, w1 = 0;
    w0 = __builtin_amdgcn_cvt_pk_fp8_f32(a[0], a[1], w0, false); w0 = __builtin_amdgcn_cvt_pk_fp8_f32(a[2], a[3], w0, true);
    w1 = __builtin_amdgcn_cvt_pk_fp8_f32(b[0], b[1], w1, false); w1 = __builtin_amdgcn_cvt_pk_fp8_f32(b[2], b[3], w1, true); return (u32x2){(unsigned)w0, (unsigned)w1}; }
struct EpiM1F8 {
    static constexpr bool PERM = true;
    __device__ __forceinline__ void init(const Unit& u, int wc, int fq, f32x4 (&ini)[2][2]) const { const int col = u.pn * HALF + wc * 32 + 8 * fq; const float* bg = bgate + (size_t)u.aux * 1024 + col; const float* bu = bup + (size_t)u.aux * 1024 + col; ini[0][0] = *(const f32x4*)bg; ini[0][1] = *(const f32x4*)(bg + 4); ini[1][0] = *(const f32x4*)bu; ini[1][1] = *(const f32x4*)(bu + 4); }
    unsigned char* act; const float* bgate; const float* bup;
    __device__ __forceinline__ void operator()(const f32x4 (&acc)[2][2][4][2], const Unit& u, int wr, int wc, int fr, int fq) const {
        const int col = u.pn * HALF + wc * 32 + 8 * fq;
#pragma unroll
        for (int ai = 0; ai < 2; ++ai)
#pragma unroll
            for (int m = 0; m < 4; ++m) { f32x4 o[2];
#pragma unroll
                for (int n = 0; n < 2; ++n) { const f32x4 gg = acc[ai][0][m][n], uu = acc[ai][1][m][n];
#pragma unroll
                    for (int j = 0; j < 4; ++j) { const float g = fminf(gg[j], 7.0f), up = fminf(fmaxf(uu[j], -7.0f), 7.0f); o[n][j] = (up + 1.0f) * (g * sigmoid_f(1.702f * g)); } }
                *(u32x2*)(act + (size_t)(u.pm * BM + ai * HALF + wr * 64 + m * 16 + fr) * 1024 + col) = pack8_fp8(o[0], o[1]); }
    }
};
struct EpiM2 {
    static constexpr bool PERM = true;
    __device__ __forceinline__ void init(const Unit& u, int wc, int fq, f32x4 (&ini)[2][2]) const { if (MOE_FP8) { _Pragma("unroll") for (int bj = 0; bj < 2; ++bj) { const float* bp = bdown + (size_t)u.aux * 1024 + u.pn * BM + bj * HALF + wc * 32 + 8 * fq; ini[bj][0] = *(const f32x4*)bp; ini[bj][1] = *(const f32x4*)(bp + 4); } } else { ini[0][0] = ini[0][1] = ini[1][0] = ini[1][1] = (f32x4){0.f, 0.f, 0.f, 0.f}; } }
    unsigned char* y; const float* bdown; float sc;
    __device__ __forceinline__ void operator()(const f32x4 (&acc)[2][2][4][2], const Unit& u, int wr, int wc, int fr, int fq) const {
        f32x4 b[2][2];
#pragma unroll
        for (int bj = 0; bj < 2; ++bj) { if (MOE_FP8) { b[bj][0] = b[bj][1] = (f32x4){0.f, 0.f, 0.f, 0.f}; }
            else { const float* bp = bdown + (size_t)u.aux * 1024 + EPI_COL8(u, bj); b[bj][0] = *(const f32x4*)bp; b[bj][1] = *(const f32x4*)(bp + 4); } }
#pragma unroll
        for (int ai = 0; ai < 2; ++ai)
#pragma unroll
            for (int m = 0; m < 4; ++m) { const size_t ro = (size_t)EPI_ROW(u, ai, m) * 1024;
#pragma unroll
                for (int bj = 0; bj < 2; ++bj) { const f32x4 v0 = acc[ai][bj][m][0] * sc + b[bj][0], v1 = acc[ai][bj][m][1] * sc + b[bj][1];
                    if (Y_FP8) *(u32x2*)(y + ro + EPI_COL8(u, bj)) = pack8_fp8(v0, v1);
                    else *(u32x4*)((bf16_t*)y + ro + EPI_COL8(u, bj)) = pack8(v0, v1); } }
    }
};
#undef EPI_ROW
#undef EPI_COL8
#undef EPI_COL4
}

struct Args { const float* in[31]; float* out; unsigned char* ws; int ph_lo, ph_hi, li, pad; };
struct Ctx { LAS unsigned char* lds; int tid, lane, wave, vcu, G, gw, ngw; };
__device__ __forceinline__ int lane_id() { return (int)__builtin_amdgcn_mbcnt_hi(~0u, __builtin_amdgcn_mbcnt_lo(~0u, 0u)); }
struct PT { const LAS unsigned long long* t;
    __device__ __forceinline__ unsigned long long get(int k) const { const unsigned long long v = t[k]; const unsigned lo = __builtin_amdgcn_readfirstlane((unsigned)v), hi = __builtin_amdgcn_readfirstlane((unsigned)(v >> 32)); return ((unsigned long long)hi << 32) | lo; }
    __device__ __forceinline__ const float* in(int k) const { return (const float*)get(k); }
    __device__ __forceinline__ float* out() const { return (float*)get(31); }
    __device__ __forceinline__ unsigned char* ws() const { return (unsigned char*)get(32); } };

__device__ __forceinline__ float wave_sum(float v) {
#pragma unroll
    for (int o = 1; o < 64; o <<= 1) v += __shfl_xor(v, o);
    return v;
}
__device__ __forceinline__ void p0_transpose_item(const float* W, int K, int N, bf16* WT, int dst_row0, LAS unsigned char* scr, int kb, int nb, int lane) {
    const int k0 = 64 * kb, n0 = 64 * nb, kr = lane >> 4, nq = lane & 15;
    f32x4 v[16];
#pragma unroll
    for (int i = 0; i < 16; ++i) v[i] = *(const f32x4*)(W + (size_t)(k0 + 4 * i + kr) * N + n0 + 4 * nq);
#pragma unroll
    for (int i = 0; i < 16; ++i) { const int k = 4 * i + kr;
#pragma unroll
        for (int j = 0; j < 4; ++j) *(LAS unsigned short*)(scr + (4 * nq + j) * 144 + 2 * k) = (unsigned short)f2bf(v[i][j]); }
    LDS_WAIT(); asm volatile("" ::: "memory");
    const int c = lane & 7;
#pragma unroll
    for (int j = 0; j < 8; ++j) { const int n = (lane >> 3) + 8 * j; const v4u o = *(const LAS v4u*)(scr + n * 144 + 16 * c);
        *(v4u*)(WT + (size_t)(dst_row0 + n) * K + k0 + 8 * c) = o; }
    LDS_WAIT(); asm volatile("" ::: "memory");
}
__device__ __forceinline__ unsigned char f2fp8(float x) { return (unsigned char)(__builtin_amdgcn_cvt_pk_fp8_f32(x, x, 0, false) & 0xff); }
struct T8Item { const float* W; unsigned char* WT; int dst_row0, k0, n0; float sc; };
__device__ __forceinline__ void t8_load(const T8Item& it, f32x4 (&v)[16], int lane) { const int kr = lane >> 3, nq = lane & 7;
#pragma unroll
    for (int i = 0; i < 16; ++i) v[i] = *(const f32x4*)(it.W + (size_t)(it.k0 + 8 * i + kr) * 1024 + it.n0 + 4 * nq); }
__device__ __forceinline__ void t8_store(const T8Item& it, const f32x4 (&v)[16], LAS unsigned char* scr, int lane) { const int kr = lane >> 3, nq = lane & 7;
#pragma unroll
    for (int i = 0; i < 16; ++i) { const int k = 8 * i + kr;
#pragma unroll
        for (int j = 0; j < 4; ++j) *(LAS unsigned char*)(scr + (4 * nq + j) * 144 + k) = f2fp8(v[i][j] * it.sc); }
    LDS_WAIT(); asm volatile("" ::: "memory");
#pragma unroll
    for (int j = 0; j < 4; ++j) { const int q = lane + 64 * j, n = q >> 3, c = q & 7; const v4u o = *(const LAS v4u*)(scr + n * 144 + 16 * c);
        *(v4u*)(it.WT + (size_t)(it.dst_row0 + n) * 1024 + it.k0 + 16 * c) = o; }
    LDS_WAIT(); asm volatile("" ::: "memory");
}
__device__ __forceinline__ void cv_load(const float* src, f32x4 (&v)[16], int lane) { const f32x4* s = (const f32x4*)src + lane;
#pragma unroll
    for (int j = 0; j < 16; ++j) v[j] = s[64 * j]; }
__device__ __forceinline__ void cv_store(bf16* dst, const f32x4 (&v)[16], int lane) { v2u* o = (v2u*)dst + lane;
#pragma unroll
    for (int j = 0; j < 16; ++j) { v2u w; w.x = pk2(v[j].x, v[j].y); w.y = pk2(v[j].z, v[j].w); o[64 * j] = w; } }
struct cplx { float re, im; };
__device__ __forceinline__ cplx cmul(cplx a, cplx b) { return cplx{a.re * b.re - a.im * b.im, a.re * b.im + a.im * b.re}; }
__device__ __forceinline__ cplx lam_pow(float lre, float lim, float step, float tau) { const float m = __expf(lre * step * tau); float s, c; sincosf(lim * step * tau, &s, &c); return cplx{m * c, m * s}; }
__device__ __forceinline__ cplx bbar_fac(float lre, float lim, float step) { const cplx lb = lam_pow(lre, lim, step, 1.0f); const float nr = lb.re - 1.0f, ni = lb.im, d = 1.0f / (lre * lre + lim * lim);
    return cplx{(nr * lre + ni * lim) * d, (ni * lre - nr * lim) * d}; }

__device__ __forceinline__ void prologue_stream(const PT a, const Ctx& c0) {
    Ctx c = c0; c.lane = lane_id(); c.tid = c.wave * 64 + c.lane;
    unsigned char* ws = a.ws();
    LAS float* scr = (LAS float*)(c.lds + c.wave * 16384);
    const float *w_in = a.in(2), *lre = a.in(3), *lim = a.in(4), *lstep = a.in(5), *bre = a.in(6), *bim = a.in(7), *cre = a.in(8), *cim = a.in(9), *dsk = a.in(10);
    const float *wval = a.in(11), *wgt = a.in(12), *wgrp = a.in(13), *pscale = a.in(14), *wpp = a.in(15), *wout = a.in(16), *wrt = a.in(19);
    const float *wgate = a.in(21), *wup = a.in(23), *wdown = a.in(25), *wpleg = a.in(27), *wplep = a.in(28);
    constexpr int I_IN = 16 * 48, I_GL = 8 * 16, I_SQ = 16 * 16, I_PP = 4 * 16, I_E = 32 * I_SQ;
    constexpr int NITEMS = I_IN + 2 * I_GL + 2 * I_SQ + I_PP + (MOE_FP8 ? 0 : 3 * I_E);
    LAS unsigned char* scrb = (LAS unsigned char*)scr;
    for (int it = c.gw; it < NITEMS; it += c.ngw) {
        int r = it;
        if (r < I_IN) { p0_transpose_item(w_in, 1024, 3072, (bf16*)(ws + WS_WIN), 64 * (r % 48), scrb, r / 48, r % 48, c.lane); continue; } r -= I_IN;
        if (r < 2 * I_GL) { const int which = r / I_GL, q = r % I_GL, nb = q % 16, n0 = 64 * nb;
            p0_transpose_item(which ? wgt : wval, 512, 1024, (bf16*)(ws + WS_WGLU), (n0 >> 7) * 256 + (n0 & 127) + which * 128, scrb, q / 16, nb, c.lane); continue; } r -= 2 * I_GL;
        if (r < I_SQ) { p0_transpose_item(wout, 1024, 1024, (bf16*)(ws + WS_WOUT), 64 * (r % 16), scrb, r / 16, r % 16, c.lane); continue; } r -= I_SQ;
        if (r < I_SQ) { p0_transpose_item(wpleg, 1024, 1024, (bf16*)(ws + WS_WPLE), 64 * (r % 16), scrb, r / 16, r % 16, c.lane); continue; } r -= I_SQ;
        if (r < I_PP) { p0_transpose_item(wplep, 256, 1024, (bf16*)(ws + WS_WPP), 64 * (r % 16), scrb, r / 16, r % 16, c.lane); continue; } r -= I_PP;
#if !MOE_FP8
        if (r < 2 * I_E) { const int which = r / I_E, q = r % I_E, e = q / I_SQ, qq = q % I_SQ, nb = qq % 16, n0 = 64 * nb;
            p0_transpose_item((which ? wup : wgate) + (size_t)e * 1048576, 1024, 1024, (bf16*)(ws + WS_WGU) + (size_t)e * 2048 * 1024, (n0 >> 7) * 256 + (n0 & 127) + which * 128, scrb, qq / 16, nb, c.lane); continue; } r -= 2 * I_E;
        { const int e = r / I_SQ, qq = r % I_SQ; p0_transpose_item(wdown + (size_t)e * 1048576, 1024, 1024, (bf16*)(ws + WS_WDN) + (size_t)e * 1048576, 64 * (qq % 16), scrb, qq / 16, qq % 16, c.lane); }
#endif
    }
    { constexpr int NCX = T / 4, NCV = NCX + T / 16; const float* xs = a.in(0); const float* ps = a.in(1);
#define CV_SRC(m_) ((m_) < NCX ? xs + (size_t)(m_) * 4096 : ps + (size_t)((m_) - NCX) * 4096)
#define CV_DST(m_) ((m_) < NCX ? (bf16*)(ws + WS_XB) + (size_t)(m_) * 4096 : (bf16*)(ws + WS_PB) + (size_t)((m_) - NCX) * 4096)
      int m = c.gw; f32x4 va[16], vb[16];
      if (m < NCV) { cv_load(CV_SRC(m), va, c.lane);
        for (;;) {
            const int m2 = m + c.ngw; const bool h2 = m2 < NCV; if (h2) cv_load(CV_SRC(m2), vb, c.lane);
            cv_store(CV_DST(m), va, c.lane);
            if (!h2) break;
            const int m3 = m2 + c.ngw; const bool h3 = m3 < NCV; if (h3) cv_load(CV_SRC(m3), va, c.lane);
            cv_store(CV_DST(m2), vb, c.lane);
            if (!h3) break;
            m = m3; } }
#undef CV_SRC
#undef CV_DST
    }
}
__device__ __forceinline__ void prologue_tables(const PT a, const Ctx& c0) {
    Ctx c = c0; c.lane = lane_id(); c.tid = c.wave * 64 + c.lane;
    unsigned char* ws = a.ws();
    LAS float* scr = (LAS float*)(c.lds + c.wave * 16384);
    const float *w_in = a.in(2), *lre = a.in(3), *lim = a.in(4), *lstep = a.in(5), *bre = a.in(6), *bim = a.in(7), *cre = a.in(8), *cim = a.in(9), *dsk = a.in(10);
    const float *wval = a.in(11), *wgt = a.in(12), *wgrp = a.in(13), *pscale = a.in(14), *wpp = a.in(15), *wout = a.in(16), *wrt = a.in(19);
    const float *wgate = a.in(21), *wup = a.in(23), *wdown = a.in(25), *wpleg = a.in(27), *wplep = a.in(28);
    { bf16* W = (bf16*)(ws + WS_WPLE) + (size_t)1024 * 1024;
      for (int ch = c.gw * 64 + c.lane; ch < 256 * 128; ch += c.ngw * 64) { const int r = ch >> 7, k0 = (ch & 127) * 8; unsigned o[4] = {0u, 0u, 0u, 0u};
          if (r < 32 || (r >= 128 && r < 160)) { const int e = r & 31; float f[8];
#pragma unroll
              for (int j = 0; j < 8; ++j) { const float w = wrt[(size_t)(k0 + j) * 32 + e]; const float hi = bf2f((unsigned short)f2bf(w)); f[j] = (r < 32) ? hi : (w - hi); }
#pragma unroll
              for (int j = 0; j < 4; ++j) o[j] = pk2(f[2 * j], f[2 * j + 1]); }
          *(v4u*)(W + (size_t)r * 1024 + k0) = (v4u){o[0], o[1], o[2], o[3]}; } }
    for (int it = c.gw; it < 64 * 16; it += c.ngw) { const int c0 = (it >> 4) * 8, d = (it & 15) * 64 + c.lane, g = c0 >> 7; float s[8];
#pragma unroll
        for (int i = 0; i < 8; ++i) s[i] = 0.f;
        for (int j = 0; j < 128; ++j) { const float pw = pscale[g * 128 + j] * wpp[(size_t)(g * 128 + j) * 1024 + d];
#pragma unroll
            for (int i = 0; i < 8; ++i) s[i] += wgrp[(size_t)(g * 128 + (c0 & 127) + i) * 128 + j] * pw; }
        *(v4u*)((bf16*)(ws + WS_WPOOL) + (size_t)d * 512 + c0) = (v4u){pk2(s[0], s[1]), pk2(s[2], s[3]), pk2(s[4], s[5]), pk2(s[6], s[7])}; }
    { bf16* TV = (bf16*)(ws + WS_TV);
      if ((c.gw & 3) == 0 && (c.gw >> 2) < 512) { const int it = c.gw >> 2, g = it >> 4, h = it & 15, hp = c.lane & 15, pq = c.lane >> 4; const float step = __expf(lstep[g]);
          float Kt[32];
#pragma unroll
          for (int tt = 0; tt < 32; ++tt) Kt[tt] = 0.f;
          for (int pi = 0; pi < 16; ++pi) { const int p = pq * 16 + pi; const float lr = lre[g * 64 + p], li = lim[g * 64 + p]; const cplx lb = lam_pow(lr, li, step, 1.0f), bf = bbar_fac(lr, li, step);
              const cplx bb = cmul(bf, cplx{bre[(size_t)(g * 64 + p) * 16 + hp], bim[(size_t)(g * 64 + p) * 16 + hp]});
              cplx w = cmul(cplx{cre[(size_t)(g * 16 + h) * 64 + p], cim[(size_t)(g * 16 + h) * 64 + p]}, bb);
#pragma unroll
              for (int tt = 0; tt < 32; ++tt) { Kt[tt] += w.re; w = cmul(w, lb); } }
#pragma unroll
          for (int tt = 0; tt < 32; ++tt) { Kt[tt] += __shfl_xor(Kt[tt], 16); Kt[tt] += __shfl_xor(Kt[tt], 32); }
          if (h == hp) Kt[0] += dsk[g * 16 + h];
#pragma unroll
          for (int tt = 0; tt < 32; ++tt) { if ((tt >> 3) == pq) { const bf16 v = (bf16)f2bf(Kt[tt]);
              for (int s = 0; s + tt < 32; ++s) TV[((size_t)g * 512 + (size_t)(s + tt) * 16 + h) * 640 + s * 16 + hp] = v; } } }
      for (int it = c.gw; it < 32 * 512; it += c.ngw) { const int g = it >> 9, n = it & 511, j = n >> 4, h = n & 15; bf16* row = TV + (size_t)it * 640;
          if (c.lane * 8 >= (j + 1) * 16) *(v4u*)(row + c.lane * 8) = (v4u){0u, 0u, 0u, 0u};
          const int p = c.lane; const float step = __expf(lstep[g]); const cplx lp = lam_pow(lre[g * 64 + p], lim[g * 64 + p], step, (float)(j + 1));
          const cplx mv = cmul(cplx{cre[(size_t)(g * 16 + h) * 64 + p], cim[(size_t)(g * 16 + h) * 64 + p]}, lp);
          row[512 + p] = (bf16)f2bf(mv.re); row[576 + p] = (bf16)f2bf(-mv.im); }
      bf16* WS = (bf16*)(ws + WS_WS);
      for (int it = c.gw; it < 32 * 256; it += c.ngw) { const int g = it >> 8, n = it & 255; v4u o = (v4u){0u, 0u, 0u, 0u};
          if (n < 128) { const int p = n & 63, s = c.lane >> 1, h0 = (c.lane & 1) * 8; const float step = __expf(lstep[g]), lr = lre[g * 64 + p], li = lim[g * 64 + p];
              const cplx f = cmul(lam_pow(lr, li, step, (float)(31 - s)), bbar_fac(lr, li, step)); float v[8];
#pragma unroll
              for (int i = 0; i < 8; ++i) { const cplx r = cmul(f, cplx{bre[(size_t)(g * 64 + p) * 16 + h0 + i], bim[(size_t)(g * 64 + p) * 16 + h0 + i]}); v[i] = (n < 64) ? r.re : r.im; }
              o = (v4u){pk2(v[0], v[1]), pk2(v[2], v[3]), pk2(v[4], v[5]), pk2(v[6], v[7])}; }
          *(v4u*)(WS + (size_t)it * 512 + c.lane * 8) = o; } }
}
__device__ __forceinline__ void phase_prologue(const PT a, const Ctx& c0) {
    if (c0.wave >= 4) { prologue_stream(a, c0); prologue_tables(a, c0); } else { prologue_tables(a, c0); prologue_stream(a, c0); }
}

__device__ __forceinline__ void phase_moe_convert(const PT a, const Ctx& c0) {
    Ctx c = c0; c.lane = lane_id(); c.tid = c.wave * 64 + c.lane;
    unsigned char* ws = a.ws(); LAS unsigned char* scrb = c.lds + c.wave * 16384;
    const float *wgate = a.in(21), *wup = a.in(23), *wdown = a.in(25);
    { constexpr int NT8 = 3 * 32 * 256;
#define T8_DECODE(r_, it_) do { const int which_ = (r_) / 8192, q_ = (r_) % 8192, e_ = q_ >> 8, qq_ = q_ & 255, nb_ = qq_ & 31, n0_ = 32 * nb_; \
        it_.k0 = 128 * (qq_ >> 5); it_.n0 = n0_; \
        if (which_ < 2) { it_.W = (which_ ? wup : wgate) + (size_t)e_ * 1048576; it_.WT = (unsigned char*)(ws + WS_WGU) + (size_t)e_ * 2048 * 1024; it_.dst_row0 = (n0_ >> 7) * 256 + (n0_ & 127) + which_ * 128; it_.sc = 32.0f; } \
        else { it_.W = wdown + (size_t)e_ * 1048576; it_.WT = (unsigned char*)(ws + WS_WDN) + (size_t)e_ * 1048576; it_.dst_row0 = n0_; it_.sc = 64.0f; } } while (0)
      int r = c.gw; T8Item ia, ib; f32x4 va[16], vb[16];
      if (r < NT8) { T8_DECODE(r, ia); t8_load(ia, va, c.lane);
        for (;;) {
            const int r2 = r + c.ngw; const bool h2 = r2 < NT8; if (h2) { T8_DECODE(r2, ib); t8_load(ib, vb, c.lane); }
            t8_store(ia, va, scrb, c.lane);
            if (!h2) break;
            const int r3 = r2 + c.ngw; const bool h3 = r3 < NT8; if (h3) { T8_DECODE(r3, ia); t8_load(ia, va, c.lane); }
            t8_store(ib, vb, scrb, c.lane);
            if (!h3) break;
            r = r3; } }
#undef T8_DECODE
    }
}

__device__ __forceinline__ void unpack8f(const v4u v, float (&f)[8]) { f[0] = pg8::bf_lo(v.x); f[1] = pg8::bf_hi(v.x); f[2] = pg8::bf_lo(v.y); f[3] = pg8::bf_hi(v.y); f[4] = pg8::bf_lo(v.z); f[5] = pg8::bf_hi(v.z); f[6] = pg8::bf_lo(v.w); f[7] = pg8::bf_hi(v.w); }
__device__ __forceinline__ void phase_pooling(const PT a, const Ctx& c0) {
    Ctx c = c0; c.lane = lane_id(); c.tid = c.wave * 64 + c.lane;
    const bf16* up = (const bf16*)(a.ws() + WS_UPOOL) + c.lane * 8; bf16* po = (bf16*)(a.ws() + WS_POOLED) + c.lane * 8;
    const int w = 2 << (c.lane >> 4);
    for (int run = c.gw; run < T / 32; run += c.ngw) { const int t0 = run * 32, pos0 = t0 & (SEQ - 1);
        float s[8];
#pragma unroll
        for (int i = 0; i < 8; ++i) s[i] = 0.f;
        for (int j = 1; j < w; ++j) { if (pos0 - j >= 0) { float f[8]; unpack8f(*(const v4u*)(up + (size_t)(t0 - j) * 512), f);
#pragma unroll
                for (int i = 0; i < 8; ++i) s[i] += f[i]; } }
#pragma unroll 4
        for (int q = 0; q < 32; ++q) { const int t = t0 + q, pos = pos0 + q; float f[8], o[8]; unpack8f(*(const v4u*)(up + (size_t)t * 512), f);
            const int cnt = (pos + 1 < w) ? pos + 1 : w; const float inv = 1.0f / (float)cnt;
#pragma unroll
            for (int i = 0; i < 8; ++i) { s[i] += f[i]; o[i] = s[i] * inv - f[i]; }
            *(v4u*)(po + (size_t)t * 512) = (v4u){pk2(o[0], o[1]), pk2(o[2], o[3]), pk2(o[4], o[5]), pk2(o[6], o[7])};
            if (pos - w + 1 >= 0) { float g[8]; unpack8f(*(const v4u*)(up + (size_t)(t - w + 1) * 512), g);
#pragma unroll
                for (int i = 0; i < 8; ++i) s[i] -= g[i]; } } }
}

__device__ __forceinline__ void phase_scan(const PT a, const Ctx& c0) {
    Ctx c = c0; c.lane = lane_id(); c.tid = c.wave * 64 + c.lane;
    const float* S = (const float*)(a.ws() + WS_S); bf16* ue = (bf16*)(a.ws() + WS_UEXT);
    const float *lre = a.in(3), *lim = a.in(4), *lstep = a.in(5);
    for (int it = c.gw; it < NG * BATCH; it += c.ngw) { const int g = it >> 4, b = it & 15, p = c.lane;
        const cplx l32 = lam_pow(lre[g * 64 + p], lim[g * 64 + p], __expf(lstep[g]), 32.0f);
        const float* sp = S + ((size_t)g * 2048 + (size_t)b * 128) * 128 + p; bf16* up = ue + ((size_t)g * 2048 + (size_t)b * 128) * 640 + 512 + p;
        cplx X{0.f, 0.f};
        for (int c0 = 0; c0 < NCH; c0 += 16) { float sr[16], si[16];
#pragma unroll
            for (int j = 0; j < 16; ++j) { sr[j] = sp[(size_t)(c0 + j) * 128]; si[j] = sp[(size_t)(c0 + j) * 128 + 64]; }
#pragma unroll
            for (int j = 0; j < 16; ++j) { up[(size_t)(c0 + j) * 640] = (bf16)f2bf(X.re); up[(size_t)(c0 + j) * 640 + 64] = (bf16)f2bf(X.im);
                const cplx n = cmul(l32, X); X.re = n.re + sr[j]; X.im = n.im + si[j]; } } }
}

__device__ __forceinline__ void phase_ln1(const PT a, const Ctx& c0) {
    Ctx c = c0; c.lane = lane_id(); c.tid = c.wave * 64 + c.lane;
    bf16* h1 = (bf16*)(a.ws() + WS_H1); const float *g1 = a.in(17), *b1 = a.in(18);
    f32x4 gv[4], bv[4];
#pragma unroll
    for (int j = 0; j < 4; ++j) { gv[j] = ((const f32x4*)g1)[c.lane + 64 * j]; bv[j] = ((const f32x4*)b1)[c.lane + 64 * j]; }
    for (int m0 = c.gw * 4; m0 < T; m0 += c.ngw * 4) {
        v2u q[4][4];
#pragma unroll
        for (int r = 0; r < 4; ++r) { const v2u* xr = (const v2u*)(h1 + (size_t)(m0 + r) * 1024) + c.lane;
#pragma unroll
            for (int j = 0; j < 4; ++j) q[r][j] = xr[64 * j]; }
#pragma unroll
        for (int r = 0; r < 4; ++r) { const int m = m0 + r; f32x4 v[4]; float sm = 0.f;
#pragma unroll
            for (int j = 0; j < 4; ++j) { v[j] = (f32x4){pg8::bf_lo(q[r][j].x), pg8::bf_hi(q[r][j].x), pg8::bf_lo(q[r][j].y), pg8::bf_hi(q[r][j].y)}; sm += (v[j].x + v[j].y) + (v[j].z + v[j].w); }
            const float mean = wave_sum(sm) * (1.f / 1024.f); float s2 = 0.f;
#pragma unroll
            for (int j = 0; j < 4; ++j) { v[j] = v[j] - mean; s2 += (v[j].x * v[j].x + v[j].y * v[j].y) + (v[j].z * v[j].z + v[j].w * v[j].w); }
            const float rstd = 1.f / sqrtf(wave_sum(s2) * (1.f / 1024.f) + LN_EPS);
            v2u* o = (v2u*)(h1 + (size_t)m * 1024) + c.lane; unsigned* oq = (unsigned*)(a.ws() + WS_H1Q + (size_t)m * 1024) + c.lane;
#pragma unroll
            for (int j = 0; j < 4; ++j) { const f32x4 y = v[j] * rstd * gv[j] + bv[j]; v2u w; w.x = pk2(y.x, y.y); w.y = pk2(y.z, y.w); o[64 * j] = w;
                if (MOE_FP8) { int qq = 0; qq = __builtin_amdgcn_cvt_pk_fp8_f32(y.x, y.y, qq, false); qq = __builtin_amdgcn_cvt_pk_fp8_f32(y.z, y.w, qq, true); oq[64 * j] = (unsigned)qq; } } } }
}

__device__ __forceinline__ void phase_route_count(const PT a, const Ctx& c0) {
    Ctx c = c0; c.lane = lane_id(); c.tid = c.wave * 64 + c.lane;
    LAS int* hist = (LAS int*)c.lds; const int* tope = (const int*)(a.ws() + WS_TOPE); int* cnt = (int*)(a.ws() + WS_CNT);
    for (int w = blockIdx.x; w < 256; w += c.G) {
        if (c.tid < 32) hist[c.tid] = 0;
        __syncthreads();
        { const int slot = c.tid * 2; const int2 e2 = *(const int2*)(tope + (size_t)w * 1024 + slot); atomicAdd((int*)&hist[e2.x], 1); atomicAdd((int*)&hist[e2.y], 1); }
        __syncthreads();
        if (c.tid < 32) cnt[w * 32 + c.tid] = hist[c.tid];
        __syncthreads();
    }
}
__device__ __forceinline__ void phase_route_place(const PT a, const Ctx& c0) {
    Ctx c = c0; c.lane = lane_id(); c.tid = c.wave * 64 + c.lane;
    LAS int* L = (LAS int*)c.lds;
    const int* tope = (const int*)(a.ws() + WS_TOPE); const int* cnt = (const int*)(a.ws() + WS_CNT); int* tpg = (int*)(a.ws() + WS_CNT + 65536);
    for (int w = blockIdx.x; w < 256; w += c.G) { const int s = w / WPS, wl = w % WPS;
        int* rowtok = (int*)(a.ws() + WS_ROWTOK) + (size_t)s * SLAB_ROWS; int* slotpos = (int*)(a.ws() + WS_SLOTPOS);
        if (c.tid < 32) { int tot = 0, pre = 0; for (int q = 0; q < WPS; ++q) { const int v = cnt[(s * WPS + q) * 32 + c.tid]; tot += v; pre += (q < wl) ? v : 0; } L[c.tid] = tot; L[32 + c.tid] = pre; L[96 + c.tid] = 0; }
        __syncthreads();
        if (c.tid == 0) { int acc = 0; for (int e = 0; e < 32; ++e) { L[128 + e] = acc; L[64 + e] = acc * 256; acc += (L[e] + 255) >> 8; } L[160] = acc;
            if (wl == 0) for (int e = 0; e <= 32; ++e) tpg[s * 64 + e] = L[128 + e]; }
        __syncthreads();
        { const int slot = c.tid * 2, tok = w * 256 + (slot >> 2); const int2 e2 = *(const int2*)(tope + (size_t)w * 1024 + slot);
#pragma unroll
          for (int q = 0; q < 2; ++q) { const int e = q ? e2.y : e2.x; const int r = atomicAdd((int*)&L[96 + e], 1); const int pos = L[64 + e] + L[32 + e] + r;
              rowtok[pos] = tok; slotpos[(size_t)tok * 4 + ((slot + q) & 3)] = pos; } }
        if (wl < 32) { const int e = wl, tot = L[e], end = ((tot + 255) >> 8) << 8; for (int r = tot + c.tid; r < end; r += 512) rowtok[L[64 + e] + r] = s * SLAB_T; }
        __syncthreads();
    }
}
__device__ __forceinline__ void phase_combine(const PT a, const Ctx& c0, int s) {
    Ctx c = c0; c.lane = lane_id(); c.tid = c.wave * 64 + c.lane;
    const bf16* y = (const bf16*)(a.ws() + WS_Y); const float* topw = (const float*)(a.ws() + WS_TOPW); float* out = a.out(); const float *g2 = a.in(29), *b2 = a.in(30);
    f32x4 gv[4], bv[4];
#pragma unroll
    for (int j = 0; j < 4; ++j) { gv[j] = ((const f32x4*)g2)[c.lane + 64 * j]; bv[j] = ((const f32x4*)b2)[c.lane + 64 * j]; }
    const bf16* base = (const bf16*)(a.ws() + WS_BASE);
    for (int tl = c.gw; tl < SLAB_T; tl += c.ngw) { const int t = s * SLAB_T + tl; f32x4* xr = (f32x4*)(out + (size_t)t * 1024) + c.lane; f32x4 v[4]; const v2u* br = (const v2u*)(base + (size_t)t * 1024) + c.lane;
        const float4 wk = *(const float4*)(topw + (size_t)t * 4); const float wv[4] = {wk.x, wk.y, wk.z, wk.w};
        const int4 pk = *(const int4*)((const int*)(a.ws() + WS_SLOTPOS) + (size_t)t * 4); const int pv[4] = {pk.x, pk.y, pk.z, pk.w};
#pragma unroll
        for (int j = 0; j < 4; ++j) { const v2u q = br[64 * j]; v[j] = (f32x4){pg8::bf_lo(q.x), pg8::bf_hi(q.x), pg8::bf_lo(q.y), pg8::bf_hi(q.y)}; }
#pragma unroll
        for (int k = 0; k < 4; ++k) {
            if (Y_FP8) { const unsigned* yr = (const unsigned*)((const unsigned char*)y + (size_t)pv[k] * 1024) + c.lane;
#pragma unroll
                for (int j = 0; j < 4; ++j) { const unsigned q = yr[64 * j]; const auto lo = __builtin_amdgcn_cvt_pk_f32_fp8((int)q, false), hi = __builtin_amdgcn_cvt_pk_f32_fp8((int)q, true);
                    v[j] = v[j] + (f32x4){lo[0], lo[1], hi[0], hi[1]} * wv[k]; } }
            else { const v2u* yr = (const v2u*)(y + (size_t)pv[k] * 1024) + c.lane;
#pragma unroll
                for (int j = 0; j < 4; ++j) { const v2u q = yr[64 * j]; v[j] = v[j] + (f32x4){pg8::bf_lo(q.x), pg8::bf_hi(q.x), pg8::bf_lo(q.y), pg8::bf_hi(q.y)} * wv[k]; } } }
        float sm = 0.f;
#pragma unroll
        for (int j = 0; j < 4; ++j) sm += (v[j].x + v[j].y) + (v[j].z + v[j].w);
        const float mean = wave_sum(sm) * (1.f / 1024.f); float s2 = 0.f;
#pragma unroll
        for (int j = 0; j < 4; ++j) { v[j] = v[j] - mean; s2 += (v[j].x * v[j].x + v[j].y * v[j].y) + (v[j].z * v[j].z + v[j].w * v[j].w); }
        const float rstd = 1.f / sqrtf(wave_sum(s2) * (1.f / 1024.f) + LN_EPS);
#pragma unroll
        for (int j = 0; j < 4; ++j) xr[64 * j] = v[j] * rstd * gv[j] + bv[j]; }
}

__global__ void __launch_bounds__(NWAVES * 64, 2) mega_fwd(Args args) {
    extern __shared__ __attribute__((aligned(16))) unsigned char lds_raw[];
    Ctx c;
    c.lds = (LAS unsigned char*)lds_raw;
    c.tid = threadIdx.x; c.lane = c.tid & 63; c.wave = __builtin_amdgcn_readfirstlane(c.tid >> 6);
    c.G = gridDim.x; { const int bx = blockIdx.x; c.vcu = (c.G % 8 == 0) ? (bx % 8) * (c.G / 8) + bx / 8 : bx; }
    c.gw = c.vcu * NWAVES + c.wave; c.ngw = c.G * NWAVES;
    volatile LAS unsigned* MISC = (volatile LAS unsigned*)(c.lds + MISC_OFF);
    for (int u = c.tid; u < (LDS_BYTES - LDSCTL_OFF) / 4; u += NWAVES * 64) ((LAS unsigned*)(c.lds + LDSCTL_OFF))[u] = 0u;
    __syncthreads();
    { LAS unsigned long long* ptw = (LAS unsigned long long*)(c.lds + PTAB_OFF);
      if (c.tid < 31) ptw[c.tid] = (unsigned long long)args.in[c.tid]; else if (c.tid == 31) ptw[31] = (unsigned long long)args.out; else if (c.tid == 32) ptw[32] = (unsigned long long)args.ws; }
    __syncthreads();
    const PT pt{(const LAS unsigned long long*)(c.lds + PTAB_OFF)};
    unsigned char* ws = pt.ws();
    XcdBarrier bar; bar.bar = (unsigned*)(ws + WS_CTL) + CW_BAR + args.li * XCD_BAR_WORDS; bar.x = 0; bar.st = nullptr;
    if (!MK_PER_PHASE) bar = xcd_barrier_post((unsigned*)(ws + WS_CTL) + CW_BAR + args.li * XCD_BAR_WORDS, MISC + 8);
    const int lo = args.ph_lo, hi = args.ph_hi;
#ifndef PH_MASK
#define PH_MASK 0xFFFFFFFFu
#endif
#define IN(k) (((PH_MASK >> (k)) & 1u) && lo <= (k) && (k) < hi)
#define SEAM(k) do { if (IN(k) && IN((k) + 1)) xcd_barrier(bar); } while (0)
    LAS unsigned char* ring = c.lds;
    const int bid = (int)blockIdx.x;
    using namespace pg8;

    if (IN(0)) { phase_prologue(pt, c); }
    SEAM(0);
    if (IN(1)) {
        Prob P{(const char*)(ws + WS_XB), (const char*)(ws + WS_WIN), nullptr, 2048u, 2048u, 128u, 16, 0, 0, c.wave, 0x7F7F7F7F};
        GridOrder S; S.init(T / 256, NIN / 256, c.G, bid, -1);
        EpiInProj E{(bf16_t*)(ws + WS_UEXT), (bf16_t*)(ws + WS_UPOOL), (bf16_t*)(ws + WS_GA), (bf16_t*)(ws + WS_GB)};
        const bool conv_first = ((bid >> 3) & 1) == 0;
        if (MOE_FP8 && conv_first) { phase_moe_convert(pt, c); __syncthreads(); }
        gemm_phase<0, false, EpiInProj, GridOrder, true>(ring, P, S, E);
        if (MOE_FP8 && !conv_first) phase_moe_convert(pt, c);
    }
    SEAM(1);
    if (IN(2)) {
        Prob P{(const char*)(ws + WS_UEXT), (const char*)(ws + WS_WS), nullptr, (unsigned)(UEXT_LD * 2), 1024u, 128u, 8, 256, 0, c.wave, 0x7F7F7F7F};
        GridOrder S; S.init(NG * CHROWS / 256, 1, c.G, bid, 3);
        EpiS E{(float*)(ws + WS_S)};
        gemm_phase<0, false, EpiS, GridOrder, true>(ring, P, S, E);
        phase_pooling(pt, c);
    }
    SEAM(2);
    if (IN(3)) {
        phase_scan(pt, c);
        Prob P{(const char*)(ws + WS_POOLED), (const char*)(ws + WS_WPOOL), nullptr, 1024u, 1024u, 128u, 8, 0, 0, c.wave, 0x7F7F7F7F};
        GridOrder S; S.init(T / 256, 4, c.G, bid, -1);
        EpiPool E{(bf16_t*)(ws + WS_GB)};
        gemm_phase<0, false, EpiPool, GridOrder, true>(ring, P, S, E);
    }
    SEAM(3);
    if (IN(4)) {
        Prob P{(const char*)(ws + WS_UEXT), (const char*)(ws + WS_TV), nullptr, (unsigned)(UEXT_LD * 2), (unsigned)(UEXT_LD * 2), 128u, 10, 512, 0, c.wave, 0x7F7F7F7F};
        GridOrder S; S.init(NG * CHROWS / 256, 2, c.G, bid, 3);
        EpiBf16<1> E{(bf16_t*)(ws + WS_Z), 512};
        gemm_phase<0, false, EpiBf16<1>, GridOrder, true>(ring, P, S, E);
    }
    SEAM(4);
    if (IN(5)) {
        Prob P{(const char*)(ws + WS_Z), (const char*)(ws + WS_WGLU), nullptr, (unsigned)(2 * MiB), 1024u, (unsigned)(8 * MiB), 8, 0, 0, c.wave, 0x7F7F7F7F};
        GridOrder S; S.init(T / 256, 8, c.G, bid, -1);
        EpiGlu E{(bf16_t*)(ws + WS_GA), (const bf16_t*)(ws + WS_GB)};
        gemm_phase<1, false, EpiGlu, GridOrder, true>(ring, P, S, E);
    }
    SEAM(5);
    if (IN(6)) {
        Prob P{(const char*)(ws + WS_GA), (const char*)(ws + WS_WOUT), nullptr, 2048u, 2048u, 128u, 16, 0, 0, c.wave, 0x7F7F7F7F};
        GridOrder S; S.init(T / 256, 4, c.G, bid, -1);
        EpiWout E{(bf16_t*)(ws + WS_H1)};
        gemm_phase<0, false, EpiWout, GridOrder, true>(ring, P, S, E);
    }
    SEAM(6);
    if (IN(7)) {
        const bool rows_first = ((bid >> 3) & 1) == 0;
        if (rows_first) phase_ln1(pt, c);
        Prob P{(const char*)(ws + WS_PB), (const char*)(ws + WS_WPP), nullptr, 512u, 512u, 128u, 4, 0, 0, c.wave, 0x7F7F7F7F};
        GridOrder S; S.init(T / 256, 4, c.G, bid, -1);
        EpiBf16<0> E{(bf16_t*)(ws + WS_PP), 1024};
        gemm_phase<0, false, EpiBf16<0>, GridOrder, true>(ring, P, S, E);
        if (!rows_first) phase_ln1(pt, c);
    }
    SEAM(7);
    if (IN(8)) {
        Prob P{(const char*)(ws + WS_H1), (const char*)(ws + WS_WPLE), nullptr, 2048u, 2048u, 128u, 16, 0, 0, c.wave, 0x7F7F7F7F};
        GridOrder S; S.init(T / 256, 5, c.G, bid, -1);
        EpiPle E{(const bf16_t*)(ws + WS_H1), (const bf16_t*)(ws + WS_PP), (bf16_t*)(ws + WS_BASE), pt.in(20), (int*)(ws + WS_TOPE), (float*)(ws + WS_TOPW)};
        gemm_phase<0, false, EpiPle, GridOrder, true>(ring, P, S, E);
    }
    SEAM(8);
    if (IN(9)) phase_route_count(pt, c);
    SEAM(9);
    if (IN(10)) phase_route_place(pt, c);
    SEAM(10);
#define MOE_SLAB(s) do { constexpr int pa = 11 + 2 * (s), pb = 12 + 2 * (s); \
        LAS int* tp = (LAS int*)(c.lds + TP_OFF); \
        if (IN(pa) || IN(pb)) { const int tid_ = c.wave * 64 + lane_id(); __syncthreads(); if (tid_ < 33) tp[tid_] = ((const int*)(ws + WS_CNT + 65536))[(s) * 64 + tid_]; __syncthreads(); } \
        if (IN(pa)) { \
            const bool rows_first = ((bid >> 3) & 1) == 0; \
            if ((s) > 0 && rows_first) phase_combine(pt, c, (s) - 1); \
            MoeOrder S; S.init((const PG8_LAS int*)tp, 8, c.G, bid); \
            if (STAGGER_US > 0 && ((bid >> 3) & 1)) { const unsigned long long t0_ = __builtin_amdgcn_s_memrealtime(); while (__builtin_amdgcn_s_memrealtime() - t0_ < (unsigned long long)(STAGGER_US * 100)) __builtin_amdgcn_s_sleep(8); } \
            if (MOE_FP8) { \
                Prob P{(const char*)(ws + WS_H1Q), (const char*)(ws + WS_WGU), (const int*)(ws + WS_ROWTOK) + (size_t)(s) * SLAB_ROWS, 1024u, 1024u, 128u, 8, 2048, IB_OFF, c.wave, 0x7A7A7A7A}; \
                EpiM1F8 E{(unsigned char*)(ws + WS_ACT), pt.in(22), pt.in(24)}; \
                if (SHADOW == 11 && (s) == 0) { EpiNull<true> E0; gemm_phase<2, true, EpiNull<true>, MoeOrder, true>(ring, P, S, E0); } \
                gemm_phase<2, true, EpiM1F8, MoeOrder, true>(ring, P, S, E); \
            } else { \
                Prob P{(const char*)(ws + WS_H1), (const char*)(ws + WS_WGU), (const int*)(ws + WS_ROWTOK) + (size_t)(s) * SLAB_ROWS, 2048u, 2048u, 128u, 16, 2048, IB_OFF, c.wave, 0x7F7F7F7F}; \
                EpiM1 E{(bf16_t*)(ws + WS_ACT), pt.in(22), pt.in(24)}; \
                gemm_phase<2, false, EpiM1, MoeOrder, true>(ring, P, S, E); \
            } \
            if ((s) > 0 && !rows_first) phase_combine(pt, c, (s) - 1); \
        } \
        SEAM(pa); \
        if (IN(pb)) { \
            MoeOrder S; S.init((const PG8_LAS int*)tp, 4, c.G, bid); \
            if (MOE_FP8) { \
                Prob P{(const char*)(ws + WS_ACT), (const char*)(ws + WS_WDN), nullptr, 1024u, 1024u, 128u, 8, 1024, 0, c.wave, 0x79797979}; \
                EpiM2 E{(unsigned char*)(ws + WS_Y), pt.in(26), 1.0f}; \
                gemm_phase<0, true, EpiM2, MoeOrder, true>(ring, P, S, E); \
            } else { \
                Prob P{(const char*)(ws + WS_ACT), (const char*)(ws + WS_WDN), nullptr, 2048u, 2048u, 128u, 16, 1024, 0, c.wave, 0x7F7F7F7F}; \
                EpiM2 E{(unsigned char*)(ws + WS_Y), pt.in(26), 1.0f}; \
                gemm_phase<0, false, EpiM2, MoeOrder, true>(ring, P, S, E); \
            } \
        } \
        SEAM(pb); } while (0)
    MOE_SLAB(0);
#if MOE_NSLAB == 2
    MOE_SLAB(1);
#endif
#undef MOE_SLAB
    if (IN(NPHASE - 1)) phase_combine(pt, c, NSLAB - 1);
#undef IN
#undef SEAM
}

extern "C" void kernel_launch(void* const* d_in, const int* in_sizes, int n_in, void* d_out, int out_size, void* d_ws, size_t ws_size, hipStream_t stream) {
    static int grid = 0;
    if (grid == 0) {
        if (n_in != 31 || in_sizes[0] != T * D || out_size != T * D || ws_size < WS_END) { fprintf(stderr, "kernel_launch: unexpected problem (n_in %d, in0 %d, out %d, ws %zu); nothing launched\n", n_in, n_in > 0 ? in_sizes[0] : -1, out_size, ws_size); grid = -1; return; }
        int dev = 0, cus = 0, per_cu = 0;
        if (hipGetDevice(&dev) != hipSuccess || hipDeviceGetAttribute(&cus, hipDeviceAttributeMultiprocessorCount, dev) != hipSuccess) { grid = -1; return; }
        if (hipFuncSetAttribute((const void*)mega_fwd, hipFuncAttributeMaxDynamicSharedMemorySize, LDS_BYTES) != hipSuccess) { fprintf(stderr, "kernel_launch: hipFuncSetAttribute failed\n"); grid = -1; return; }
        if (hipOccupancyMaxActiveBlocksPerMultiprocessor(&per_cu, (const void*)mega_fwd, NWAVES * 64, LDS_BYTES) != hipSuccess || per_cu < 1) { fprintf(stderr, "kernel_launch: occupancy query reports %d workgroups per CU\n", per_cu); }
        (void)hipGetLastError();
        grid = cus;
    }
    if (grid < 0) return;
    if (hipMemsetAsync((char*)d_ws + WS_CTL, 0, CTL_ZERO_BYTES, stream) != hipSuccess) return;
    Args a{};
    for (int i = 0; i < 31; ++i) a.in[i] = (const float*)d_in[i];
    a.out = (float*)d_out; a.ws = (unsigned char*)d_ws; a.pad = 0;
#if MK_PER_PHASE
    for (int ph = 0; ph < NPHASE; ++ph) { a.ph_lo = ph; a.ph_hi = ph + 1; a.li = 0; hipLaunchKernelGGL(mega_fwd, dim3(grid), dim3(NWAVES * 64), LDS_BYTES, stream, a); }
#elif defined(PROBE_REPEAT)
    a.ph_lo = 0; a.ph_hi = PROBE_REPEAT + 1; a.li = 0; hipLaunchKernelGGL(mega_fwd, dim3(grid), dim3(NWAVES * 64), LDS_BYTES, stream, a);
    a.ph_lo = PROBE_REPEAT; a.ph_hi = NPHASE; a.li = 1; hipLaunchKernelGGL(mega_fwd, dim3(grid), dim3(NWAVES * 64), LDS_BYTES, stream, a);
#else
    a.ph_lo = 0; a.ph_hi = NPHASE; a.li = 0;
    hipLaunchKernelGGL(mega_fwd, dim3(grid), dim3(NWAVES * 64), LDS_BYTES, stream, a);
#endif
}
```

```cpp
#include <hip/hip_runtime.h>
#include <cstdio>
#include <cstdint>

#ifndef SHADOW
#define SHADOW 0
#endif
#ifndef MOE_FP8
#define MOE_FP8 1
#endif
#ifndef Y_FP8
#define Y_FP8 1
#endif
#ifndef STAGGER_US
#define STAGGER_US 0
#endif
#ifndef MK_PER_PHASE
#define MK_PER_PHASE 0
#endif

namespace pg8 {
#define PG8_LAS __attribute__((address_space(3)))
typedef unsigned short bf16_t;
typedef short bf16x8 __attribute__((ext_vector_type(8)));
typedef float f32x4 __attribute__((ext_vector_type(4)));
typedef float f32x2 __attribute__((ext_vector_type(2)));
typedef unsigned u32x4 __attribute__((ext_vector_type(4)));
typedef unsigned u32x2 __attribute__((ext_vector_type(2)));
constexpr int BM = 256, BK = 64, HALF = 128, HTB = HALF * BK * 2  , STAGE_BYTES = 8 * HTB, NXCD = 8, WGM = 8;

__host__ __device__ __forceinline__ int lds_byte(int r, int c) { const int st = (r >> 4) * 2 + (c >> 5), rr = r & 15, cc = c & 31, ob = rr * 64 + cc * 2; return st * 1024 + (ob ^ (((ob >> 9) & 1) << 5)); }
__host__ __device__ __forceinline__ void stage_rc(int b, int& R, int& C) { const int st = b / 1024, sb = b % 1024, swz = sb ^ (((sb >> 9) & 1) << 5); R = (st >> 1) * 16 + swz / 64; C = (st & 1) * 32 + (swz % 64) / 2; }
__host__ __device__ __forceinline__ int perm32(int rho) { const int n = rho >> 4, i = rho & 15; return 8 * (i >> 2) + 4 * n + (i & 3); }

struct Unit { int pm, pn, aux; };

struct Prob {
    const char* A; const char* B; const int* gidx;
    unsigned lda;
    unsigned ldb;
    unsigned kstepA;
    int nt;
    int bgn;
    int ib_off;
    int wid;
    int wscale;
};

struct GridOrder {
    int nM, nN, nwg, G, c, gshift;
    __device__ void init(int nM_, int nN_, int G_, int c_, int gshift_) { nM = nM_; nN = nN_; nwg = nM * nN; G = G_; c = c_; gshift = gshift_; }
    __device__ bool next(int i, Unit& u) const {
        const long L = (long)i * G + c; if (L >= nwg) return false;
        int wgid = (int)L; { const int q = nwg / NXCD, r = nwg % NXCD, xcd = wgid % NXCD, off = wgid / NXCD; wgid = (xcd < r ? xcd * (q + 1) : r * (q + 1) + (xcd - r) * q) + off; }
        const int nig = WGM * nN, gid = wgid / nig, fm = gid * WGM, gsz = (nM - fm) < WGM ? (nM - fm) : WGM;
        u.pm = fm + ((wgid % nig) % gsz); u.pn = (wgid % nig) / gsz; u.aux = gshift >= 0 ? (u.pm >> gshift) : 0; return true;
    }
};
struct MoeOrder {
    const PG8_LAS int* tp; int nct, total, G, c;
    __device__ void init(const PG8_LAS int* tp_, int nct_, int G_, int c_) { tp = tp_; nct = nct_; G = G_; c = c_; total = __builtin_amdgcn_readfirstlane(tp_[32]) * nct_; }
    __device__ bool next(int i, Unit& u) const {
        const long L = (long)i * G + c; if (L >= total) return false;
        int wgid = (int)L; { const int q = total / NXCD, r = total % NXCD, xcd = wgid % NXCD, off = wgid / NXCD; wgid = (xcd < r ? xcd * (q + 1) : r * (q + 1) + (xcd - r) * q) + off; }
        int ln = (int)__builtin_amdgcn_mbcnt_hi(~0u, __builtin_amdgcn_mbcnt_lo(~0u, 0u)); asm volatile("" : "+v"(ln));
        int e = __builtin_popcountll(__ballot(ln < 31 && wgid >= tp[(ln < 31 ? ln : 30) + 1] * nct)); e = __builtin_amdgcn_readfirstlane(e);
        const int t0 = __builtin_amdgcn_readfirstlane(tp[e]), nte = __builtin_amdgcn_readfirstlane(tp[e + 1]) - t0, local = wgid - t0 * nct;
        (void)nte; u.pn = __builtin_amdgcn_readfirstlane(local % nct); u.pm = __builtin_amdgcn_readfirstlane(t0 + local / nct); u.aux = e; return true;
    }
};

__device__ __forceinline__ unsigned cvt_pk_bf16(float lo, float hi) { unsigned r; asm volatile("v_cvt_pk_bf16_f32 %0, %1, %2" : "=v"(r) : "v"(lo), "v"(hi)); return r; }
__device__ __forceinline__ float bf_lo(unsigned w) { return __uint_as_float(w << 16); }
__device__ __forceinline__ float bf_hi(unsigned w) { return __uint_as_float(w & 0xffff0000u); }
__device__ __forceinline__ float sigmoid_f(float x) { return __builtin_amdgcn_rcpf(1.0f + __builtin_amdgcn_exp2f(-1.4426950409f * x)); }

typedef int v4i __attribute__((ext_vector_type(4)));
typedef int v8i __attribute__((ext_vector_type(8)));
template <bool FP8> __device__ __forceinline__ void stage_map(int p, int& R, int& Cb) {
    if (FP8) { R = (p >> 11) * 16 + ((p & 255) >> 4); Cb = ((p & 2047) >> 8) * 16; }
    else { int C; stage_rc(p, R, C); Cb = 2 * C; }
}
template <int AMODE, bool FP8, class Epi, class Sched, bool ALIGN_EPI>
__device__ __forceinline__ void gemm_phase(PG8_LAS unsigned char* lds, const Prob P, const Sched& S, const Epi& E) {
    const int wid = P.wid, lane = (int)__builtin_amdgcn_mbcnt_hi(~0u, __builtin_amdgcn_mbcnt_lo(~0u, 0u)), tid = wid * 64 + lane, wr = wid >> 2, wc = wid & 3, fr = lane & 15, fq = lane >> 4;
    const int nt = P.nt;
    unsigned vo[2][2], voffB[2];
#pragma unroll
    for (int i = 0; i < 2; ++i) { int R, Cb; stage_map<FP8>(tid * 16 + i * 8192, R, Cb); const int Rb = Epi::PERM ? ((R & ~31) + perm32(R & 31)) : R;
        voffB[i] = (unsigned)Rb * P.ldb + (unsigned)Cb;
#pragma unroll
        for (int h = 0; h < 2; ++h) {
            if (AMODE == 0) vo[h][i] = (unsigned)(h * HALF + R) * P.lda + (unsigned)Cb;
            else if (AMODE == 1) vo[h][i] = (unsigned)(Cb >> 5) * P.lda + (unsigned)(h * HALF + R) * 32u + (unsigned)(Cb & 31);
            else vo[h][i] = 0u; } }
    const unsigned kstepA = P.kstepA, kstepB = (unsigned)(BK * 2);
    const unsigned hstepB = (unsigned)HALF * P.ldb;
    const unsigned ldsw = (unsigned)wid * 1024u;
    const int aoff = FP8 ? (wr * 4 * 2048 + 2 * fq * 256 + fr * 16) : lds_byte(wr * 64 + fr, fq * 8), boff = FP8 ? (wc * 2 * 2048 + 2 * fq * 256 + fr * 16) : lds_byte(wc * 32 + fr, fq * 8);
    constexpr int KOFF = FP8 ? 256 : 1024;
    const int sc1 = 0x7F7F7F7F;
#define PG8_AOFF(u) ((unsigned)(AMODE == 0 ? (unsigned)(u).pm * BM * P.lda : (AMODE == 1 ? (unsigned)(u).pm * BM * 32u : 0u)))
#define PG8_BOFF(u) ((unsigned)(((unsigned)(u).aux * P.bgn + (unsigned)(u).pn * BM) * P.ldb))
#define PG8_GIDX(src, dst) do { _Pragma("unroll") for (int _i = 0; _i < 2; ++_i) { int _R, _C; stage_map<FP8>(tid * 16 + _i * 8192, _R, _C); _Pragma("unroll") for (int _h = 0; _h < 2; ++_h) \
        dst[_h][_i] = (unsigned)(src)[_h * HALF + _R] * P.lda + (unsigned)_C; } } while (0)
#define PG8_SA(b, h) (((b) * 2 + (h)) * HTB)
#define PG8_SB(b, h) ((4 + (b) * 2 + (h)) * HTB)
    const __amdgpu_buffer_rsrc_t rsA = __builtin_amdgcn_make_buffer_rsrc((void*)P.A, 0, 0xFFFFFFFF, 0x00020000);
    const __amdgpu_buffer_rsrc_t rsB = __builtin_amdgcn_make_buffer_rsrc((void*)P.B, 0, 0xFFFFFFFF, 0x00020000);
#define PG8_STAGE2(bufoff, rs, so, v0, v1) do { \
        __builtin_amdgcn_raw_ptr_buffer_load_lds(rs, (PG8_LAS void*)(lds + (bufoff) + ldsw), 16, (int)(v0), (int)(so), 0, 0); \
        __builtin_amdgcn_raw_ptr_buffer_load_lds(rs, (PG8_LAS void*)(lds + (bufoff) + ldsw + 8192), 16, (int)(v1), (int)(so), 0, 0); } while (0)
#define PG8_STAGE_A(bufoff, so, h) PG8_STAGE2(bufoff, rsA, so, vo[h][0], vo[h][1])
#define PG8_STAGE_B(bufoff, so) PG8_STAGE2(bufoff, rsB, so, voffB[0], voffB[1])
#define PG8_LDA(dst, b, h) do { _Pragma("unroll") for (int m = 0; m < 4; ++m) _Pragma("unroll") for (int k = 0; k < 2; ++k) dst[m][k] = *(const PG8_LAS bf16x8*)(lds + PG8_SA(b, h) + aoff + m * 2048 + k * KOFF); } while (0)
#define PG8_LDB(dst, b, h) do { _Pragma("unroll") for (int n = 0; n < 2; ++n) _Pragma("unroll") for (int k = 0; k < 2; ++k) dst[n][k] = *(const PG8_LAS bf16x8*)(lds + PG8_SB(b, h) + boff + n * 2048 + k * KOFF); } while (0)
#define PG8_MMA(ai, bj, At, Bt) do { __builtin_amdgcn_s_setprio(1); _Pragma("unroll") for (int m = 0; m < 4; ++m) _Pragma("unroll") for (int n = 0; n < 2; ++n) { \
        if constexpr (FP8) { acc[ai][bj][m][n] = __builtin_amdgcn_mfma_scale_f32_16x16x128_f8f6f4( \
                __builtin_shufflevector(__builtin_bit_cast(v4i, Bt[n][0]), __builtin_bit_cast(v4i, Bt[n][1]), 0, 1, 2, 3, 4, 5, 6, 7), \
                __builtin_shufflevector(__builtin_bit_cast(v4i, At[m][0]), __builtin_bit_cast(v4i, At[m][1]), 0, 1, 2, 3, 4, 5, 6, 7), acc[ai][bj][m][n], 0, 0, 0, P.wscale, 0, sc1); } \
        else { _Pragma("unroll") for (int k = 0; k < 2; ++k) acc[ai][bj][m][n] = __builtin_amdgcn_mfma_f32_16x16x32_bf16(Bt[n][k], At[m][k], acc[ai][bj][m][n], 0, 0, 0); } } \
        __builtin_amdgcn_s_setprio(0); } while (0)
#define PG8_WAIT_V(n) asm volatile("s_waitcnt vmcnt(" #n ")" ::: "memory")
#define PG8_WAIT_L(n) asm volatile("s_waitcnt lgkmcnt(" #n ")" ::: "memory")
#define PG8_BAR __builtin_amdgcn_s_barrier()
#define PG8_SCHED __builtin_amdgcn_sched_barrier(0)
    Unit cur, nxt; int ui = 0;
    if (!S.next(0, cur)) return;
    f32x4 acc[2][2][4][2];
    { f32x4 ini[2][2];
    E.init(cur, wc, fq, ini);
#pragma unroll
    for (int a = 0; a < 2; ++a)
#pragma unroll
        for (int b = 0; b < 2; ++b)
#pragma unroll
            for (int m = 0; m < 4; ++m)
#pragma unroll
                for (int n = 0; n < 2; ++n) acc[a][b][m][n] = ini[b][n]; }
    bf16x8 At[4][2], B0[2][2], B1[2][2];
    unsigned cA = PG8_AOFF(cur), cB = PG8_BOFF(cur);
    if (AMODE == 2) { const int* gi = P.gidx + cur.pm * BM; PG8_GIDX(gi, vo); }
    PG8_STAGE_B(PG8_SB(0, 0), cB); PG8_STAGE_B(PG8_SB(0, 1), cB + hstepB); PG8_STAGE_A(PG8_SA(0, 0), cA, 0); PG8_STAGE_A(PG8_SA(0, 1), cA, 1);
    if (wr == 1) PG8_BAR;
    PG8_WAIT_V(2); PG8_BAR;
    PG8_STAGE_B(PG8_SB(1, 0), cB + kstepB); PG8_STAGE_A(PG8_SA(1, 0), cA + kstepA, 0); PG8_STAGE_B(PG8_SB(1, 1), cB + hstepB + kstepB);
    PG8_WAIT_V(6); PG8_BAR;
    for (;;) {
        const bool has_next = S.next(ui + 1, nxt);
        const unsigned nA = has_next ? PG8_AOFF(nxt) : cA, nB = has_next ? PG8_BOFF(nxt) : cB;
#pragma nounroll
        for (int t = 0; t < nt; t += 2) {
            const bool last = (t == nt - 2);
            const unsigned a1 = cA + (unsigned)(t + 1) * kstepA;
            const unsigned a2 = last ? nA : cA + (unsigned)(t + 2) * kstepA, b2 = last ? nB : cB + (unsigned)(t + 2) * kstepB;
            const unsigned a3 = a2 + kstepA, b3 = b2 + kstepB;
            if (AMODE == 2) { if (t == 0 && has_next && wid < 4)
                    __builtin_amdgcn_global_load_lds((const unsigned*)(P.gidx + nxt.pm * BM + wid * 64 + lane), (PG8_LAS unsigned*)(lds + P.ib_off + (((ui + 1) & 1) * 256 + wid * 64) * 4), 4, 0, 0); }
            PG8_LDB(B0, 0, 0); PG8_LDB(B1, 0, 1); PG8_SCHED; PG8_LDA(At, 0, 0); PG8_STAGE_A(PG8_SA(1, 1), a1, 1);
            if (AMODE == 2) { if (last && has_next) { const PG8_LAS int* ib = (const PG8_LAS int*)(lds + P.ib_off) + ((ui + 1) & 1) * 256; PG8_GIDX(ib, vo); } }
            PG8_WAIT_V(8); PG8_WAIT_L(0); PG8_BAR; PG8_MMA(0, 0, At, B0); PG8_MMA(0, 1, At, B1); PG8_BAR; PG8_SCHED;
            PG8_LDA(At, 0, 1); PG8_STAGE_B(PG8_SB(0, 0), b2); PG8_STAGE_B(PG8_SB(0, 1), b2 + hstepB); PG8_STAGE_A(PG8_SA(0, 0), a2, 0);
            PG8_WAIT_V(8); PG8_WAIT_L(0); PG8_BAR; PG8_MMA(1, 0, At, B0); PG8_MMA(1, 1, At, B1); PG8_BAR; PG8_SCHED;
            PG8_LDB(B0, 1, 0); PG8_LDB(B1, 1, 1); PG8_SCHED; PG8_LDA(At, 1, 0); PG8_STAGE_A(PG8_SA(0, 1), a2, 1);
            PG8_WAIT_V(8); PG8_WAIT_L(0); PG8_BAR; PG8_MMA(0, 0, At, B0); PG8_MMA(0, 1, At, B1); PG8_BAR; PG8_SCHED;
            PG8_LDA(At, 1, 1); PG8_STAGE_B(PG8_SB(1, 0), b3); PG8_STAGE_B(PG8_SB(1, 1), b3 + hstepB); PG8_STAGE_A(PG8_SA(1, 0), a3, 0);
            PG8_WAIT_V(8); PG8_WAIT_L(0); PG8_BAR; PG8_MMA(1, 0, At, B0); PG8_MMA(1, 1, At, B1); PG8_BAR; PG8_SCHED;
        }
        if constexpr (ALIGN_EPI) { if (wr == 0) PG8_BAR; }
        { int fr2 = fr, fq2 = fq; asm volatile("" : "+v"(fr2), "+v"(fq2));
          f32x4 nini[2][2];
          if (has_next) E.init(nxt, wc, fq2, nini); else nini[0][0] = nini[0][1] = nini[1][0] = nini[1][1] = (f32x4){0.f, 0.f, 0.f, 0.f};
          E(acc, cur, wr, wc, fr2, fq2);
#pragma unroll
          for (int a = 0; a < 2; ++a)
#pragma unroll
            for (int b = 0; b < 2; ++b)
#pragma unroll
                for (int m = 0; m < 4; ++m)
#pragma unroll
                    for (int n = 0; n < 2; ++n) acc[a][b][m][n] = nini[b][n]; }
        if (!has_next) break;
        cur = nxt; cA = nA; cB = nB; ++ui;
        if constexpr (ALIGN_EPI) { if (wr == 1) PG8_BAR; }
    }
    PG8_WAIT_V(0);
    if constexpr (!ALIGN_EPI) { if (wr == 0) PG8_BAR; }
    PG8_BAR;
#undef PG8_AOFF
#undef PG8_BOFF
#undef PG8_GIDX
#undef PG8_SA
#undef PG8_SB
#undef PG8_STAGE2
#undef PG8_STAGE_B
#undef PG8_STAGE_A
#undef PG8_LDA
#undef PG8_LDB
#undef PG8_MMA
#undef PG8_WAIT_V
#undef PG8_WAIT_L
#undef PG8_BAR
#undef PG8_SCHED
}
}

constexpr int NWAVES = 8;
constexpr int BATCH = 16, SEQ = 4096, D = 1024, T = BATCH * SEQ;
constexpr int PLE = 256, SSMW = 512, POOLW = 512, NG = 32, GH = 16, NP = 64;
constexpr int LC = 32, NCH = SEQ / LC, CHROWS = BATCH * NCH;
constexpr int UEXT_LD = 640;
constexpr int NEXP = 32, TOPK = 4, NIN = 3072;
#ifndef MOE_NSLAB
#define MOE_NSLAB 1
#endif
constexpr int NSLAB = MOE_NSLAB, WPS = 256 / NSLAB  , SLAB_T = T / NSLAB, SLAB_ROWS = (SLAB_T * TOPK / 256 + NEXP) * 256;
constexpr float LN_EPS = 1e-5f, DN_ALPHA = 1.189207115002721f, SW_LIMIT = 7.0f, SW_ALPHA = 1.702f;
constexpr int NPHASE = 11 + 2 * NSLAB;

constexpr size_t MiB = 1u << 20;
constexpr size_t WS_WGU = 0 * MiB;
constexpr size_t WS_WDN = 128 * MiB;
constexpr size_t WS_WIN = 192 * MiB;
constexpr size_t WS_WGLU = 198 * MiB;
constexpr size_t WS_WPOOL = 200 * MiB;
constexpr size_t WS_WOUT = 201 * MiB;
constexpr size_t WS_WPLE = 203 * MiB;
constexpr size_t WS_WPP = 206 * MiB;
constexpr size_t WS_WS = 207 * MiB;
constexpr size_t WS_TV = 215 * MiB;
constexpr size_t WS_CTL = 235 * MiB;
constexpr size_t WS_TOPE = 236 * MiB;
constexpr size_t WS_TOPW = 237 * MiB;
constexpr size_t WS_ROWTOK = 238 * MiB;
constexpr size_t WS_SLOTPOS = 240 * MiB;
constexpr size_t WS_CNT = 242 * MiB;
constexpr size_t WS_XB = 244 * MiB;
constexpr size_t WS_H1 = 244 * MiB;
constexpr size_t WS_UEXT = 372 * MiB;
constexpr size_t WS_UPOOL = 452 * MiB;
constexpr size_t WS_PP = 372 * MiB;
constexpr size_t WS_GA = 516 * MiB;
constexpr size_t WS_GB = 644 * MiB;
constexpr size_t WS_POOLED = 772 * MiB;
constexpr size_t WS_S = 836 * MiB;
constexpr size_t WS_Z = 868 * MiB;
constexpr size_t WS_PB = 932 * MiB;
constexpr size_t WS_ACT = (NSLAB == 1 ? 244 : 372) * MiB;
constexpr size_t WS_BASE = 580 * MiB;
constexpr size_t WS_Y = (NSLAB == 1 ? 708 : 752) * MiB;
constexpr size_t WS_H1Q = 516 * MiB;
constexpr size_t WS_END = 1024 * MiB;
static_assert(MOE_FP8 && Y_FP8, "the workspace map below assumes e4m3 act and y");
static_assert(WS_BASE + (size_t)T * 2048 <= WS_Y && WS_H1Q + (size_t)T * 1024 <= WS_BASE && WS_ACT + (size_t)SLAB_ROWS * 1024 <= WS_H1Q && WS_Y + (size_t)SLAB_ROWS * 1024 <= WS_END && (size_t)NSLAB * SLAB_ROWS * 4 <= 2 * MiB && WS_PB + (size_t)T * PLE * 2 <= WS_END, "ws map");
constexpr size_t CTL_ZERO_BYTES = 1 * MiB;
constexpr int CW_BAR = 4096;

constexpr int RING_BYTES = 131072;
constexpr int LDSCTL_OFF = RING_BYTES, MISC_OFF = LDSCTL_OFF + 320;
constexpr int HIST_OFF = LDSCTL_OFF + 512;
constexpr int TP_OFF = LDSCTL_OFF + 1024, IB_OFF = TP_OFF + 512, PTAB_OFF = IB_OFF + 2048;
constexpr int LDS_BYTES = 147456;

#define GAS __attribute__((address_space(1)))
#define LAS __attribute__((address_space(3)))
typedef unsigned short bf16;
typedef unsigned v4u __attribute__((ext_vector_type(4)));
typedef unsigned v2u __attribute__((ext_vector_type(2)));
typedef float f32x4 __attribute__((ext_vector_type(4)));
typedef GAS unsigned gu32;
#define RLX_AGENT __ATOMIC_RELAXED, __HIP_MEMORY_SCOPE_AGENT
#define LDS_WAIT() asm volatile("s_waitcnt lgkmcnt(0)" ::: "memory")
#define VM_WAIT() asm volatile("s_waitcnt vmcnt(0)" ::: "memory")
__device__ __forceinline__ unsigned f2bf(float f) { unsigned u = __builtin_bit_cast(unsigned, f); return (u + 0x7fffu + ((u >> 16) & 1u)) >> 16; }
__device__ __forceinline__ unsigned pk2(float lo, float hi) { return f2bf(lo) | (f2bf(hi) << 16); }
__device__ __forceinline__ float bf2f(unsigned short b) { return __uint_as_float(((unsigned)b) << 16); }

#define XB_TMO      128
#define XB_XCNT(j)  (256  + 64 * (j))
#define XB_XSUB(j)  (1280 + 64 * (j))
#define XB_XGEN(j)  (2304 + 64 * (j))
#define XB_TOP      3328
#define XB_TOPGEN   3392
#define XCD_BAR_WORDS 3456
#define XB_SPIN_CAP (1u << 18)

__device__ __forceinline__ unsigned xb_ld(unsigned* p)              { return __hip_atomic_load(p, __ATOMIC_RELAXED, __HIP_MEMORY_SCOPE_AGENT); }
__device__ __forceinline__ unsigned xb_add(unsigned* p, unsigned v) { return __hip_atomic_fetch_add(p, v, __ATOMIC_RELAXED, __HIP_MEMORY_SCOPE_AGENT); }
__device__ __forceinline__ unsigned xb_xcc_id() { return (unsigned)__builtin_amdgcn_s_getreg((3 << 11) | 20) & 0xFu; }
#define XB_SPIN(cond, bar) do { unsigned _sp = 0; while (cond) { __builtin_amdgcn_s_sleep(1); \
    if ((++_sp & 255u) == 0u) { if (xb_ld(&(bar)[XB_TMO])) break; if (_sp > XB_SPIN_CAP) { atomicAdd(&(bar)[XB_TMO], 1u); break; } } } } while (0)

struct XcdBarrier {
    unsigned* bar; unsigned x;
    volatile LAS unsigned* st;
};

__device__ __forceinline__ XcdBarrier xcd_barrier_post(unsigned* bar, volatile LAS unsigned* st) {
    XcdBarrier b; b.bar = bar; b.x = xb_xcc_id(); b.st = st;
    if (threadIdx.x == 0) (void)xb_add(&bar[XB_XCNT(b.x)], 1u);
    return b;
}
__device__ __forceinline__ void xcd_barrier_complete(unsigned* bar, unsigned x, unsigned& nloc, unsigned& nx) {
    const unsigned G = gridDim.x * gridDim.y * gridDim.z;
    unsigned sum, cnt, mine, sp = 0u;
    for (;;) {
        sum = 0u; cnt = 0u; mine = 0u;
#pragma unroll
        for (unsigned j = 0; j < 16; ++j) { const unsigned c = xb_ld(&bar[XB_XCNT(j)]); sum += c; cnt += (c > 0u) ? 1u : 0u; mine = (j == x) ? c : mine; }
        if (sum == G) break;
        __builtin_amdgcn_s_sleep(1);
        if ((++sp & 255u) == 0u) { if (xb_ld(&bar[XB_TMO])) break; if (sp > XB_SPIN_CAP) { atomicAdd(&bar[XB_TMO], 1u); break; } }
    }
    nloc = mine > 0u ? mine : 1u; nx = cnt > 0u ? cnt : 1u;
}

__device__ __forceinline__ void xcd_barrier(const XcdBarrier& b) {
    asm volatile("s_waitcnt vmcnt(0)" ::: "memory");
    __syncthreads();
    if (threadIdx.x == 0) {
        unsigned* bar = b.bar;
        __builtin_amdgcn_s_waitcnt(0);
        unsigned nloc = b.st[0], nx = b.st[1];
        if (nloc == 0u) { xcd_barrier_complete(bar, b.x, nloc, nx); b.st[0] = nloc; b.st[1] = nx; }
        const unsigned old = xb_add(&bar[XB_XSUB(b.x)], 1u);
        const unsigned gen = old / nloc;
        if (old + 1u == (gen + 1u) * nloc) {
            __builtin_amdgcn_fence(__ATOMIC_RELEASE, "agent");
            asm volatile("s_waitcnt vmcnt(0)" ::: "memory");
            const unsigned og = xb_add(&bar[XB_TOP], 1u);
            const unsigned tg = og / nx;
            if (og + 1u == (tg + 1u) * nx) xb_add(&bar[XB_TOPGEN], 1u);
            else XB_SPIN(xb_ld(&bar[XB_TOPGEN]) == tg, bar);
            __builtin_amdgcn_fence(__ATOMIC_ACQUIRE, "agent");
            xb_add(&bar[XB_XGEN(b.x)], 1u);
            asm volatile("s_waitcnt vmcnt(0)" ::: "memory");
        } else {
            XB_SPIN(xb_ld(&bar[XB_XGEN(b.x)]) == gen, bar);
            __builtin_amdgcn_fence(__ATOMIC_ACQUIRE, "agent");
            asm volatile("s_waitcnt vmcnt(0)" ::: "memory");
        }
    }
    __syncthreads();
}

namespace pg8 {
#define EPI_ROW(u, ai, m) ((u).pm * BM + (ai) * HALF + wr * 64 + (m) * 16 + fr)
#define EPI_COL8(u, bj) ((u).pn * BM + (bj) * HALF + wc * 32 + 8 * fq)
#define EPI_COL4(u, bj, n) ((u).pn * BM + (bj) * HALF + wc * 32 + 16 * (n) + 4 * fq)
__device__ __forceinline__ u32x4 pack8(const f32x4 a, const f32x4 b) { u32x4 w; w.x = cvt_pk_bf16(a[0], a[1]); w.y = cvt_pk_bf16(a[2], a[3]); w.z = cvt_pk_bf16(b[0], b[1]); w.w = cvt_pk_bf16(b[2], b[3]); return w; }
__device__ __forceinline__ void unpack8(const u32x4 w, f32x4& a, f32x4& b) { a = (f32x4){bf_lo(w.x), bf_hi(w.x), bf_lo(w.y), bf_hi(w.y)}; b = (f32x4){bf_lo(w.z), bf_hi(w.z), bf_lo(w.w), bf_hi(w.w)}; }
__device__ __forceinline__ f32x4 sig4(const f32x4 v) { return (f32x4){sigmoid_f(v[0]), sigmoid_f(v[1]), sigmoid_f(v[2]), sigmoid_f(v[3])}; }
__device__ __forceinline__ float gelu_tanh(float x) { return x * sigmoid_f(1.5957691216f * (x + 0.044715f * x * x * x)); }

template <bool PERM_> struct EpiNull {
    static constexpr bool PERM = PERM_;
    __device__ __forceinline__ void init(const Unit& u, int wc, int fq, f32x4 (&ini)[2][2]) const { ini[0][0] = ini[0][1] = ini[1][0] = ini[1][1] = (f32x4){0.f, 0.f, 0.f, 0.f}; }
    __device__ __forceinline__ void operator()(const f32x4 (&acc)[2][2][4][2], const Unit& u, int wr, int wc, int fr, int fq) const {
#pragma unroll
        for (int ai = 0; ai < 2; ++ai)
#pragma unroll
            for (int bj = 0; bj < 2; ++bj)
#pragma unroll
                for (int m = 0; m < 4; ++m)
#pragma unroll
                    for (int n = 0; n < 2; ++n) asm volatile("" :: "v"(acc[ai][bj][m][n]));
    }
};
struct EpiInProj {
    static constexpr bool PERM = true;
    __device__ __forceinline__ void init(const Unit& u, int wc, int fq, f32x4 (&ini)[2][2]) const { ini[0][0] = ini[0][1] = ini[1][0] = ini[1][1] = (f32x4){0.f, 0.f, 0.f, 0.f}; }
    bf16_t* uext; bf16_t* upool; bf16_t* ga; bf16_t* gb;
    __device__ __forceinline__ void operator()(const f32x4 (&acc)[2][2][4][2], const Unit& u, int wr, int wc, int fr, int fq) const {
#pragma unroll
        for (int ai = 0; ai < 2; ++ai)
#pragma unroll
            for (int m = 0; m < 4; ++m) { const int t = EPI_ROW(u, ai, m);
#pragma unroll
                for (int bj = 0; bj < 2; ++bj) { const int c = EPI_COL8(u, bj); f32x4 v0 = acc[ai][bj][m][0], v1 = acc[ai][bj][m][1]; bf16_t* dst;
                    if (u.pn < 2) { const int g = c >> 4, h0 = c & 15; dst = uext + ((size_t)g * 2048 + (size_t)(t >> 5)) * 640 + (size_t)((t & 31) * 16 + h0); }
                    else if (u.pn < 4) dst = upool + (size_t)t * 512 + (c - 512);
                    else { v0 = sig4(v0); v1 = sig4(v1); dst = (u.pn < 8) ? ga + (size_t)t * 1024 + (c - 1024) : gb + (size_t)t * 1024 + (c - 2048); }
                    *(u32x4*)dst = pack8(v0, v1); } }
    }
};
struct EpiS {
    static constexpr bool PERM = false;
    __device__ __forceinline__ void init(const Unit& u, int wc, int fq, f32x4 (&ini)[2][2]) const { ini[0][0] = ini[0][1] = ini[1][0] = ini[1][1] = (f32x4){0.f, 0.f, 0.f, 0.f}; }
    float* S;
    __device__ __forceinline__ void operator()(const f32x4 (&acc)[2][2][4][2], const Unit& u, int wr, int wc, int fr, int fq) const {
#pragma unroll
        for (int ai = 0; ai < 2; ++ai)
#pragma unroll
            for (int m = 0; m < 4; ++m) { float* rowp = S + (size_t)EPI_ROW(u, ai, m) * 128 + wc * 32 + 4 * fq;
#pragma unroll
                for (int n = 0; n < 2; ++n) *(f32x4*)(rowp + 16 * n) = acc[ai][0][m][n]; }
    }
};
template <int ACT> struct EpiBf16 {
    static constexpr bool PERM = true;
    __device__ __forceinline__ void init(const Unit& u, int wc, int fq, f32x4 (&ini)[2][2]) const { ini[0][0] = ini[0][1] = ini[1][0] = ini[1][1] = (f32x4){0.f, 0.f, 0.f, 0.f}; }
    bf16_t* O; int ldc;
    __device__ __forceinline__ void operator()(const f32x4 (&acc)[2][2][4][2], const Unit& u, int wr, int wc, int fr, int fq) const {
#pragma unroll
        for (int ai = 0; ai < 2; ++ai)
#pragma unroll
            for (int m = 0; m < 4; ++m) { bf16_t* rowp = O + (size_t)EPI_ROW(u, ai, m) * ldc;
#pragma unroll
                for (int bj = 0; bj < 2; ++bj) { f32x4 v0 = acc[ai][bj][m][0], v1 = acc[ai][bj][m][1];
                    if (ACT == 1) {
#pragma unroll
                        for (int j = 0; j < 4; ++j) { v0[j] = gelu_tanh(v0[j]); v1[j] = gelu_tanh(v1[j]); } }
                    *(u32x4*)(rowp + EPI_COL8(u, bj)) = pack8(v0, v1); } }
    }
};
struct EpiPool {
    static constexpr bool PERM = true;
    __device__ __forceinline__ void init(const Unit& u, int wc, int fq, f32x4 (&ini)[2][2]) const { ini[0][0] = ini[0][1] = ini[1][0] = ini[1][1] = (f32x4){0.f, 0.f, 0.f, 0.f}; }
    bf16_t* gb;
    __device__ __forceinline__ void operator()(const f32x4 (&acc)[2][2][4][2], const Unit& u, int wr, int wc, int fr, int fq) const {
#pragma unroll
        for (int ai = 0; ai < 2; ++ai)
#pragma unroll
            for (int m = 0; m < 4; ++m) { bf16_t* rowp = gb + (size_t)EPI_ROW(u, ai, m) * 1024;
#pragma unroll
                for (int bj = 0; bj < 2; ++bj) { u32x4* p = (u32x4*)(rowp + EPI_COL8(u, bj)); f32x4 g0, g1; unpack8(*p, g0, g1);
                    *p = pack8(g0 * acc[ai][bj][m][0], g1 * acc[ai][bj][m][1]); } }
    }
};
struct EpiGlu {
    static constexpr bool PERM = true;
    __device__ __forceinline__ void init(const Unit& u, int wc, int fq, f32x4 (&ini)[2][2]) const { ini[0][0] = ini[0][1] = ini[1][0] = ini[1][1] = (f32x4){0.f, 0.f, 0.f, 0.f}; }
    bf16_t* ga; const bf16_t* gb;
    __device__ __forceinline__ void operator()(const f32x4 (&acc)[2][2][4][2], const Unit& u, int wr, int wc, int fr, int fq) const {
#pragma unroll
        for (int ai = 0; ai < 2; ++ai)
#pragma unroll
            for (int m = 0; m < 4; ++m) { const size_t off = (size_t)EPI_ROW(u, ai, m) * 1024 + (size_t)(u.pn * HALF + wc * 32 + 8 * fq);
                u32x4* pa = (u32x4*)(ga + off); f32x4 a0, a1, t0, t1; unpack8(*pa, a0, a1); unpack8(*(const u32x4*)(gb + off), t0, t1);
                const f32x4 y0 = acc[ai][0][m][0] * sig4(acc[ai][1][m][0]), y1 = acc[ai][0][m][1] * sig4(acc[ai][1][m][1]);
                *pa = pack8(a0 * y0 + t0, a1 * y1 + t1); }
    }
};
struct EpiWout {
    static constexpr bool PERM = true;
    __device__ __forceinline__ void init(const Unit& u, int wc, int fq, f32x4 (&ini)[2][2]) const { ini[0][0] = ini[0][1] = ini[1][0] = ini[1][1] = (f32x4){0.f, 0.f, 0.f, 0.f}; }
    bf16_t* s;
    __device__ __forceinline__ void operator()(const f32x4 (&acc)[2][2][4][2], const Unit& u, int wr, int wc, int fr, int fq) const {
        u32x4 xv[2][4][2];
#pragma unroll
        for (int ai = 0; ai < 2; ++ai) {
#pragma unroll
            for (int m = 0; m < 4; ++m)
#pragma unroll
                for (int bj = 0; bj < 2; ++bj) xv[ai & 1][m][bj] = *(const u32x4*)(s + (size_t)EPI_ROW(u, ai, m) * 1024 + EPI_COL8(u, bj));
#pragma unroll
            for (int m = 0; m < 4; ++m)
#pragma unroll
                for (int bj = 0; bj < 2; ++bj) { f32x4 x0, x1; unpack8(xv[ai & 1][m][bj], x0, x1);
                    *(u32x4*)(s + (size_t)EPI_ROW(u, ai, m) * 1024 + EPI_COL8(u, bj)) = pack8(x0 * 1.189207115002721f + acc[ai][bj][m][0], x1 * 1.189207115002721f + acc[ai][bj][m][1]); }
            asm volatile("" ::: "memory"); }
    }
};
struct EpiPle {
    static constexpr bool PERM = true;
    __device__ __forceinline__ void init(const Unit& u, int wc, int fq, f32x4 (&ini)[2][2]) const { ini[0][0] = ini[0][1] = ini[1][0] = ini[1][1] = (f32x4){0.f, 0.f, 0.f, 0.f}; }
    const bf16_t* h1; const bf16_t* pp; bf16_t* base; const float* brouter; int* tope; float* topw; PG8_LAS int* hist; int* cnt;
    __device__ __forceinline__ void operator()(const f32x4 (&acc)[2][2][4][2], const Unit& u, int wr, int wc, int fr, int fq) const {
        if (u.pn < 4) {
#pragma unroll
            for (int ai = 0; ai < 2; ++ai) { u32x4 hv[4][2], pv[4][2];
#pragma unroll
                for (int m = 0; m < 4; ++m)
#pragma unroll
                    for (int bj = 0; bj < 2; ++bj) { const size_t o = (size_t)EPI_ROW(u, ai, m) * 1024 + EPI_COL8(u, bj); hv[m][bj] = *(const u32x4*)(h1 + o); pv[m][bj] = *(const u32x4*)(pp + o); }
#pragma unroll
                for (int m = 0; m < 4; ++m)
#pragma unroll
                    for (int bj = 0; bj < 2; ++bj) { const size_t o = (size_t)EPI_ROW(u, ai, m) * 1024 + EPI_COL8(u, bj); f32x4 h0, h1v, p0, p1; unpack8(hv[m][bj], h0, h1v); unpack8(pv[m][bj], p0, p1);
                        *(u32x4*)(base + o) = pack8(h0 * 1.189207115002721f + sig4(acc[ai][bj][m][0]) * p0, h1v * 1.189207115002721f + sig4(acc[ai][bj][m][1]) * p1); }
                asm volatile("" ::: "memory"); }
        } else if (wc == 0) {
            const int ln_ = fr + 16 * fq; PG8_LAS int* hw = hist + wr * 32; if (ln_ < 32) hw[ln_] = 0;
            const f32x4 b0 = *(const f32x4*)(brouter + 8 * fq), b1 = *(const f32x4*)(brouter + 8 * fq + 4);
#pragma unroll
            for (int ai = 0; ai < 2; ++ai)
#pragma unroll
                for (int m = 0; m < 4; ++m) {
                    float v[8]; const f32x4 l0 = acc[ai][0][m][0] + acc[ai][1][m][0] + b0, l1 = acc[ai][0][m][1] + acc[ai][1][m][1] + b1;
#pragma unroll
                    for (int i = 0; i < 4; ++i) { v[i] = l0[i]; v[4 + i] = l1[i]; }
                    float tv[4]; int te[4];
#pragma unroll
                    for (int r = 0; r < 4; ++r) {
                        float bv = -3.0e38f; int bi = 0;
#pragma unroll
                        for (int i = 0; i < 8; ++i) { if (v[i] > bv) { bv = v[i]; bi = i; } }
                        const int be = 8 * fq + bi;
                        float gv = bv; int ge = be;
#pragma unroll
                        for (int o = 16; o <= 32; o <<= 1) { const float ov = __shfl_xor(gv, o); const int oe = __shfl_xor(ge, o); if (ov > gv || (ov == gv && oe < ge)) { gv = ov; ge = oe; } }
                        tv[r] = gv; te[r] = ge;
                        if (ge == be) {
#pragma unroll
                            for (int i = 0; i < 8; ++i) if (i == bi) v[i] = -3.0e38f; }
                    }
                    if (fq == 0) { const float e1 = __expf(tv[1] - tv[0]), e2 = __expf(tv[2] - tv[0]), e3 = __expf(tv[3] - tv[0]); const float inv = 1.0f / (1.0f + e1 + e2 + e3);
                        const int t = EPI_ROW(u, ai, m);
                        *(int4*)(tope + (size_t)t * 4) = make_int4(te[0], te[1], te[2], te[3]);
                        *(float4*)(topw + (size_t)t * 4) = make_float4(inv, e1 * inv, e2 * inv, e3 * inv);
#pragma unroll
                        for (int k = 0; k < 4; ++k) atomicAdd((int*)&hw[te[k]], 1); }
                }
            if (ln_ < 32) cnt[(u.pm * 2 + wr) * 32 + ln_] = hw[ln_];
        }
    }
};
struct EpiM1 {
    static constexpr bool PERM = true;
    __device__ __forceinline__ void init(const Unit& u, int wc, int fq, f32x4 (&ini)[2][2]) const { ini[0][0] = ini[0][1] = ini[1][0] = ini[1][1] = (f32x4){0.f, 0.f, 0.f, 0.f}; }
    bf16_t* act; const float* bgate; const float* bup;
    __device__ __forceinline__ void operator()(const f32x4 (&acc)[2][2][4][2], const Unit& u, int wr, int wc, int fr, int fq) const {
        const int col = u.pn * HALF + wc * 32 + 8 * fq;
#pragma unroll
        for (int ai = 0; ai < 2; ++ai)
#pragma unroll
            for (int m = 0; m < 4; ++m) { f32x4 o[2];
#pragma unroll
                for (int n = 0; n < 2; ++n) { const f32x4 gg = acc[ai][0][m][n], uu = acc[ai][1][m][n];
#pragma unroll
                    for (int j = 0; j < 4; ++j) { const float g = fminf(gg[j], 7.0f), up = fminf(fmaxf(uu[j], -7.0f), 7.0f); o[n][j] = (up + 1.0f) * (g * sigmoid_f(1.702f * g)); } }
                *(u32x4*)(act + (size_t)EPI_ROW(u, ai, m) * 1024 + col) = pack8(o[0], o[1]); }
    }
};
__device__ __forceinline__ u32x2 pack8_fp8(const f32x4 a, const f32x4 b) { int w0 = 0, w1 = 0;
    w0 = __builtin_amdgcn_cvt_pk_fp8_f32(a[0], a[1], w0, false); w0 = __builtin_amdgcn_cvt_pk_fp8_f32(a[2], a[3], w0, true);
    w1 = __builtin_amdgcn_cvt_pk_fp8_f32(b[0], b[1], w1, false); w1 = __builtin_amdgcn_cvt_pk_fp8_f32(b[2], b[3], w1, true); return (u32x2){(unsigned)w0, (unsigned)w1}; }
struct EpiM1F8 {
    static constexpr bool PERM = true;
    __device__ __forceinline__ void init(const Unit& u, int wc, int fq, f32x4 (&ini)[2][2]) const { const int col = u.pn * HALF + wc * 32 + 8 * fq; const float* bg = bgate + (size_t)u.aux * 1024 + col; const float* bu = bup + (size_t)u.aux * 1024 + col; ini[0][0] = *(const f32x4*)bg; ini[0][1] = *(const f32x4*)(bg + 4); ini[1][0] = *(const f32x4*)bu; ini[1][1] = *(const f32x4*)(bu + 4); }
    unsigned char* act; const float* bgate; const float* bup;
    __device__ __forceinline__ void operator()(const f32x4 (&acc)[2][2][4][2], const Unit& u, int wr, int wc, int fr, int fq) const {
        const int col = u.pn * HALF + wc * 32 + 8 * fq;
#pragma unroll
        for (int ai = 0; ai < 2; ++ai)
#pragma unroll
            for (int m = 0; m < 4; ++m) { f32x4 o[2];
#pragma unroll
                for (int n = 0; n < 2; ++n) { const f32x4 gg = acc[ai][0][m][n], uu = acc[ai][1][m][n];
#pragma unroll
                    for (int j = 0; j < 4; ++j) { const float g = fminf(gg[j], 7.0f), up = fminf(fmaxf(uu[j], -7.0f), 7.0f); o[n][j] = (up + 1.0f) * (g * sigmoid_f(1.702f * g)); } }
                *(u32x2*)(act + (size_t)(u.pm * BM + ai * HALF + wr * 64 + m * 16 + fr) * 1024 + col) = pack8_fp8(o[0], o[1]); }
    }
};
struct EpiM2 {
    static constexpr bool PERM = true;
    __device__ __forceinline__ void init(const Unit& u, int wc, int fq, f32x4 (&ini)[2][2]) const { if (MOE_FP8) { _Pragma("unroll") for (int bj = 0; bj < 2; ++bj) { const float* bp = bdown + (size_t)u.aux * 1024 + u.pn * BM + bj * HALF + wc * 32 + 8 * fq; ini[bj][0] = *(const f32x4*)bp; ini[bj][1] = *(const f32x4*)(bp + 4); } } else { ini[0][0] = ini[0][1] = ini[1][0] = ini[1][1] = (f32x4){0.f, 0.f, 0.f, 0.f}; } }
    unsigned char* y; const float* bdown; float sc;
    __device__ __forceinline__ void operator()(const f32x4 (&acc)[2][2][4][2], const Unit& u, int wr, int wc, int fr, int fq) const {
        f32x4 b[2][2];
#pragma unroll
        for (int bj = 0; bj < 2; ++bj) { if (MOE_FP8) { b[bj][0] = b[bj][1] = (f32x4){0.f, 0.f, 0.f, 0.f}; }
            else { const float* bp = bdown + (size_t)u.aux * 1024 + EPI_COL8(u, bj); b[bj][0] = *(const f32x4*)bp; b[bj][1] = *(const f32x4*)(bp + 4); } }
#pragma unroll
        for (int ai = 0; ai < 2; ++ai)
#pragma unroll
            for (int m = 0; m < 4; ++m) { const size_t ro = (size_t)EPI_ROW(u, ai, m) * 1024;
#pragma unroll
                for (int bj = 0; bj < 2; ++bj) { const f32x4 v0 = acc[ai][bj][m][0] * sc + b[bj][0], v1 = acc[ai][bj][m][1] * sc + b[bj][1];
                    if (Y_FP8) *(u32x2*)(y + ro + EPI_COL8(u, bj)) = pack8_fp8(v0, v1);
                    else *(u32x4*)((bf16_t*)y + ro + EPI_COL8(u, bj)) = pack8(v0, v1); } }
    }
};
#undef EPI_ROW
#undef EPI_COL8
#undef EPI_COL4
}

struct Args { const float* in[31]; float* out; unsigned char* ws; int ph_lo, ph_hi, li, pad; };
struct Ctx { LAS unsigned char* lds; int tid, lane, wave, vcu, G, gw, ngw; };
__device__ __forceinline__ int lane_id() { return (int)__builtin_amdgcn_mbcnt_hi(~0u, __builtin_amdgcn_mbcnt_lo(~0u, 0u)); }
struct PT { const LAS unsigned long long* t;
    __device__ __forceinline__ unsigned long long get(int k) const { const unsigned long long v = t[k]; const unsigned lo = __builtin_amdgcn_readfirstlane((unsigned)v), hi = __builtin_amdgcn_readfirstlane((unsigned)(v >> 32)); return ((unsigned long long)hi << 32) | lo; }
    __device__ __forceinline__ const float* in(int k) const { return (const float*)get(k); }
    __device__ __forceinline__ float* out() const { return (float*)get(31); }
    __device__ __forceinline__ unsigned char* ws() const { return (unsigned char*)get(32); } };

__device__ __forceinline__ float wave_sum(float v) {
#pragma unroll
    for (int o = 1; o < 64; o <<= 1) v += __shfl_xor(v, o);
    return v;
}
__device__ __forceinline__ void p0_transpose_item(const float* W, int K, int N, bf16* WT, int dst_row0, LAS unsigned char* scr, int kb, int nb, int lane) {
    const int k0 = 64 * kb, n0 = 64 * nb, kr = lane >> 4, nq = lane & 15;
    f32x4 v[16];
#pragma unroll
    for (int i = 0; i < 16; ++i) v[i] = *(const f32x4*)(W + (size_t)(k0 + 4 * i + kr) * N + n0 + 4 * nq);
#pragma unroll
    for (int i = 0; i < 16; ++i) { const int k = 4 * i + kr;
#pragma unroll
        for (int j = 0; j < 4; ++j) *(LAS unsigned short*)(scr + (4 * nq + j) * 144 + 2 * k) = (unsigned short)f2bf(v[i][j]); }
    LDS_WAIT(); asm volatile("" ::: "memory");
    const int c = lane & 7;
#pragma unroll
    for (int j = 0; j < 8; ++j) { const int n = (lane >> 3) + 8 * j; const v4u o = *(const LAS v4u*)(scr + n * 144 + 16 * c);
        *(v4u*)(WT + (size_t)(dst_row0 + n) * K + k0 + 8 * c) = o; }
    LDS_WAIT(); asm volatile("" ::: "memory");
}
__device__ __forceinline__ unsigned char f2fp8(float x) { return (unsigned char)(__builtin_amdgcn_cvt_pk_fp8_f32(x, x, 0, false) & 0xff); }
struct T8Item { const float* W; unsigned char* WT; int dst_row0, k0, n0; float sc; };
__device__ __forceinline__ void t8_load(const T8Item& it, f32x4 (&v)[16], int lane) { const int kr = lane >> 3, nq = lane & 7;
#pragma unroll
    for (int i = 0; i < 16; ++i) v[i] = *(const f32x4*)(it.W + (size_t)(it.k0 + 8 * i + kr) * 1024 + it.n0 + 4 * nq); }
__device__ __forceinline__ void t8_store(const T8Item& it, const f32x4 (&v)[16], LAS unsigned char* scr, int lane) { const int kr = lane >> 3, nq = lane & 7;
#pragma unroll
    for (int i = 0; i < 16; ++i) { const int k = 8 * i + kr;
#pragma unroll
        for (int j = 0; j < 4; ++j) *(LAS unsigned char*)(scr + (4 * nq + j) * 144 + k) = f2fp8(v[i][j] * it.sc); }
    LDS_WAIT(); asm volatile("" ::: "memory");
#pragma unroll
    for (int j = 0; j < 4; ++j) { const int q = lane + 64 * j, n = q >> 3, c = q & 7; const v4u o = *(const LAS v4u*)(scr + n * 144 + 16 * c);
        *(v4u*)(it.WT + (size_t)(it.dst_row0 + n) * 1024 + it.k0 + 16 * c) = o; }
    LDS_WAIT(); asm volatile("" ::: "memory");
}
__device__ __forceinline__ void cv_load(const float* src, f32x4 (&v)[16], int lane) { const f32x4* s = (const f32x4*)src + lane;
#pragma unroll
    for (int j = 0; j < 16; ++j) v[j] = s[64 * j]; }
__device__ __forceinline__ void cv_store(bf16* dst, const f32x4 (&v)[16], int lane) { v2u* o = (v2u*)dst + lane;
#pragma unroll
    for (int j = 0; j < 16; ++j) { v2u w; w.x = pk2(v[j].x, v[j].y); w.y = pk2(v[j].z, v[j].w); o[64 * j] = w; } }
struct cplx { float re, im; };
__device__ __forceinline__ cplx cmul(cplx a, cplx b) { return cplx{a.re * b.re - a.im * b.im, a.re * b.im + a.im * b.re}; }
__device__ __forceinline__ cplx lam_pow(float lre, float lim, float step, float tau) { const float m = __expf(lre * step * tau); float s, c; sincosf(lim * step * tau, &s, &c); return cplx{m * c, m * s}; }
__device__ __forceinline__ cplx bbar_fac(float lre, float lim, float step) { const cplx lb = lam_pow(lre, lim, step, 1.0f); const float nr = lb.re - 1.0f, ni = lb.im, d = 1.0f / (lre * lre + lim * lim);
    return cplx{(nr * lre + ni * lim) * d, (ni * lre - nr * lim) * d}; }

__device__ __forceinline__ void prologue_stream(const PT a, const Ctx& c0) {
    Ctx c = c0; c.lane = lane_id(); c.tid = c.wave * 64 + c.lane;
    unsigned char* ws = a.ws();
    LAS float* scr = (LAS float*)(c.lds + c.wave * 16384);
    const float *w_in = a.in(2), *lre = a.in(3), *lim = a.in(4), *lstep = a.in(5), *bre = a.in(6), *bim = a.in(7), *cre = a.in(8), *cim = a.in(9), *dsk = a.in(10);
    const float *wval = a.in(11), *wgt = a.in(12), *wgrp = a.in(13), *pscale = a.in(14), *wpp = a.in(15), *wout = a.in(16), *wrt = a.in(19);
    const float *wgate = a.in(21), *wup = a.in(23), *wdown = a.in(25), *wpleg = a.in(27), *wplep = a.in(28);
    constexpr int I_IN = 16 * 48, I_GL = 8 * 16, I_SQ = 16 * 16, I_PP = 4 * 16, I_E = 32 * I_SQ;
    constexpr int NITEMS = I_IN + 2 * I_GL + 2 * I_SQ + I_PP + (MOE_FP8 ? 0 : 3 * I_E);
    LAS unsigned char* scrb = (LAS unsigned char*)scr;
    for (int it = c.gw; it < NITEMS; it += c.ngw) {
        int r = it;
        if (r < I_IN) { p0_transpose_item(w_in, 1024, 3072, (bf16*)(ws + WS_WIN), 64 * (r % 48), scrb, r / 48, r % 48, c.lane); continue; } r -= I_IN;
        if (r < 2 * I_GL) { const int which = r / I_GL, q = r % I_GL, nb = q % 16, n0 = 64 * nb;
            p0_transpose_item(which ? wgt : wval, 512, 1024, (bf16*)(ws + WS_WGLU), (n0 >> 7) * 256 + (n0 & 127) + which * 128, scrb, q / 16, nb, c.lane); continue; } r -= 2 * I_GL;
        if (r < I_SQ) { p0_transpose_item(wout, 1024, 1024, (bf16*)(ws + WS_WOUT), 64 * (r % 16), scrb, r / 16, r % 16, c.lane); continue; } r -= I_SQ;
        if (r < I_SQ) { p0_transpose_item(wpleg, 1024, 1024, (bf16*)(ws + WS_WPLE), 64 * (r % 16), scrb, r / 16, r % 16, c.lane); continue; } r -= I_SQ;
        if (r < I_PP) { p0_transpose_item(wplep, 256, 1024, (bf16*)(ws + WS_WPP), 64 * (r % 16), scrb, r / 16, r % 16, c.lane); continue; } r -= I_PP;
#if !MOE_FP8
        if (r < 2 * I_E) { const int which = r / I_E, q = r % I_E, e = q / I_SQ, qq = q % I_SQ, nb = qq % 16, n0 = 64 * nb;
            p0_transpose_item((which ? wup : wgate) + (size_t)e * 1048576, 1024, 1024, (bf16*)(ws + WS_WGU) + (size_t)e * 2048 * 1024, (n0 >> 7) * 256 + (n0 & 127) + which * 128, scrb, qq / 16, nb, c.lane); continue; } r -= 2 * I_E;
        { const int e = r / I_SQ, qq = r % I_SQ; p0_transpose_item(wdown + (size_t)e * 1048576, 1024, 1024, (bf16*)(ws + WS_WDN) + (size_t)e * 1048576, 64 * (qq % 16), scrb, qq / 16, qq % 16, c.lane); }
#endif
    }
    { constexpr int NCX = T / 4, NCV = NCX + T / 16; const float* xs = a.in(0); const float* ps = a.in(1);
#define CV_SRC(m_) ((m_) < NCX ? xs + (size_t)(m_) * 4096 : ps + (size_t)((m_) - NCX) * 4096)
#define CV_DST(m_) ((m_) < NCX ? (bf16*)(ws + WS_XB) + (size_t)(m_) * 4096 : (bf16*)(ws + WS_PB) + (size_t)((m_) - NCX) * 4096)
      int m = c.gw; f32x4 va[16], vb[16];
      if (m < NCV) { cv_load(CV_SRC(m), va, c.lane);
        for (;;) {
            const int m2 = m + c.ngw; const bool h2 = m2 < NCV; if (h2) cv_load(CV_SRC(m2), vb, c.lane);
            cv_store(CV_DST(m), va, c.lane);
            if (!h2) break;
            const int m3 = m2 + c.ngw; const bool h3 = m3 < NCV; if (h3) cv_load(CV_SRC(m3), va, c.lane);
            cv_store(CV_DST(m2), vb, c.lane);
            if (!h3) break;
            m = m3; } }
#undef CV_SRC
#undef CV_DST
    }
}
__device__ __forceinline__ void prologue_tables(const PT a, const Ctx& c0) {
    Ctx c = c0; c.lane = lane_id(); c.tid = c.wave * 64 + c.lane;
    unsigned char* ws = a.ws();
    LAS float* scr = (LAS float*)(c.lds + c.wave * 16384);
    const float *w_in = a.in(2), *lre = a.in(3), *lim = a.in(4), *lstep = a.in(5), *bre = a.in(6), *bim = a.in(7), *cre = a.in(8), *cim = a.in(9), *dsk = a.in(10);
    const float *wval = a.in(11), *wgt = a.in(12), *wgrp = a.in(13), *pscale = a.in(14), *wpp = a.in(15), *wout = a.in(16), *wrt = a.in(19);
    const float *wgate = a.in(21), *wup = a.in(23), *wdown = a.in(25), *wpleg = a.in(27), *wplep = a.in(28);
    { bf16* W = (bf16*)(ws + WS_WPLE) + (size_t)1024 * 1024;
      for (int ch = c.gw * 64 + c.lane; ch < 256 * 128; ch += c.ngw * 64) { const int r = ch >> 7, k0 = (ch & 127) * 8; unsigned o[4] = {0u, 0u, 0u, 0u};
          if (r < 32 || (r >= 128 && r < 160)) { const int e = r & 31; float f[8];
#pragma unroll
              for (int j = 0; j < 8; ++j) { const float w = wrt[(size_t)(k0 + j) * 32 + e]; const float hi = bf2f((unsigned short)f2bf(w)); f[j] = (r < 32) ? hi : (w - hi); }
#pragma unroll
              for (int j = 0; j < 4; ++j) o[j] = pk2(f[2 * j], f[2 * j + 1]); }
          *(v4u*)(W + (size_t)r * 1024 + k0) = (v4u){o[0], o[1], o[2], o[3]}; } }
    for (int it = c.gw; it < 64 * 16; it += c.ngw) { const int c0 = (it >> 4) * 8, d = (it & 15) * 64 + c.lane, g = c0 >> 7; float s[8];
#pragma unroll
        for (int i = 0; i < 8; ++i) s[i] = 0.f;
        for (int j = 0; j < 128; ++j) { const float pw = pscale[g * 128 + j] * wpp[(size_t)(g * 128 + j) * 1024 + d];
#pragma unroll
            for (int i = 0; i < 8; ++i) s[i] += wgrp[(size_t)(g * 128 + (c0 & 127) + i) * 128 + j] * pw; }
        *(v4u*)((bf16*)(ws + WS_WPOOL) + (size_t)d * 512 + c0) = (v4u){pk2(s[0], s[1]), pk2(s[2], s[3]), pk2(s[4], s[5]), pk2(s[6], s[7])}; }
    { bf16* TV = (bf16*)(ws + WS_TV);
      if ((c.gw & 3) == 0 && (c.gw >> 2) < 512) { const int it = c.gw >> 2, g = it >> 4, h = it & 15, hp = c.lane & 15, pq = c.lane >> 4; const float step = __expf(lstep[g]);
          float Kt[32];
#pragma unroll
          for (int tt = 0; tt < 32; ++tt) Kt[tt] = 0.f;
          for (int pi = 0; pi < 16; ++pi) { const int p = pq * 16 + pi; const float lr = lre[g * 64 + p], li = lim[g * 64 + p]; const cplx lb = lam_pow(lr, li, step, 1.0f), bf = bbar_fac(lr, li, step);
              const cplx bb = cmul(bf, cplx{bre[(size_t)(g * 64 + p) * 16 + hp], bim[(size_t)(g * 64 + p) * 16 + hp]});
              cplx w = cmul(cplx{cre[(size_t)(g * 16 + h) * 64 + p], cim[(size_t)(g * 16 + h) * 64 + p]}, bb);
#pragma unroll
              for (int tt = 0; tt < 32; ++tt) { Kt[tt] += w.re; w = cmul(w, lb); } }
#pragma unroll
          for (int tt = 0; tt < 32; ++tt) { Kt[tt] += __shfl_xor(Kt[tt], 16); Kt[tt] += __shfl_xor(Kt[tt], 32); }
          if (h == hp) Kt[0] += dsk[g * 16 + h];
#pragma unroll
          for (int tt = 0; tt < 32; ++tt) { if ((tt >> 3) == pq) { const bf16 v = (bf16)f2bf(Kt[tt]);
              for (int s = 0; s + tt < 32; ++s) TV[((size_t)g * 512 + (size_t)(s + tt) * 16 + h) * 640 + s * 16 + hp] = v; } } }
      for (int it = c.gw; it < 32 * 512; it += c.ngw) { const int g = it >> 9, n = it & 511, j = n >> 4, h = n & 15; bf16* row = TV + (size_t)it * 640;
          if (c.lane * 8 >= (j + 1) * 16) *(v4u*)(row + c.lane * 8) = (v4u){0u, 0u, 0u, 0u};
          const int p = c.lane; const float step = __expf(lstep[g]); const cplx lp = lam_pow(lre[g * 64 + p], lim[g * 64 + p], step, (float)(j + 1));
          const cplx mv = cmul(cplx{cre[(size_t)(g * 16 + h) * 64 + p], cim[(size_t)(g * 16 + h) * 64 + p]}, lp);
          row[512 + p] = (bf16)f2bf(mv.re); row[576 + p] = (bf16)f2bf(-mv.im); }
      bf16* WS = (bf16*)(ws + WS_WS);
      for (int it = c.gw; it < 32 * 256; it += c.ngw) { const int g = it >> 8, n = it & 255; v4u o = (v4u){0u, 0u, 0u, 0u};
          if (n < 128) { const int p = n & 63, s = c.lane >> 1, h0 = (c.lane & 1) * 8; const float step = __expf(lstep[g]), lr = lre[g * 64 + p], li = lim[g * 64 + p];
              const cplx f = cmul(lam_pow(lr, li, step, (float)(31 - s)), bbar_fac(lr, li, step)); float v[8];
#pragma unroll
              for (int i = 0; i < 8; ++i) { const cplx r = cmul(f, cplx{bre[(size_t)(g * 64 + p) * 16 + h0 + i], bim[(size_t)(g * 64 + p) * 16 + h0 + i]}); v[i] = (n < 64) ? r.re : r.im; }
              o = (v4u){pk2(v[0], v[1]), pk2(v[2], v[3]), pk2(v[4], v[5]), pk2(v[6], v[7])}; }
          *(v4u*)(WS + (size_t)it * 512 + c.lane * 8) = o; } }
}
__device__ __forceinline__ void phase_prologue(const PT a, const Ctx& c0) {
    if (c0.wave >= 4) { prologue_stream(a, c0); prologue_tables(a, c0); } else { prologue_tables(a, c0); prologue_stream(a, c0); }
}

__device__ __forceinline__ void phase_moe_convert(const PT a, const Ctx& c0) {
    Ctx c = c0; c.lane = lane_id(); c.tid = c.wave * 64 + c.lane;
    unsigned char* ws = a.ws(); LAS unsigned char* scrb = c.lds + c.wave * 16384;
    const float *wgate = a.in(21), *wup = a.in(23), *wdown = a.in(25);
    { constexpr int NT8 = 3 * 32 * 256;
#define T8_DECODE(r_, it_) do { const int which_ = (r_) / 8192, q_ = (r_) % 8192, e_ = q_ >> 8, qq_ = q_ & 255, nb_ = qq_ & 31, n0_ = 32 * nb_; \
        it_.k0 = 128 * (qq_ >> 5); it_.n0 = n0_; \
        if (which_ < 2) { it_.W = (which_ ? wup : wgate) + (size_t)e_ * 1048576; it_.WT = (unsigned char*)(ws + WS_WGU) + (size_t)e_ * 2048 * 1024; it_.dst_row0 = (n0_ >> 7) * 256 + (n0_ & 127) + which_ * 128; it_.sc = 32.0f; } \
        else { it_.W = wdown + (size_t)e_ * 1048576; it_.WT = (unsigned char*)(ws + WS_WDN) + (size_t)e_ * 1048576; it_.dst_row0 = n0_; it_.sc = 64.0f; } } while (0)
      int r = c.gw; T8Item ia, ib; f32x4 va[16], vb[16];
      if (r < NT8) { T8_DECODE(r, ia); t8_load(ia, va, c.lane);
        for (;;) {
            const int r2 = r + c.ngw; const bool h2 = r2 < NT8; if (h2) { T8_DECODE(r2, ib); t8_load(ib, vb, c.lane); }
            t8_store(ia, va, scrb, c.lane);
            if (!h2) break;
            const int r3 = r2 + c.ngw; const bool h3 = r3 < NT8; if (h3) { T8_DECODE(r3, ia); t8_load(ia, va, c.lane); }
            t8_store(ib, vb, scrb, c.lane);
            if (!h3) break;
            r = r3; } }
#undef T8_DECODE
    }
}

__device__ __forceinline__ void unpack8f(const v4u v, float (&f)[8]) { f[0] = pg8::bf_lo(v.x); f[1] = pg8::bf_hi(v.x); f[2] = pg8::bf_lo(v.y); f[3] = pg8::bf_hi(v.y); f[4] = pg8::bf_lo(v.z); f[5] = pg8::bf_hi(v.z); f[6] = pg8::bf_lo(v.w); f[7] = pg8::bf_hi(v.w); }
__device__ __forceinline__ void phase_pooling(const PT a, const Ctx& c0) {
    Ctx c = c0; c.lane = lane_id(); c.tid = c.wave * 64 + c.lane;
    const bf16* up = (const bf16*)(a.ws() + WS_UPOOL) + c.lane * 8; bf16* po = (bf16*)(a.ws() + WS_POOLED) + c.lane * 8;
    const int w = 2 << (c.lane >> 4);
    for (int run = c.gw; run < T / 32; run += c.ngw) { const int t0 = run * 32, pos0 = t0 & (SEQ - 1);
        float s[8];
#pragma unroll
        for (int i = 0; i < 8; ++i) s[i] = 0.f;
        for (int j = 1; j < w; ++j) { if (pos0 - j >= 0) { float f[8]; unpack8f(*(const v4u*)(up + (size_t)(t0 - j) * 512), f);
#pragma unroll
                for (int i = 0; i < 8; ++i) s[i] += f[i]; } }
#pragma unroll 4
        for (int q = 0; q < 32; ++q) { const int t = t0 + q, pos = pos0 + q; float f[8], o[8]; unpack8f(*(const v4u*)(up + (size_t)t * 512), f);
            const int cnt = (pos + 1 < w) ? pos + 1 : w; const float inv = 1.0f / (float)cnt;
#pragma unroll
            for (int i = 0; i < 8; ++i) { s[i] += f[i]; o[i] = s[i] * inv - f[i]; }
            *(v4u*)(po + (size_t)t * 512) = (v4u){pk2(o[0], o[1]), pk2(o[2], o[3]), pk2(o[4], o[5]), pk2(o[6], o[7])};
            if (pos - w + 1 >= 0) { float g[8]; unpack8f(*(const v4u*)(up + (size_t)(t - w + 1) * 512), g);
#pragma unroll
                for (int i = 0; i < 8; ++i) s[i] -= g[i]; } } }
}

__device__ __forceinline__ void phase_scan(const PT a, const Ctx& c0) {
    Ctx c = c0; c.lane = lane_id(); c.tid = c.wave * 64 + c.lane;
    const float* S = (const float*)(a.ws() + WS_S); bf16* ue = (bf16*)(a.ws() + WS_UEXT);
    const float *lre = a.in(3), *lim = a.in(4), *lstep = a.in(5);
    for (int it = c.gw; it < NG * BATCH; it += c.ngw) { const int g = it >> 4, b = it & 15, p = c.lane;
        const cplx l32 = lam_pow(lre[g * 64 + p], lim[g * 64 + p], __expf(lstep[g]), 32.0f);
        const float* sp = S + ((size_t)g * 2048 + (size_t)b * 128) * 128 + p; bf16* up = ue + ((size_t)g * 2048 + (size_t)b * 128) * 640 + 512 + p;
        cplx X{0.f, 0.f};
        for (int c0 = 0; c0 < NCH; c0 += 16) { float sr[16], si[16];
#pragma unroll
            for (int j = 0; j < 16; ++j) { sr[j] = sp[(size_t)(c0 + j) * 128]; si[j] = sp[(size_t)(c0 + j) * 128 + 64]; }
#pragma unroll
            for (int j = 0; j < 16; ++j) { up[(size_t)(c0 + j) * 640] = (bf16)f2bf(X.re); up[(size_t)(c0 + j) * 640 + 64] = (bf16)f2bf(X.im);
                const cplx n = cmul(l32, X); X.re = n.re + sr[j]; X.im = n.im + si[j]; } } }
}

__device__ __forceinline__ void phase_ln1(const PT a, const Ctx& c0) {
    Ctx c = c0; c.lane = lane_id(); c.tid = c.wave * 64 + c.lane;
    bf16* h1 = (bf16*)(a.ws() + WS_H1); const float *g1 = a.in(17), *b1 = a.in(18);
    f32x4 gv[4], bv[4];
#pragma unroll
    for (int j = 0; j < 4; ++j) { gv[j] = ((const f32x4*)g1)[c.lane + 64 * j]; bv[j] = ((const f32x4*)b1)[c.lane + 64 * j]; }
    for (int m0 = c.gw * 4; m0 < T; m0 += c.ngw * 4) {
        v2u q[4][4];
#pragma unroll
        for (int r = 0; r < 4; ++r) { const v2u* xr = (const v2u*)(h1 + (size_t)(m0 + r) * 1024) + c.lane;
#pragma unroll
            for (int j = 0; j < 4; ++j) q[r][j] = xr[64 * j]; }
#pragma unroll
        for (int r = 0; r < 4; ++r) { const int m = m0 + r; f32x4 v[4]; float sm = 0.f;
#pragma unroll
            for (int j = 0; j < 4; ++j) { v[j] = (f32x4){pg8::bf_lo(q[r][j].x), pg8::bf_hi(q[r][j].x), pg8::bf_lo(q[r][j].y), pg8::bf_hi(q[r][j].y)}; sm += (v[j].x + v[j].y) + (v[j].z + v[j].w); }
            const float mean = wave_sum(sm) * (1.f / 1024.f); float s2 = 0.f;
#pragma unroll
            for (int j = 0; j < 4; ++j) { v[j] = v[j] - mean; s2 += (v[j].x * v[j].x + v[j].y * v[j].y) + (v[j].z * v[j].z + v[j].w * v[j].w); }
            const float rstd = 1.f / sqrtf(wave_sum(s2) * (1.f / 1024.f) + LN_EPS);
            v2u* o = (v2u*)(h1 + (size_t)m * 1024) + c.lane; unsigned* oq = (unsigned*)(a.ws() + WS_H1Q + (size_t)m * 1024) + c.lane;
#pragma unroll
            for (int j = 0; j < 4; ++j) { const f32x4 y = v[j] * rstd * gv[j] + bv[j]; v2u w; w.x = pk2(y.x, y.y); w.y = pk2(y.z, y.w); o[64 * j] = w;
                if (MOE_FP8) { int qq = 0; qq = __builtin_amdgcn_cvt_pk_fp8_f32(y.x, y.y, qq, false); qq = __builtin_amdgcn_cvt_pk_fp8_f32(y.z, y.w, qq, true); oq[64 * j] = (unsigned)qq; } } } }
}

__device__ __forceinline__ void phase_route_count(const PT a, const Ctx& c0) {
    Ctx c = c0; c.lane = lane_id(); c.tid = c.wave * 64 + c.lane;
    LAS int* hist = (LAS int*)c.lds; const int* tope = (const int*)(a.ws() + WS_TOPE); int* cnt = (int*)(a.ws() + WS_CNT);
    for (int w = blockIdx.x; w < 256; w += c.G) {
        if (c.tid < 32) hist[c.tid] = 0;
        __syncthreads();
        { const int slot = c.tid * 2; const int2 e2 = *(const int2*)(tope + (size_t)w * 1024 + slot); atomicAdd((int*)&hist[e2.x], 1); atomicAdd((int*)&hist[e2.y], 1); }
        __syncthreads();
        if (c.tid < 32) cnt[w * 32 + c.tid] = hist[c.tid];
        __syncthreads();
    }
}
__device__ __forceinline__ void phase_route_place(const PT a, const Ctx& c0) {
    Ctx c = c0; c.lane = lane_id(); c.tid = c.wave * 64 + c.lane;
    LAS int* L = (LAS int*)c.lds;
    const int* tope = (const int*)(a.ws() + WS_TOPE); const int* cnt = (const int*)(a.ws() + WS_CNT); int* tpg = (int*)(a.ws() + WS_CNT + 65536);
    for (int w = blockIdx.x; w < 256; w += c.G) { const int s = w / WPS, wl = w % WPS;
        int* rowtok = (int*)(a.ws() + WS_ROWTOK) + (size_t)s * SLAB_ROWS; int* slotpos = (int*)(a.ws() + WS_SLOTPOS);
        if (c.tid < 32) { int tot = 0, pre = 0; for (int q = 0; q < WPS; ++q) { const int v = cnt[((s * WPS + q) * 2) * 32 + c.tid] + cnt[((s * WPS + q) * 2 + 1) * 32 + c.tid]; tot += v; pre += (q < wl) ? v : 0; } L[c.tid] = tot; L[32 + c.tid] = pre; L[96 + c.tid] = 0; }
        __syncthreads();
        if (c.tid == 0) { int acc = 0; for (int e = 0; e < 32; ++e) { L[128 + e] = acc; L[64 + e] = acc * 256; acc += (L[e] + 255) >> 8; } L[160] = acc;
            if (wl == 0) for (int e = 0; e <= 32; ++e) tpg[s * 64 + e] = L[128 + e]; }
        __syncthreads();
        { const int slot = c.tid * 2, tok = w * 256 + (slot >> 2); const int2 e2 = *(const int2*)(tope + (size_t)w * 1024 + slot);
#pragma unroll
          for (int q = 0; q < 2; ++q) { const int e = q ? e2.y : e2.x; const int r = atomicAdd((int*)&L[96 + e], 1); const int pos = L[64 + e] + L[32 + e] + r;
              rowtok[pos] = tok; slotpos[(size_t)tok * 4 + ((slot + q) & 3)] = pos; } }
        if (wl < 32) { const int e = wl, tot = L[e], end = ((tot + 255) >> 8) << 8; for (int r = tot + c.tid; r < end; r += 512) rowtok[L[64 + e] + r] = s * SLAB_T; }
        __syncthreads();
    }
}
__device__ __forceinline__ void phase_combine(const PT a, const Ctx& c0, int s) {
    Ctx c = c0; c.lane = lane_id(); c.tid = c.wave * 64 + c.lane;
    const bf16* y = (const bf16*)(a.ws() + WS_Y); const float* topw = (const float*)(a.ws() + WS_TOPW); float* out = a.out(); const float *g2 = a.in(29), *b2 = a.in(30);
    f32x4 gv[4], bv[4];
#pragma unroll
    for (int j = 0; j < 4; ++j) { gv[j] = ((const f32x4*)g2)[c.lane + 64 * j]; bv[j] = ((const f32x4*)b2)[c.lane + 64 * j]; }
    const bf16* base = (const bf16*)(a.ws() + WS_BASE);
    for (int tl = c.gw; tl < SLAB_T; tl += c.ngw) { const int t = s * SLAB_T + tl; f32x4* xr = (f32x4*)(out + (size_t)t * 1024) + c.lane; f32x4 v[4]; const v2u* br = (const v2u*)(base + (size_t)t * 1024) + c.lane;
        const float4 wk = *(const float4*)(topw + (size_t)t * 4); const float wv[4] = {wk.x, wk.y, wk.z, wk.w};
        const int4 pk = *(const int4*)((const int*)(a.ws() + WS_SLOTPOS) + (size_t)t * 4); const int pv[4] = {pk.x, pk.y, pk.z, pk.w};
#pragma unroll
        for (int j = 0; j < 4; ++j) { const v2u q = br[64 * j]; v[j] = (f32x4){pg8::bf_lo(q.x), pg8::bf_hi(q.x), pg8::bf_lo(q.y), pg8::bf_hi(q.y)}; }
#pragma unroll
        for (int k = 0; k < 4; ++k) {
            if (Y_FP8) { const unsigned* yr = (const unsigned*)((const unsigned char*)y + (size_t)pv[k] * 1024) + c.lane;
#pragma unroll
                for (int j = 0; j < 4; ++j) { const unsigned q = yr[64 * j]; const auto lo = __builtin_amdgcn_cvt_pk_f32_fp8((int)q, false), hi = __builtin_amdgcn_cvt_pk_f32_fp8((int)q, true);
                    v[j] = v[j] + (f32x4){lo[0], lo[1], hi[0], hi[1]} * wv[k]; } }
            else { const v2u* yr = (const v2u*)(y + (size_t)pv[k] * 1024) + c.lane;
#pragma unroll
                for (int j = 0; j < 4; ++j) { const v2u q = yr[64 * j]; v[j] = v[j] + (f32x4){pg8::bf_lo(q.x), pg8::bf_hi(q.x), pg8::bf_lo(q.y), pg8::bf_hi(q.y)} * wv[k]; } } }
        float sm = 0.f;
#pragma unroll
        for (int j = 0; j < 4; ++j) sm += (v[j].x + v[j].y) + (v[j].z + v[j].w);
        const float mean = wave_sum(sm) * (1.f / 1024.f); float s2 = 0.f;
#pragma unroll
        for (int j = 0; j < 4; ++j) { v[j] = v[j] - mean; s2 += (v[j].x * v[j].x + v[j].y * v[j].y) + (v[j].z * v[j].z + v[j].w * v[j].w); }
        const float rstd = 1.f / sqrtf(wave_sum(s2) * (1.f / 1024.f) + LN_EPS);
#pragma unroll
        for (int j = 0; j < 4; ++j) xr[64 * j] = v[j] * rstd * gv[j] + bv[j]; }
}

__global__ void __launch_bounds__(NWAVES * 64, 2) mega_fwd(Args args) {
    extern __shared__ __attribute__((aligned(16))) unsigned char lds_raw[];
    Ctx c;
    c.lds = (LAS unsigned char*)lds_raw;
    c.tid = threadIdx.x; c.lane = c.tid & 63; c.wave = __builtin_amdgcn_readfirstlane(c.tid >> 6);
    c.G = gridDim.x; { const int bx = blockIdx.x; c.vcu = (c.G % 8 == 0) ? (bx % 8) * (c.G / 8) + bx / 8 : bx; }
    c.gw = c.vcu * NWAVES + c.wave; c.ngw = c.G * NWAVES;
    volatile LAS unsigned* MISC = (volatile LAS unsigned*)(c.lds + MISC_OFF);
    for (int u = c.tid; u < (LDS_BYTES - LDSCTL_OFF) / 4; u += NWAVES * 64) ((LAS unsigned*)(c.lds + LDSCTL_OFF))[u] = 0u;
    __syncthreads();
    { LAS unsigned long long* ptw = (LAS unsigned long long*)(c.lds + PTAB_OFF);
      if (c.tid < 31) ptw[c.tid] = (unsigned long long)args.in[c.tid]; else if (c.tid == 31) ptw[31] = (unsigned long long)args.out; else if (c.tid == 32) ptw[32] = (unsigned long long)args.ws; }
    __syncthreads();
    const PT pt{(const LAS unsigned long long*)(c.lds + PTAB_OFF)};
    unsigned char* ws = pt.ws();
    XcdBarrier bar; bar.bar = (unsigned*)(ws + WS_CTL) + CW_BAR + args.li * XCD_BAR_WORDS; bar.x = 0; bar.st = nullptr;
    if (!MK_PER_PHASE) bar = xcd_barrier_post((unsigned*)(ws + WS_CTL) + CW_BAR + args.li * XCD_BAR_WORDS, MISC + 8);
    const int lo = args.ph_lo, hi = args.ph_hi;
#ifndef PH_MASK
#define PH_MASK 0xFFFFFFFFu
#endif
#define IN(k) (((PH_MASK >> (k)) & 1u) && lo <= (k) && (k) < hi)
#define SEAM(k) do { if (IN(k) && IN((k) + 1)) xcd_barrier(bar); } while (0)
    LAS unsigned char* ring = c.lds;
    const int bid = (int)blockIdx.x;
    using namespace pg8;

    if (IN(0)) { phase_prologue(pt, c); }
    SEAM(0);
    if (IN(1)) {
        Prob P{(const char*)(ws + WS_XB), (const char*)(ws + WS_WIN), nullptr, 2048u, 2048u, 128u, 16, 0, 0, c.wave, 0x7F7F7F7F};
        GridOrder S; S.init(T / 256, NIN / 256, c.G, bid, -1);
        EpiInProj E{(bf16_t*)(ws + WS_UEXT), (bf16_t*)(ws + WS_UPOOL), (bf16_t*)(ws + WS_GA), (bf16_t*)(ws + WS_GB)};
        const bool conv_first = ((bid >> 3) & 1) == 0;
        if (MOE_FP8 && conv_first) { phase_moe_convert(pt, c); __syncthreads(); }
        gemm_phase<0, false, EpiInProj, GridOrder, true>(ring, P, S, E);
        if (MOE_FP8 && !conv_first) phase_moe_convert(pt, c);
    }
    SEAM(1);
    if (IN(2)) {
        Prob P{(const char*)(ws + WS_UEXT), (const char*)(ws + WS_WS), nullptr, (unsigned)(UEXT_LD * 2), 1024u, 128u, 8, 256, 0, c.wave, 0x7F7F7F7F};
        GridOrder S; S.init(NG * CHROWS / 256, 1, c.G, bid, 3);
        EpiS E{(float*)(ws + WS_S)};
        gemm_phase<0, false, EpiS, GridOrder, true>(ring, P, S, E);
        phase_pooling(pt, c);
    }
    SEAM(2);
    if (IN(3)) {
        phase_scan(pt, c);
        Prob P{(const char*)(ws + WS_POOLED), (const char*)(ws + WS_WPOOL), nullptr, 1024u, 1024u, 128u, 8, 0, 0, c.wave, 0x7F7F7F7F};
        GridOrder S; S.init(T / 256, 4, c.G, bid, -1);
        EpiPool E{(bf16_t*)(ws + WS_GB)};
        gemm_phase<0, false, EpiPool, GridOrder, true>(ring, P, S, E);
    }
    SEAM(3);
    if (IN(4)) {
        Prob P{(const char*)(ws + WS_UEXT), (const char*)(ws + WS_TV), nullptr, (unsigned)(UEXT_LD * 2), (unsigned)(UEXT_LD * 2), 128u, 10, 512, 0, c.wave, 0x7F7F7F7F};
        GridOrder S; S.init(NG * CHROWS / 256, 2, c.G, bid, 3);
        EpiBf16<1> E{(bf16_t*)(ws + WS_Z), 512};
        gemm_phase<0, false, EpiBf16<1>, GridOrder, true>(ring, P, S, E);
    }
    SEAM(4);
    if (IN(5)) {
        Prob P{(const char*)(ws + WS_Z), (const char*)(ws + WS_WGLU), nullptr, (unsigned)(2 * MiB), 1024u, (unsigned)(8 * MiB), 8, 0, 0, c.wave, 0x7F7F7F7F};
        GridOrder S; S.init(T / 256, 8, c.G, bid, -1);
        EpiGlu E{(bf16_t*)(ws + WS_GA), (const bf16_t*)(ws + WS_GB)};
        gemm_phase<1, false, EpiGlu, GridOrder, true>(ring, P, S, E);
    }
    SEAM(5);
    if (IN(6)) {
        Prob P{(const char*)(ws + WS_GA), (const char*)(ws + WS_WOUT), nullptr, 2048u, 2048u, 128u, 16, 0, 0, c.wave, 0x7F7F7F7F};
        GridOrder S; S.init(T / 256, 4, c.G, bid, -1);
        EpiWout E{(bf16_t*)(ws + WS_H1)};
        gemm_phase<0, false, EpiWout, GridOrder, true>(ring, P, S, E);
    }
    SEAM(6);
    if (IN(7)) {
        const bool rows_first = ((bid >> 3) & 1) == 0;
        if (rows_first) phase_ln1(pt, c);
        Prob P{(const char*)(ws + WS_PB), (const char*)(ws + WS_WPP), nullptr, 512u, 512u, 128u, 4, 0, 0, c.wave, 0x7F7F7F7F};
        GridOrder S; S.init(T / 256, 4, c.G, bid, -1);
        EpiBf16<0> E{(bf16_t*)(ws + WS_PP), 1024};
        gemm_phase<0, false, EpiBf16<0>, GridOrder, true>(ring, P, S, E);
        if (!rows_first) phase_ln1(pt, c);
    }
    SEAM(7);
    if (IN(8)) {
        Prob P{(const char*)(ws + WS_H1), (const char*)(ws + WS_WPLE), nullptr, 2048u, 2048u, 128u, 16, 0, 0, c.wave, 0x7F7F7F7F};
        GridOrder S; S.init(T / 256, 5, c.G, bid, -1);
        EpiPle E{(const bf16_t*)(ws + WS_H1), (const bf16_t*)(ws + WS_PP), (bf16_t*)(ws + WS_BASE), pt.in(20), (int*)(ws + WS_TOPE), (float*)(ws + WS_TOPW), (PG8_LAS int*)(c.lds + HIST_OFF), (int*)(ws + WS_CNT)};
        gemm_phase<0, false, EpiPle, GridOrder, true>(ring, P, S, E);
    }
    SEAM(8);
    if (IN(9)) phase_route_place(pt, c);
    SEAM(9);
#define MOE_SLAB(s) do { constexpr int pa = 10 + 2 * (s), pb = 11 + 2 * (s); \
        LAS int* tp = (LAS int*)(c.lds + TP_OFF); \
        if (IN(pa) || IN(pb)) { const int tid_ = c.wave * 64 + lane_id(); __syncthreads(); if (tid_ < 33) tp[tid_] = ((const int*)(ws + WS_CNT + 65536))[(s) * 64 + tid_]; __syncthreads(); } \
        if (IN(pa)) { \
            const bool rows_first = ((bid >> 3) & 1) == 0; \
            if ((s) > 0 && rows_first) phase_combine(pt, c, (s) - 1); \
            MoeOrder S; S.init((const PG8_LAS int*)tp, 8, c.G, bid); \
            if (STAGGER_US > 0 && ((bid >> 3) & 1)) { const unsigned long long t0_ = __builtin_amdgcn_s_memrealtime(); while (__builtin_amdgcn_s_memrealtime() - t0_ < (unsigned long long)(STAGGER_US * 100)) __builtin_amdgcn_s_sleep(8); } \
            if (MOE_FP8) { \
                Prob P{(const char*)(ws + WS_H1Q), (const char*)(ws + WS_WGU), (const int*)(ws + WS_ROWTOK) + (size_t)(s) * SLAB_ROWS, 1024u, 1024u, 128u, 8, 2048, IB_OFF, c.wave, 0x7A7A7A7A}; \
                EpiM1F8 E{(unsigned char*)(ws + WS_ACT), pt.in(22), pt.in(24)}; \
                if (SHADOW == 11 && (s) == 0) { EpiNull<true> E0; gemm_phase<2, true, EpiNull<true>, MoeOrder, true>(ring, P, S, E0); } \
                gemm_phase<2, true, EpiM1F8, MoeOrder, true>(ring, P, S, E); \
            } else { \
                Prob P{(const char*)(ws + WS_H1), (const char*)(ws + WS_WGU), (const int*)(ws + WS_ROWTOK) + (size_t)(s) * SLAB_ROWS, 2048u, 2048u, 128u, 16, 2048, IB_OFF, c.wave, 0x7F7F7F7F}; \
                EpiM1 E{(bf16_t*)(ws + WS_ACT), pt.in(22), pt.in(24)}; \
                gemm_phase<2, false, EpiM1, MoeOrder, true>(ring, P, S, E); \
            } \
            if ((s) > 0 && !rows_first) phase_combine(pt, c, (s) - 1); \
        } \
        SEAM(pa); \
        if (IN(pb)) { \
            MoeOrder S; S.init((const PG8_LAS int*)tp, 4, c.G, bid); \
            if (MOE_FP8) { \
                Prob P{(const char*)(ws + WS_ACT), (const char*)(ws + WS_WDN), nullptr, 1024u, 1024u, 128u, 8, 1024, 0, c.wave, 0x79797979}; \
                EpiM2 E{(unsigned char*)(ws + WS_Y), pt.in(26), 1.0f}; \
                gemm_phase<0, true, EpiM2, MoeOrder, true>(ring, P, S, E); \
            } else { \
                Prob P{(const char*)(ws + WS_ACT), (const char*)(ws + WS_WDN), nullptr, 2048u, 2048u, 128u, 16, 1024, 0, c.wave, 0x7F7F7F7F}; \
                EpiM2 E{(unsigned char*)(ws + WS_Y), pt.in(26), 1.0f}; \
                gemm_phase<0, false, EpiM2, MoeOrder, true>(ring, P, S, E); \
            } \
        } \
        SEAM(pb); } while (0)
    MOE_SLAB(0);
#if MOE_NSLAB == 2
    MOE_SLAB(1);
#endif
#undef MOE_SLAB
    if (IN(NPHASE - 1)) phase_combine(pt, c, NSLAB - 1);
#undef IN
#undef SEAM
}

extern "C" void kernel_launch(void* const* d_in, const int* in_sizes, int n_in, void* d_out, int out_size, void* d_ws, size_t ws_size, hipStream_t stream) {
    static int grid = 0;
    if (grid == 0) {
        if (n_in != 31 || in_sizes[0] != T * D || out_size != T * D || ws_size < WS_END) { fprintf(stderr, "kernel_launch: unexpected problem (n_in %d, in0 %d, out %d, ws %zu); nothing launched\n", n_in, n_in > 0 ? in_sizes[0] : -1, out_size, ws_size); grid = -1; return; }
        int dev = 0, cus = 0, per_cu = 0;
        if (hipGetDevice(&dev) != hipSuccess || hipDeviceGetAttribute(&cus, hipDeviceAttributeMultiprocessorCount, dev) != hipSuccess) { grid = -1; return; }
        if (hipFuncSetAttribute((const void*)mega_fwd, hipFuncAttributeMaxDynamicSharedMemorySize, LDS_BYTES) != hipSuccess) { fprintf(stderr, "kernel_launch: hipFuncSetAttribute failed\n"); grid = -1; return; }
        if (hipOccupancyMaxActiveBlocksPerMultiprocessor(&per_cu, (const void*)mega_fwd, NWAVES * 64, LDS_BYTES) != hipSuccess || per_cu < 1) { fprintf(stderr, "kernel_launch: occupancy query reports %d workgroups per CU\n", per_cu); }
        (void)hipGetLastError();
        grid = cus;
    }
    if (grid < 0) return;
    if (hipMemsetAsync((char*)d_ws + WS_CTL, 0, CTL_ZERO_BYTES, stream) != hipSuccess) return;
    Args a{};
    for (int i = 0; i < 31; ++i) a.in[i] = (const float*)d_in[i];
    a.out = (float*)d_out; a.ws = (unsigned char*)d_ws; a.pad = 0;
#if MK_PER_PHASE
    for (int ph = 0; ph < NPHASE; ++ph) { a.ph_lo = ph; a.ph_hi = ph + 1; a.li = 0; hipLaunchKernelGGL(mega_fwd, dim3(grid), dim3(NWAVES * 64), LDS_BYTES, stream, a); }
#elif defined(PROBE_REPEAT)
    a.ph_lo = 0; a.ph_hi = PROBE_REPEAT + 1; a.li = 0; hipLaunchKernelGGL(mega_fwd, dim3(grid), dim3(NWAVES * 64), LDS_BYTES, stream, a);
    a.ph_lo = PROBE_REPEAT; a.ph_hi = NPHASE; a.li = 1; hipLaunchKernelGGL(mega_fwd, dim3(grid), dim3(NWAVES * 64), LDS_BYTES, stream, a);
#else
    a.ph_lo = 0; a.ph_hi = NPHASE; a.li = 0;
    hipLaunchKernelGGL(mega_fwd, dim3(grid), dim3(NWAVES * 64), LDS_BYTES, stream, a);
#endif
}
```
